# Optimizing an MI355X kernel written in HIP

```python
import jax, jax.numpy as jnp
from jax import lax
import numpy as np

D_MODEL = 1024
BATCH = 8
SEQ = 2048
DEPTH = 1
DEC_BATCH = 128
DEC_SEQ = 4
PAST_LEN = 16384
PAGE_SIZE = 128

GLA_HEADS = 4
GLA_DK = 64
GLA_DV = 128
GLA_RANK = 16
GLA_TEMP = 16.0
RET_HEADS = 4
RET_DK = 64
RET_DV = 128
ROPE_BASE = 10000.0
CHUNK = 32
N_MEM = 256
XA_HEADS = 4
XA_DH = D_MODEL // XA_HEADS
PEER_HEADS = 8
PEER_NKEYS = 128
PEER_N = PEER_NKEYS * PEER_NKEYS
PEER_DQ = 256
PEER_TOPK = 16
PEER_BLOCK = 256
EPS = 1e-6

GLA_QK = GLA_HEADS * GLA_DK
GLA_V = GLA_HEADS * GLA_DV
RET_QK = RET_HEADS * RET_DK
RET_V = RET_HEADS * RET_DV
IN_SIZES = (GLA_QK, GLA_QK, GLA_V, GLA_RANK, GLA_V, RET_QK, RET_QK, RET_V, RET_V, D_MODEL, D_MODEL)
IN_WIDTH = 3 * GLA_QK + 2 * GLA_V + GLA_RANK - GLA_QK + 2 * RET_QK + 2 * RET_V + 2 * D_MODEL

kernel_name = 'gla_retnet_peer_hybrid_step'


def rms_norm(x, g):
    xf = x.astype(jnp.float32)
    y = xf * lax.rsqrt(jnp.mean(xf * xf, axis=-1, keepdims=True) + EPS)
    return (y * g.astype(jnp.float32)).astype(x.dtype)


def rotary(x, pos):
    half = x.shape[-1] // 2
    inv = ROPE_BASE ** (-jnp.arange(half, dtype=jnp.float32) / half)
    ang = pos.astype(jnp.float32)[:, None] * inv[None, :]
    cos = jnp.cos(ang)[None, :, None, :]
    sin = jnp.sin(ang)[None, :, None, :]
    xf = x.astype(jnp.float32)
    x1, x2 = xf[..., :half], xf[..., half:]
    return jnp.concatenate([x1 * cos - x2 * sin, x1 * sin + x2 * cos], axis=-1).astype(x.dtype)


def gated_linear_chunked(q, k, v, log_a, s0):
    B, S, H, dk = q.shape
    dv = v.shape[-1]
    C = CHUNK if S % CHUNK == 0 else S
    n = S // C

    def to_chunks(t):
        return t.astype(jnp.float32).reshape(B, n, C, H, t.shape[-1]).transpose(1, 0, 2, 3, 4)

    mask = jnp.tril(jnp.ones((C, C), dtype=bool))

    def step(state, inp):
        qc, kc, vc, lc = inp
        b = jnp.cumsum(lc, axis=1)
        b_last = b[:, -1]
        qe = qc * jnp.exp(b)
        ke = kc * jnp.exp(-b)
        inter = jnp.einsum('bchk,bhkv->bchv', qe, state)
        att = jnp.where(mask, jnp.einsum('bchk,bshk->bhcs', qe, ke), 0.0)
        intra = jnp.einsum('bhcs,bshv->bchv', att, vc)
        kd = kc * jnp.exp(b_last[:, None] - b)
        new_state = jnp.exp(b_last)[..., None] * state + jnp.einsum('bshk,bshv->bhkv', kd, vc)
        return new_state, inter + intra

    s_final, o = lax.scan(step, s0.astype(jnp.float32),
                          (to_chunks(q), to_chunks(k), to_chunks(v), to_chunks(log_a)))
    o = o.transpose(1, 0, 2, 3, 4).reshape(B, S, H, dv)
    return o.astype(v.dtype), s_final.astype(s0.dtype)


def token_mixers(xn, pos, s_gla0, s_ret0, w_in, w_a2, b_a, gla_head_norm, ret_head_norm, w_pa, w_pb, w_o):
    B, S, _ = xn.shape
    proj = xn @ w_in
    splits = np.cumsum(np.array(IN_SIZES))[:-1].tolist()
    gq, gk, gv, glr, gr, rq, rk, rv, rg, za, zb = jnp.split(proj, splits, axis=-1)

    def heads(t, h):
        return t.reshape(B, S, h, t.shape[-1] // h)

    log_a = jax.nn.log_sigmoid((glr @ w_a2 + b_a).astype(jnp.float32)) / GLA_TEMP
    o_a, s_gla = gated_linear_chunked(heads(gq, GLA_HEADS) * GLA_DK ** -0.5, heads(gk, GLA_HEADS),
                                      heads(gv, GLA_HEADS), heads(log_a, GLA_HEADS), s_gla0)
    o_a = (rms_norm(o_a, gla_head_norm) * jax.nn.silu(heads(gr, GLA_HEADS))).reshape(B, S, GLA_V)

    log_gamma = jnp.log1p(-(2.0 ** (-5.0 - jnp.arange(RET_HEADS, dtype=jnp.float32))))
    log_g = jnp.broadcast_to(log_gamma[None, None, :, None], (B, S, RET_HEADS, RET_DK))
    q_r = rotary(heads(rq, RET_HEADS), pos)
    k_r = rotary(heads(rk, RET_HEADS), pos) * RET_DK ** -0.5
    o_b, s_ret = gated_linear_chunked(q_r, k_r, heads(rv, RET_HEADS), log_g, s_ret0)
    o_b = (rms_norm(o_b, ret_head_norm) * jax.nn.silu(heads(rg, RET_HEADS))).reshape(B, S, RET_V)

    merged = jax.nn.sigmoid(za) * (o_a @ w_pa) + jax.nn.sigmoid(zb) * (o_b @ w_pb)
    return merged @ w_o, s_gla, s_ret


def memory_kv(mem, norm_mem, w_xk, w_xv):
    B, M, _ = mem.shape
    mn = rms_norm(mem, norm_mem)
    return (mn @ w_xk).reshape(B, M, XA_HEADS, XA_DH), (mn @ w_xv).reshape(B, M, XA_HEADS, XA_DH)


def cross_attn(hn, mk, mv, w_xq, w_xo):
    B, S, D = hn.shape
    q = (hn @ w_xq).reshape(B, S, XA_HEADS, XA_DH)
    s = jnp.einsum('bshd,bmhd->bhsm', q.astype(jnp.float32), mk.astype(jnp.float32)) * XA_DH ** -0.5
    p = jax.nn.softmax(s, axis=-1)
    o = jnp.einsum('bhsm,bmhd->bshd', p, mv.astype(jnp.float32)).astype(hn.dtype).reshape(B, S, D)
    return o @ w_xo


def peer(xn, peer_wq, peer_subkeys, peer_u, peer_v):
    B, S, D = xn.shape
    T = B * S
    xf = xn.reshape(T, D)
    q = (xf @ peer_wq).astype(jnp.float32).reshape(T, PEER_HEADS, PEER_DQ)
    half = PEER_DQ // 2
    sk = peer_subkeys.astype(jnp.float32)
    s1 = jnp.einsum('thd,hkd->thk', q[..., :half], sk[:, 0])
    s2 = jnp.einsum('thd,hkd->thk', q[..., half:], sk[:, 1])
    v1, i1 = lax.top_k(s1, PEER_TOPK)
    v2, i2 = lax.top_k(s2, PEER_TOPK)
    n_cand = PEER_TOPK * PEER_TOPK
    cand_s = (v1[..., :, None] + v2[..., None, :]).reshape(T, PEER_HEADS, n_cand)
    cand_i = (i1[..., :, None] * PEER_NKEYS + i2[..., None, :]).reshape(T, PEER_HEADS, n_cand)
    top_s, top_p = lax.top_k(cand_s, PEER_TOPK)
    idx = jnp.take_along_axis(cand_i, top_p, axis=-1).reshape(T, PEER_HEADS * PEER_TOPK)
    gate = jax.nn.softmax(top_s, axis=-1).reshape(T, PEER_HEADS * PEER_TOPK)
    blk = PEER_BLOCK if T % PEER_BLOCK == 0 else T
    nb = T // blk

    def expert_block(args):
        xb, ib, gb = args
        ue = jnp.take(peer_u, ib, axis=0)
        a = jnp.einsum('td,tkd->tk', xb, ue).astype(jnp.float32)
        w = (jax.nn.gelu(a, approximate=False) * gb).astype(xb.dtype)
        ve = jnp.take(peer_v, ib, axis=0)
        return jnp.einsum('tk,tkd->td', w, ve)

    out = lax.map(expert_block, (xf.reshape(nb, blk, D), idx.reshape(nb, blk, -1), gate.reshape(nb, blk, -1)))
    return out.reshape(B, S, D)


def layer(x, pos, mk, mv, s_gla0, s_ret0, norm_mix, w_in, w_a2, b_a, gla_head_norm, ret_head_norm,
          w_pa, w_pb, w_o, norm_xattn, w_xq, w_xo, norm_ffn, peer_wq, peer_subkeys, peer_u, peer_v):
    mix, s_gla, s_ret = token_mixers(rms_norm(x, norm_mix), pos, s_gla0, s_ret0, w_in, w_a2, b_a,
                                     gla_head_norm, ret_head_norm, w_pa, w_pb, w_o)
    h = x + mix
    h = h + cross_attn(rms_norm(h, norm_xattn), mk, mv, w_xq, w_xo)
    h = h + peer(rms_norm(h, norm_ffn), peer_wq, peer_subkeys, peer_u, peer_v)
    return h, s_gla, s_ret


def setup_inputs(seed: int = 0) -> dict:
    key = jax.random.key(seed)
    ks = iter(jax.random.split(key, 40))
    f32 = jnp.float32

    def nrm(shape, scale):
        return scale * jax.random.normal(next(ks), shape, f32)

    def gain(shape):
        return 1.0 + 0.05 * jax.random.normal(next(ks), shape, f32)

    L, D = DEPTH, D_MODEL
    return {
        'x_prompt': nrm((BATCH, SEQ, D), 1.0),
        'x_sample': nrm((DEC_BATCH, DEC_SEQ, D), 1.0),
        'mem_prompt': nrm((BATCH, N_MEM, D), 1.0),
        'state_gla': nrm((L, DEC_BATCH, GLA_HEADS, GLA_DK, GLA_DV), 0.5),
        'state_ret': nrm((L, DEC_BATCH, RET_HEADS, RET_DK, RET_DV), 0.5),
        'cache_mem_k': nrm((L, DEC_BATCH, N_MEM, XA_HEADS, XA_DH), 1.0),
        'cache_mem_v': nrm((L, DEC_BATCH, N_MEM, XA_HEADS, XA_DH), 1.0),
        'norm_mix': gain((L, D)),
        'w_in': nrm((L, D, IN_WIDTH), D ** -0.5),
        'w_a2': nrm((L, GLA_RANK, GLA_QK), GLA_RANK ** -0.5),
        'b_a': nrm((L, GLA_QK), 0.1),
        'gla_head_norm': gain((L, GLA_HEADS, GLA_DV)),
        'ret_head_norm': gain((L, RET_HEADS, RET_DV)),
        'w_pa': nrm((L, GLA_V, D), GLA_V ** -0.5),
        'w_pb': nrm((L, RET_V, D), RET_V ** -0.5),
        'w_o': nrm((L, D, D), D ** -0.5),
        'norm_xattn': gain((L, D)),
        'norm_mem': gain((L, D)),
        'w_xq': nrm((L, D, D), D ** -0.5),
        'w_xk': nrm((L, D, D), D ** -0.5),
        'w_xv': nrm((L, D, D), D ** -0.5),
        'w_xo': nrm((L, D, D), D ** -0.5),
        'norm_ffn': gain((L, D)),
        'peer_wq': nrm((L, D, PEER_HEADS * PEER_DQ), D ** -0.5),
        'peer_subkeys': nrm((L, PEER_HEADS, 2, PEER_NKEYS, PEER_DQ // 2), (PEER_DQ // 2) ** -0.5),
        'peer_u': nrm((L, PEER_N, D), D ** -0.5),
        'peer_v': nrm((L, PEER_N, D), 0.2),
        'norm_final': gain((D,)),
    }


def reference(x_prompt, x_sample, mem_prompt, state_gla, state_ret, cache_mem_k, cache_mem_v,
              norm_mix, w_in, w_a2, b_a, gla_head_norm, ret_head_norm, w_pa, w_pb, w_o,
              norm_xattn, norm_mem, w_xq, w_xk, w_xv, w_xo,
              norm_ffn, peer_wq, peer_subkeys, peer_u, peer_v, norm_final):
    Bp, Sp, _ = x_prompt.shape
    pos_p = jnp.arange(Sp, dtype=jnp.int32)
    pos_s = PAST_LEN + jnp.arange(x_sample.shape[1], dtype=jnp.int32)
    hp, hs = x_prompt, x_sample
    gla_p, ret_p, mk_p, mv_p, gla_s, ret_s = [], [], [], [], [], []
    for l in range(DEPTH):
        lw = (norm_mix[l], w_in[l], w_a2[l], b_a[l], gla_head_norm[l], ret_head_norm[l],
              w_pa[l], w_pb[l], w_o[l], norm_xattn[l], w_xq[l], w_xo[l],
              norm_ffn[l], peer_wq[l], peer_subkeys[l], peer_u[l], peer_v[l])
        mk, mv = memory_kv(mem_prompt, norm_mem[l], w_xk[l], w_xv[l])
        z_gla = jnp.zeros((Bp, GLA_HEADS, GLA_DK, GLA_DV), x_prompt.dtype)
        z_ret = jnp.zeros((Bp, RET_HEADS, RET_DK, RET_DV), x_prompt.dtype)
        hp, sg, sr = layer(hp, pos_p, mk, mv, z_gla, z_ret, *lw)
        gla_p.append(sg)
        ret_p.append(sr)
        mk_p.append(mk)
        mv_p.append(mv)
        hs, sg, sr = layer(hs, pos_s, cache_mem_k[l], cache_mem_v[l], state_gla[l], state_ret[l], *lw)
        gla_s.append(sg)
        ret_s.append(sr)
    y_prompt = rms_norm(hp, norm_final)
    y_sample = rms_norm(hs, norm_final)
    return (y_prompt, y_sample, jnp.stack(gla_p), jnp.stack(ret_p), jnp.stack(mk_p), jnp.stack(mv_p),
            jnp.stack(gla_s), jnp.stack(ret_s))
```

```cpp
#include <hip/hip_runtime.h>
#include <hip/hip_cooperative_groups.h>
#include <cstdio>
namespace cg = cooperative_groups;

#define LAS __attribute__((address_space(3)))
typedef unsigned short bf16_t;
typedef short bf16x8 __attribute__((ext_vector_type(8)));
typedef float f32x4 __attribute__((ext_vector_type(4)));
typedef float f32x2 __attribute__((ext_vector_type(2)));
typedef unsigned u32x4 __attribute__((ext_vector_type(4)));
typedef unsigned u32x2 __attribute__((ext_vector_type(2)));

constexpr int NTHR = 512;
constexpr int M_TOK = 16896, M_PR = 16384, M_ALL = 18944, DM = 1024, NPROJ = 5376;
constexpr float EPS = 1e-6f;
constexpr int LDS_BYTES = 147456;

constexpr size_t OUT_Y = 0, OUT_GLAP = 17301504, OUT_RETP = 17563648, OUT_MK = 17825792, OUT_MV = 19922944, OUT_GLAS = 22020096, OUT_RETS = 26214400;

constexpr size_t al256(size_t x) { return (x + 255) & ~(size_t)255; }
constexpr size_t OFF_A0 = 0;
constexpr size_t OFF_SS0 = al256(OFF_A0 + (size_t)M_ALL * DM * 2);
constexpr size_t OFF_SS1 = al256(OFF_SS0 + (size_t)M_ALL * 4);
constexpr size_t OFF_SS2 = OFF_SS1 + (size_t)M_TOK * 4;
constexpr size_t OFF_WTIN = al256(OFF_SS2 + (size_t)M_TOK * 4);
constexpr size_t OFF_WTKV = OFF_WTIN + (size_t)NPROJ * DM * 2;
constexpr size_t OFF_WTP = OFF_WTKV + (size_t)2048 * DM * 2;
constexpr size_t OFF_WTO = OFF_WTP + (size_t)DM * DM * 2;
constexpr size_t OFF_WTXQ = OFF_WTO + (size_t)DM * DM * 2;
constexpr size_t OFF_WTXO = OFF_WTXQ + (size_t)DM * DM * 2;
constexpr size_t OFF_WTPQ = OFF_WTXO + (size_t)DM * DM * 2;
constexpr size_t OFF_SKB = OFF_WTPQ + (size_t)2048 * DM * 2;
constexpr size_t OFF_UB = OFF_SKB + (size_t)8 * 2 * 128 * 128 * 2;
constexpr size_t OFF_VB = OFF_UB + (size_t)16384 * DM;
constexpr size_t OFF_PROJ = OFF_VB + (size_t)16384 * DM;
constexpr size_t OFF_LOGA = OFF_PROJ + (size_t)M_TOK * NPROJ * 2;
constexpr size_t OFF_KB = OFF_LOGA + (size_t)M_TOK * 256 * 4;
constexpr size_t OFF_VTB = OFF_KB + (size_t)2048 * DM * 2;
constexpr size_t OFF_X = OFF_VTB + (size_t)2048 * DM * 2;
constexpr size_t OFF_A2 = OFF_X + (size_t)M_TOK * DM * 4;
constexpr size_t OFF_SSP1 = OFF_A2 + (size_t)M_TOK * DM * 2;
constexpr size_t OFF_SSP2 = OFF_SSP1 + (size_t)16 * M_TOK * 4;
constexpr size_t OFF_BAR = OFF_SSP2 + (size_t)16 * M_TOK * 4;
constexpr size_t WS_END = OFF_BAR + 16384;
constexpr size_t OFF_H1B = OFF_PROJ;
constexpr size_t OFF_Q = OFF_H1B + (size_t)M_TOK * DM * 2;
constexpr size_t OFF_AO = OFF_Q + (size_t)M_TOK * DM * 2;
constexpr size_t OFF_H2B = OFF_AO + (size_t)M_TOK * DM * 2;
constexpr size_t OFF_PQ = OFF_PROJ;

struct Params { const float* in[28]; float* out; unsigned char* ws; };
#ifndef PHMASK
#define PHMASK 0xFFFF
#endif
#define PH(k) if constexpr ((PHMASK >> (k)) & 1)

typedef __bf16 bf16v2_t __attribute__((ext_vector_type(2)));
__device__ __forceinline__ unsigned cvt_pk_bf16(float lo, float hi) { const f32x2 v = {lo, hi}; return __builtin_bit_cast(unsigned, __builtin_convertvector(v, bf16v2_t)); }
__device__ __forceinline__ float bflo(unsigned u) { return __uint_as_float(u << 16); }
__device__ __forceinline__ float bfhi(unsigned u) { return __uint_as_float(u & 0xffff0000u); }
__device__ __forceinline__ float bf2f(bf16_t b) { return __uint_as_float(((unsigned)b) << 16); }
__device__ __forceinline__ float wave_sum(float v) {
#pragma unroll
    for (int o = 32; o > 0; o >>= 1) v += __shfl_xor(v, o);
    return v;
}
__device__ __forceinline__ float sigmoidf_(float v) { return __builtin_amdgcn_rcpf(1.0f + __expf(-v)); }

namespace pg8 {
constexpr int BM = 256, BK = 64, HALF = 128, HTB = HALF * BK * 2, STAGE_BYTES = 8 * HTB, NXCD = 8, WGM = 8;
__device__ __forceinline__ int lds_byte(int r, int c) { const int st = (r >> 4) * 2 + (c >> 5), rr = r & 15, cc = c & 31, ob = rr * 64 + cc * 2; return st * 1024 + (ob ^ (((ob >> 9) & 1) << 5)); }
__device__ __forceinline__ void stage_rc(int b, int& R, int& C) { const int st = b / 1024, sb = b % 1024, swz = sb ^ (((sb >> 9) & 1) << 5); R = (st >> 1) * 16 + swz / 64; C = (st & 1) * 32 + (swz % 64) / 2; }

struct Unit { int pm, pn, job; };
struct Sched {
    const bf16_t* A0; const bf16_t* B0; const bf16_t* A1; const bf16_t* B1;
    int nM0, nN0, n0, nM1, nN1, n1, G, c;
    __device__ __forceinline__ void init(const bf16_t* a0, const bf16_t* b0, int M0, int N0, const bf16_t* a1, const bf16_t* b1, int M1, int N1, int G_, int c_) {
        A0 = a0; B0 = b0; A1 = a1; B1 = b1; nM0 = M0 / BM; nN0 = N0 / BM; n0 = nM0 * nN0; nM1 = M1 / BM; nN1 = N1 / BM; n1 = nM1 * nN1; G = G_; c = c_; }
    __device__ __forceinline__ void map(int wgid, int nwg, int nM, int nN, Unit& u) const {
        { const int q = nwg / NXCD, r = nwg % NXCD, xcd = wgid % NXCD, off = wgid / NXCD; wgid = (xcd < r ? xcd * (q + 1) : r * (q + 1) + (xcd - r) * q) + off; }
        const int nig = WGM * nN, gid = wgid / nig, fm = gid * WGM, gsz = (nM - fm) < WGM ? (nM - fm) : WGM;
        u.pm = fm + ((wgid % nig) % gsz); u.pn = (wgid % nig) / gsz;
    }
    __device__ __forceinline__ bool next(int i, Unit& u) const {
        int L = i * G + c;
        if (L < n0) { map(L, n0, nM0, nN0, u); u.job = 0; return true; }
        L -= n0;
        if (L < n1) { map(L, n1, nM1, nN1, u); u.job = 1; return true; }
        return false;
    }
    __device__ __forceinline__ const char* aptr(const Unit& u, size_t tstep) const { return (const char*)(u.job ? A1 : A0) + (size_t)u.pm * tstep; }
    __device__ __forceinline__ const char* bptr(const Unit& u, size_t tstep) const { return (const char*)(u.job ? B1 : B0) + (size_t)u.pn * tstep; }
};

template <class Epi>
__device__ __forceinline__ void gemm_phase(LAS unsigned char* lds, const int K, const Sched& S, const Epi& E) {
    int tid_ = threadIdx.x; asm volatile("" : "+v"(tid_)); const int tid = tid_, wid = __builtin_amdgcn_readfirstlane(tid >> 6), lane = tid & 63, wr = wid >> 2, wc = wid & 3, fr = lane & 15, fq = lane >> 4;
    const int nt = K / BK;
    unsigned voffA[2];
#pragma unroll
    for (int i = 0; i < 2; ++i) { int R, C; stage_rc(tid * 16 + i * 8192, R, C); voffA[i] = (unsigned)(R * K + C) * 2u; }
    const size_t kstep = (size_t)(BK * 2);
    const size_t hstep = (size_t)HALF * K * 2;
    const size_t tstep = 2 * hstep;
    const unsigned ldsw = (unsigned)wid * 1024u;
    const int aoff = lds_byte(wr * 64 + fr, fq * 8), boff = lds_byte(wc * 32 + fr, fq * 8);
#define PG8_SA(b, h) (((b) * 2 + (h)) * HTB)
#define PG8_SB(b, h) ((4 + (b) * 2 + (h)) * HTB)
#define PG8_STAGE(bufoff, gbase) do { _Pragma("unroll") for (int _i = 0; _i < 2; ++_i) \
        __builtin_amdgcn_global_load_lds((const unsigned*)((const char*)(gbase) + voffA[_i]), (LAS unsigned*)(lds + (bufoff) + ldsw + _i * 8192), 16, 0, 0); } while (0)
#define PG8_LDA(dst, b, h) do { _Pragma("unroll") for (int m = 0; m < 4; ++m) _Pragma("unroll") for (int k = 0; k < 2; ++k) dst[m][k] = *(const LAS bf16x8*)(lds + PG8_SA(b, h) + aoff + m * 2048 + k * 1024); } while (0)
#define PG8_LDB(dst, b, h) do { _Pragma("unroll") for (int n = 0; n < 2; ++n) _Pragma("unroll") for (int k = 0; k < 2; ++k) dst[n][k] = *(const LAS bf16x8*)(lds + PG8_SB(b, h) + boff + n * 2048 + k * 1024); } while (0)
#define PG8_MMA(ai, bj, At, Bt) do { __builtin_amdgcn_s_setprio(1); _Pragma("unroll") for (int m = 0; m < 4; ++m) _Pragma("unroll") for (int n = 0; n < 2; ++n) _Pragma("unroll") for (int k = 0; k < 2; ++k) \
        acc[ai][bj][m][n] = __builtin_amdgcn_mfma_f32_16x16x32_bf16(Bt[n][k], At[m][k], acc[ai][bj][m][n], 0, 0, 0); __builtin_amdgcn_s_setprio(0); } while (0)
#define PG8_WAIT_V(n) asm volatile("s_waitcnt vmcnt(" #n ")" ::: "memory")
#define PG8_WAIT_L(n) asm volatile("s_waitcnt lgkmcnt(" #n ")" ::: "memory")
#define PG8_BAR __builtin_amdgcn_s_barrier()
#define PG8_SCHED __builtin_amdgcn_sched_barrier(0)
    Unit cur, nxt; int ui = 0;
    if (!S.next(0, cur)) return;
    f32x4 acc[2][2][4][2];
#pragma unroll
    for (int a = 0; a < 2; ++a)
#pragma unroll
        for (int b = 0; b < 2; ++b)
#pragma unroll
            for (int m = 0; m < 4; ++m)
#pragma unroll
                for (int n = 0; n < 2; ++n) acc[a][b][m][n] = (f32x4){0.f, 0.f, 0.f, 0.f};
    bf16x8 At[4][2], B0[2][2], B1[2][2];
    const char* cA = S.aptr(cur, tstep); const char* cB = S.bptr(cur, tstep);
    PG8_STAGE(PG8_SB(0, 0), cB); PG8_STAGE(PG8_SA(0, 0), cA); PG8_STAGE(PG8_SB(0, 1), cB + hstep); PG8_STAGE(PG8_SA(0, 1), cA + hstep);
    if (wr == 1) PG8_BAR;
    PG8_WAIT_V(4); PG8_BAR;
    PG8_STAGE(PG8_SB(1, 0), cB + kstep); PG8_STAGE(PG8_SA(1, 0), cA + kstep); PG8_STAGE(PG8_SB(1, 1), cB + hstep + kstep);
    PG8_WAIT_V(6); PG8_BAR;
    for (;;) {
        const bool has_next = S.next(ui + 1, nxt);
        const char* nA = has_next ? S.aptr(nxt, tstep) : cA; const char* nB = has_next ? S.bptr(nxt, tstep) : cB;
        for (int hf = 0; hf < (Epi::HAS_MID ? 2 : 1); ++hf) {
        const int t_lo = Epi::HAS_MID ? hf * (nt / 2) : 0, t_hi = Epi::HAS_MID ? (hf + 1) * (nt / 2) : nt;
        if constexpr (Epi::HAS_MID) { if (hf == 1) { E.mid(acc, cur, wr, wc, fr, fq); PG8_SCHED; } }
#pragma unroll 1
        for (int t = t_lo; t < t_hi; t += 2) {
            const bool last = (t == nt - 2);
            const char* a1 = cA + (size_t)(t + 1) * kstep;
            const char* a2 = last ? nA : cA + (size_t)(t + 2) * kstep; const char* b2 = last ? nB : cB + (size_t)(t + 2) * kstep;
            const char* a3 = a2 + kstep; const char* b3 = b2 + kstep;
            PG8_LDB(B0, 0, 0); PG8_SCHED; PG8_LDA(At, 0, 0); PG8_STAGE(PG8_SA(1, 1), a1 + hstep);
            PG8_WAIT_L(8); PG8_BAR; PG8_WAIT_L(0); PG8_MMA(0, 0, At, B0); PG8_BAR; PG8_SCHED;
            PG8_LDB(B1, 0, 1); PG8_STAGE(PG8_SB(0, 0), b2);
            PG8_BAR; PG8_WAIT_L(0); PG8_MMA(0, 1, At, B1); PG8_BAR;
            PG8_LDA(At, 0, 1); PG8_STAGE(PG8_SA(0, 0), a2);
            PG8_BAR; PG8_WAIT_L(0); PG8_MMA(1, 0, At, B0); PG8_BAR; PG8_SCHED;
            PG8_STAGE(PG8_SB(0, 1), b2 + hstep);
            PG8_WAIT_V(6); PG8_BAR; PG8_MMA(1, 1, At, B1); PG8_BAR;
            PG8_LDB(B0, 1, 0); PG8_SCHED; PG8_LDA(At, 1, 0); PG8_STAGE(PG8_SA(0, 1), a2 + hstep);
            PG8_WAIT_L(8); PG8_BAR; PG8_WAIT_L(0); PG8_MMA(0, 0, At, B0); PG8_BAR; PG8_SCHED;
            PG8_LDB(B1, 1, 1); PG8_STAGE(PG8_SB(1, 0), b3);
            PG8_BAR; PG8_WAIT_L(0); PG8_MMA(0, 1, At, B1); PG8_BAR;
            PG8_LDA(At, 1, 1); PG8_STAGE(PG8_SA(1, 0), a3);
            PG8_BAR; PG8_WAIT_L(0); PG8_MMA(1, 0, At, B0); PG8_BAR; PG8_SCHED;
            PG8_STAGE(PG8_SB(1, 1), b3 + hstep);
            PG8_WAIT_V(6); PG8_BAR; PG8_MMA(1, 1, At, B1); PG8_BAR;
        }
        }
        E(acc, cur, wr, wc, fr, fq);
        if (!has_next) break;
#pragma unroll
        for (int a = 0; a < 2; ++a)
#pragma unroll
            for (int b = 0; b < 2; ++b)
#pragma unroll
                for (int m = 0; m < 4; ++m)
#pragma unroll
                    for (int n = 0; n < 2; ++n) acc[a][b][m][n] = (f32x4){0.f, 0.f, 0.f, 0.f};
        cur = nxt; cA = nA; cB = nB; ++ui;
    }
    PG8_WAIT_V(0);
    if (wr == 0) PG8_BAR;
    PG8_BAR;
#undef PG8_SA
#undef PG8_SB
#undef PG8_STAGE
#undef PG8_LDA
#undef PG8_LDB
#undef PG8_MMA
#undef PG8_WAIT_V
#undef PG8_WAIT_L
#undef PG8_BAR
#undef PG8_SCHED
}
}

typedef f32x4 AccT[2][2][4][2];
#define EPI_LOOP_ROWS for (int ai = 0; ai < 2; ++ai) _Pragma("unroll") for (int m = 0; m < 4; ++m)
#define EPI_LOOP_COLS for (int bj = 0; bj < 2; ++bj) _Pragma("unroll") for (int n = 0; n < 2; ++n)

struct EpiProj {
    static constexpr bool HAS_MID = false;
    const float* ss0; const float* b_a; bf16_t* proj; float* loga; float* out; bf16_t* kb; bf16_t* vtb;
    __device__ __forceinline__ void operator()(const AccT& acc, const pg8::Unit& u, int wr, int wc, int fr, int fq) const {
        const int row0 = u.pm * 256 + wr * 64 + fr, col0 = u.pn * 256 + wc * 32 + 4 * fq;
        if (u.job == 0) {
            const int pn = u.pn;
            const int kind = (pn == 4) ? 3 : ((pn == 5 || pn == 6 || pn == 11 || pn == 12) ? 1 : (pn >= 13 ? 2 : 0));
            const float sc = (pn == 0 || pn == 8) ? 0.125f : 1.0f;
            float rsv[2][4];
#pragma unroll
            EPI_LOOP_ROWS rsv[ai][m] = ss0[row0 + ai * 128 + m * 16];
#pragma unroll
            EPI_LOOP_ROWS {
                const int row = row0 + ai * 128 + m * 16;
                const float rs = rsqrtf(rsv[ai][m] * (1.0f / 1024.0f) + EPS) * sc;
#pragma unroll
                EPI_LOOP_COLS {
                    const int col = col0 + bj * 128 + n * 16;
                    f32x4 v = acc[ai][bj][m][n] * rs;
                    if (kind == 3) {
                        const f32x4 bb = *(const f32x4*)(b_a + (col - 1024));
                        f32x4 o;
#pragma unroll
                        for (int j = 0; j < 4; ++j) { const float z = v[j] + bb[j]; o[j] = (fminf(z, 0.f) - __logf(1.0f + __expf(-fabsf(z)))) * (1.0f / 16.0f); }
                        *(f32x4*)(loga + (size_t)row * 256 + (col - 1024)) = o;
                    } else {
                        if (kind == 1) {
#pragma unroll
                            for (int j = 0; j < 4; ++j) v[j] = v[j] * sigmoidf_(v[j]);
                        } else if (kind == 2) {
#pragma unroll
                            for (int j = 0; j < 4; ++j) v[j] = sigmoidf_(v[j]);
                        }
                        u32x2 w; w.x = cvt_pk_bf16(v[0], v[1]); w.y = cvt_pk_bf16(v[2], v[3]);
                        *(u32x2*)(proj + (size_t)row * NPROJ + col) = w;
                    }
                }
            }
        } else {
            float rsv[2][4];
#pragma unroll
            EPI_LOOP_ROWS rsv[ai][m] = ss0[M_TOK + row0 + ai * 128 + m * 16];
#pragma unroll
            EPI_LOOP_ROWS {
                const int row = row0 + ai * 128 + m * 16;
                const float rs = rsqrtf(rsv[ai][m] * (1.0f / 1024.0f) + EPS);
#pragma unroll
                EPI_LOOP_COLS {
                    const int col = col0 + bj * 128 + n * 16;
                    const f32x4 v = acc[ai][bj][m][n] * rs;
                    if (col < 1024) {
                        *(f32x4*)(out + OUT_MK + (size_t)row * 1024 + col) = v;
                        u32x2 w; w.x = cvt_pk_bf16(v[0], v[1]); w.y = cvt_pk_bf16(v[2], v[3]);
                        *(u32x2*)(kb + (size_t)row * 1024 + col) = w;
                    } else {
                        const int c = col - 1024;
                        *(f32x4*)(out + OUT_MV + (size_t)row * 1024 + c) = v;
                        const int b = row >> 8, mem = row & 255;
                        const unsigned w0 = cvt_pk_bf16(v[0], v[1]), w1 = cvt_pk_bf16(v[2], v[3]);
                        bf16_t* vt = vtb + ((size_t)b * 1024 + c) * 256 + mem;
                        vt[0] = (bf16_t)(w0 & 0xffff); vt[256] = (bf16_t)(w0 >> 16); vt[512] = (bf16_t)(w1 & 0xffff); vt[768] = (bf16_t)(w1 >> 16);
                    }
                }
            }
        }
    }
};

struct EpiMerge {
    static constexpr bool HAS_MID = true;
    const bf16_t* proj; bf16_t* mrg;
    __device__ __forceinline__ void mid(AccT& acc, const pg8::Unit& u, int wr, int wc, int fr, int fq) const {
        const int row0 = u.pm * 256 + wr * 64 + fr, col0 = u.pn * 256 + wc * 32 + 4 * fq;
#pragma unroll
        for (int ai = 0; ai < 2; ++ai) {
            u32x2 a[4][2][2], b[4][2][2];
#pragma unroll
            for (int m = 0; m < 4; ++m) {
                unsigned roff = (unsigned)(row0 + ai * 128 + m * 16) * (unsigned)NPROJ + (unsigned)col0;
                asm volatile("" : "+v"(roff));
                const bf16_t* rp = proj + roff;
#pragma unroll
                EPI_LOOP_COLS { a[m][bj][n] = *(const u32x2*)(rp + 3328 + bj * 128 + n * 16); b[m][bj][n] = *(const u32x2*)(rp + 4352 + bj * 128 + n * 16); }
            }
#pragma unroll
            for (int m = 0; m < 4; ++m) {
#pragma unroll
                EPI_LOOP_COLS {
                    const u32x2 av = a[m][bj][n], bv = b[m][bj][n];
                    f32x4 r;
                    r[0] = bflo(av.x) * __builtin_amdgcn_rcpf(bflo(bv.x)); r[1] = bfhi(av.x) * __builtin_amdgcn_rcpf(bfhi(bv.x));
                    r[2] = bflo(av.y) * __builtin_amdgcn_rcpf(bflo(bv.y)); r[3] = bfhi(av.y) * __builtin_amdgcn_rcpf(bfhi(bv.y));
                    acc[ai][bj][m][n] *= r;
                }
                asm volatile("" : "+v"(acc[ai][0][m][0]), "+v"(acc[ai][0][m][1]), "+v"(acc[ai][1][m][0]), "+v"(acc[ai][1][m][1]) :: "memory");
            }
        }
    }
    __device__ __forceinline__ void operator()(const AccT& acc, const pg8::Unit& u, int wr, int wc, int fr, int fq) const {
        const int row0 = u.pm * 256 + wr * 64 + fr, col0 = u.pn * 256 + wc * 32 + 4 * fq;
        u32x2 b[2][4][2][2];
#pragma unroll
        EPI_LOOP_ROWS {
            const bf16_t* rp = proj + (size_t)(row0 + ai * 128 + m * 16) * NPROJ + 4352 + col0;
#pragma unroll
            EPI_LOOP_COLS b[ai][m][bj][n] = *(const u32x2*)(rp + bj * 128 + n * 16);
        }
#pragma unroll
        EPI_LOOP_ROWS {
            const int row = row0 + ai * 128 + m * 16;
#pragma unroll
            EPI_LOOP_COLS {
                const int col = col0 + bj * 128 + n * 16;
                const u32x2 bv = b[ai][m][bj][n];
                const f32x4 v = acc[ai][bj][m][n];
                u32x2 w; w.x = cvt_pk_bf16(v[0] * bflo(bv.x), v[1] * bfhi(bv.x)); w.y = cvt_pk_bf16(v[2] * bflo(bv.y), v[3] * bfhi(bv.y));
                *(u32x2*)(mrg + (size_t)row * 1024 + col) = w;
            }
        }
    }
};

struct EpiResid {
    static constexpr bool HAS_MID = false;
    const bf16_t* base; bf16_t* HB; float* SS;
    __device__ __forceinline__ void operator()(const AccT& acc, const pg8::Unit& u, int wr, int wc, int fr, int fq) const {
        const int row0 = u.pm * 256 + wr * 64 + fr, col0 = u.pn * 256 + wc * 32 + 4 * fq;
        u32x2 bv[2][4][2][2];
#pragma unroll
        EPI_LOOP_ROWS {
            const bf16_t* rp = base + (size_t)(row0 + ai * 128 + m * 16) * 1024 + col0;
#pragma unroll
            EPI_LOOP_COLS bv[ai][m][bj][n] = *(const u32x2*)(rp + bj * 128 + n * 16);
        }
#pragma unroll
        EPI_LOOP_ROWS {
            const int row = row0 + ai * 128 + m * 16;
            float s = 0.f;
#pragma unroll
            EPI_LOOP_COLS {
                const int col = col0 + bj * 128 + n * 16;
                const u32x2 b = bv[ai][m][bj][n];
                f32x4 v = acc[ai][bj][m][n];
                v[0] += bflo(b.x); v[1] += bfhi(b.x); v[2] += bflo(b.y); v[3] += bfhi(b.y);
                s += (v[0] * v[0] + v[1] * v[1]) + (v[2] * v[2] + v[3] * v[3]);
                u32x2 w; w.x = cvt_pk_bf16(v[0], v[1]); w.y = cvt_pk_bf16(v[2], v[3]);
                *(u32x2*)(HB + (size_t)row * 1024 + col) = w;
            }
            s += __shfl_xor(s, 16); s += __shfl_xor(s, 32);
            if (fq == 0) SS[(size_t)(u.pn * 4 + wc) * M_TOK + row] = s;
        }
    }
};

struct EpiScale {
    static constexpr bool HAS_MID = false;
    const float* SS; bf16_t* O; int ldo; float sc;
    __device__ __forceinline__ void operator()(const AccT& acc, const pg8::Unit& u, int wr, int wc, int fr, int fq) const {
        const int row0 = u.pm * 256 + wr * 64 + fr, col0 = u.pn * 256 + wc * 32 + 4 * fq;
        float part[2][4];
#pragma unroll
        EPI_LOOP_ROWS {
            const int row = row0 + ai * 128 + m * 16;
            float t = 0.f;
#pragma unroll
            for (int q = 0; q < 4; ++q) t += SS[(size_t)(fq * 4 + q) * M_TOK + row];
            part[ai][m] = t;
        }
#pragma unroll
        EPI_LOOP_ROWS {
            const int row = row0 + ai * 128 + m * 16;
            float ssum = part[ai][m];
            ssum += __shfl_xor(ssum, 16); ssum += __shfl_xor(ssum, 32);
            const float rs = rsqrtf(ssum * (1.0f / 1024.0f) + EPS) * sc;
#pragma unroll
            EPI_LOOP_COLS {
                const int col = col0 + bj * 128 + n * 16;
                const f32x4 v = acc[ai][bj][m][n] * rs;
                u32x2 w; w.x = cvt_pk_bf16(v[0], v[1]); w.y = cvt_pk_bf16(v[2], v[3]);
                *(u32x2*)(O + (size_t)row * ldo + col) = w;
            }
        }
    }
};

struct TJob { const float* src; int ld, c0, tn, K; bf16_t* dst; int Kd, kofs; const float* gain; };
__device__ __forceinline__ void tjob_get(const Params& p, int T, TJob& j, int& tile) {
    unsigned char* ws = p.ws;
    if (T < 256) { j = TJob{p.in[8], 5136, 0, 16, 1024, (bf16_t*)(ws + OFF_WTIN), 1024, 0, p.in[7]}; tile = T; return; }
    T -= 256;
    if (T < 1024) { j = TJob{p.in[8], 5136, 1040, 64, 1024, (bf16_t*)(ws + OFF_WTIN) + (size_t)1280 * 1024, 1024, 0, p.in[7]}; tile = T; return; }
    T -= 1024;
    if (T < 128) { j = TJob{p.in[13], 1024, 0, 16, 512, (bf16_t*)(ws + OFF_WTP), 1024, 0, nullptr}; tile = T; return; }
    T -= 128;
    if (T < 128) { j = TJob{p.in[14], 1024, 0, 16, 512, (bf16_t*)(ws + OFF_WTP), 1024, 512, nullptr}; tile = T; return; }
    T -= 128;
    if (T < 256) { j = TJob{p.in[15], 1024, 0, 16, 1024, (bf16_t*)(ws + OFF_WTO), 1024, 0, nullptr}; tile = T; return; }
    T -= 256;
    if (T < 256) { j = TJob{p.in[18], 1024, 0, 16, 1024, (bf16_t*)(ws + OFF_WTXQ), 1024, 0, p.in[16]}; tile = T; return; }
    T -= 256;
    if (T < 256) { j = TJob{p.in[19], 1024, 0, 16, 1024, (bf16_t*)(ws + OFF_WTKV), 1024, 0, p.in[17]}; tile = T; return; }
    T -= 256;
    if (T < 256) { j = TJob{p.in[20], 1024, 0, 16, 1024, (bf16_t*)(ws + OFF_WTKV) + (size_t)1024 * 1024, 1024, 0, p.in[17]}; tile = T; return; }
    T -= 256;
    if (T < 256) { j = TJob{p.in[21], 1024, 0, 16, 1024, (bf16_t*)(ws + OFF_WTXO), 1024, 0, nullptr}; tile = T; return; }
    T -= 256;
    j = TJob{p.in[23], 2048, 0, 32, 1024, (bf16_t*)(ws + OFF_WTPQ), 1024, 0, p.in[22]}; tile = T;
}
constexpr int N_TTILES = 256 + 1024 + 128 + 128 + 256 * 5 + 512;

__device__ void phase_prep(const Params& p, LAS unsigned char* lds) {
    int tid_ = threadIdx.x; asm volatile("" : "+v"(tid_)); const int tid = tid_, lane = tid & 63, wid = tid >> 6;
    const int gw = blockIdx.x * 8 + wid, nw = gridDim.x * 8;
    const size_t gt = (size_t)blockIdx.x * NTHR + tid, ngt = (size_t)gridDim.x * NTHR;
    unsigned char* ws = p.ws;
    {
        bf16_t* A0 = (bf16_t*)(ws + OFF_A0); float* ss0 = (float*)(ws + OFF_SS0);
        for (int r = gw; r < M_ALL; r += nw) {
            const float* src = r < M_PR ? p.in[0] + (size_t)r * 1024 : (r < M_TOK ? p.in[1] + (size_t)(r - M_PR) * 1024 : p.in[2] + (size_t)(r - M_TOK) * 1024);
            float s = 0.f;
#pragma unroll
            for (int i = 0; i < 4; ++i) {
                const f32x4 v = *(const f32x4*)(src + i * 256 + lane * 4);
                s += (v[0] * v[0] + v[1] * v[1]) + (v[2] * v[2] + v[3] * v[3]);
                u32x2 w; w.x = cvt_pk_bf16(v[0], v[1]); w.y = cvt_pk_bf16(v[2], v[3]);
                *(u32x2*)(A0 + (size_t)r * 1024 + i * 256 + lane * 4) = w;
            }
            s = wave_sum(s);
            if (lane == 0) ss0[r] = s;
        }
    }
    { float* z = (float*)(ws + OFF_SS1); for (size_t i = gt; i < (size_t)2 * M_TOK; i += ngt) z[i] = 0.f; }
    {
        const size_t n_sk = (size_t)8 * 2 * 128 * 128 / 8;
        for (size_t k = gt; k < n_sk; k += ngt) {
            const float* src = p.in[24]; bf16_t* dst = (bf16_t*)(ws + OFF_SKB);
            const f32x4 a = *(const f32x4*)(src + k * 8), b = *(const f32x4*)(src + k * 8 + 4);
            u32x4 w; w.x = cvt_pk_bf16(a[0], a[1]); w.y = cvt_pk_bf16(a[2], a[3]); w.z = cvt_pk_bf16(b[0], b[1]); w.w = cvt_pk_bf16(b[2], b[3]);
            *(u32x4*)(dst + k * 8) = w;
        }
        const size_t n_u = (size_t)16384 * 1024 / 16;
        for (size_t i = gt; i < 2 * n_u; i += ngt) {
            const bool isv = i >= n_u; const size_t k = isv ? i - n_u : i;
            const float* src = (isv ? p.in[26] : p.in[25]) + k * 16; unsigned char* dst = ws + (isv ? OFF_VB : OFF_UB) + k * 16;
            const float sc = isv ? 64.0f : 1024.0f;
            u32x4 w;
#pragma unroll
            for (int q = 0; q < 4; ++q) {
                f32x4 a = *(const f32x4*)(src + q * 4) * sc;
#pragma unroll
                for (int e = 0; e < 4; ++e) a[e] = fminf(fmaxf(a[e], -448.0f), 448.0f);
                int t = 0;
                t = __builtin_amdgcn_cvt_pk_fp8_f32(a[0], a[1], t, false);
                t = __builtin_amdgcn_cvt_pk_fp8_f32(a[2], a[3], t, true);
                w[q] = (unsigned)t;
            }
            *(u32x4*)dst = w;
        }
    }
    {
        const float* w_in = p.in[8]; const float* w_a2 = p.in[9]; const float* g = p.in[7];
        bf16_t* dst = (bf16_t*)(ws + OFF_WTIN) + (size_t)1024 * 1024;
        for (size_t i = gt; i < (size_t)256 * 128; i += ngt) {
            const int j = (int)(i >> 7), k0 = (int)(i & 127) * 8;
            float wa[16];
#pragma unroll
            for (int r = 0; r < 16; ++r) wa[r] = w_a2[r * 256 + j];
            float o[8];
#pragma unroll
            for (int e = 0; e < 8; ++e) {
                const float* wr_ = w_in + (size_t)(k0 + e) * 5136 + 1024;
                float s = 0.f;
#pragma unroll
                for (int r4 = 0; r4 < 4; ++r4) { const f32x4 v = *(const f32x4*)(wr_ + r4 * 4); s += v[0] * wa[r4 * 4] + v[1] * wa[r4 * 4 + 1] + v[2] * wa[r4 * 4 + 2] + v[3] * wa[r4 * 4 + 3]; }
                o[e] = s * g[k0 + e];
            }
            u32x4 w; w.x = cvt_pk_bf16(o[0], o[1]); w.y = cvt_pk_bf16(o[2], o[3]); w.z = cvt_pk_bf16(o[4], o[5]); w.w = cvt_pk_bf16(o[6], o[7]);
            *(u32x4*)(dst + (size_t)j * 1024 + k0) = w;
        }
    }
    {
        LAS float* tl = (LAS float*)lds;
        for (int T = blockIdx.x; T < N_TTILES; T += gridDim.x) {
            TJob j; int tile; tjob_get(p, T, j, tile);
            const int tk = tile / j.tn, tnn = tile % j.tn, k0 = tk * 64, n0 = tnn * 64;
            {
                const int kr = tid >> 4, nc = (tid & 15) * 4;
#pragma unroll
                for (int pp = 0; pp < 2; ++pp) {
                    const int k = k0 + kr + 32 * pp;
                    f32x4 v = *(const f32x4*)(j.src + (size_t)k * j.ld + j.c0 + n0 + nc);
                    if (j.gain) v *= j.gain[k];
                    LAS float* d = tl + (kr + 32 * pp) * 65 + nc;
                    d[0] = v[0]; d[1] = v[1]; d[2] = v[2]; d[3] = v[3];
                }
            }
            __syncthreads();
            {
                const int n = tid >> 3, kq = (tid & 7) * 8;
                float o[8];
#pragma unroll
                for (int e = 0; e < 8; ++e) o[e] = tl[(kq + e) * 65 + n];
                u32x4 w; w.x = cvt_pk_bf16(o[0], o[1]); w.y = cvt_pk_bf16(o[2], o[3]); w.z = cvt_pk_bf16(o[4], o[5]); w.w = cvt_pk_bf16(o[6], o[7]);
                *(u32x4*)(j.dst + (size_t)(n0 + n) * j.Kd + j.kofs + k0 + kq) = w;
            }
            __syncthreads();
        }
    }
}

#define MFMA16(a, b, c) __builtin_amdgcn_mfma_f32_16x16x32_bf16((a), (b), (c), 0, 0, 0)
__device__ __forceinline__ float scan64(float v, int lane) {
#pragma unroll
    for (int o = 1; o < 64; o <<= 1) { const float t = __shfl_up(v, o); if (lane >= o) v += t; }
    return v;
}
__device__ void phase_scan(const Params& p, LAS unsigned char* lds) {
    int tid_ = threadIdx.x; asm volatile("" : "+v"(tid_)); const int tid = tid_, lane = tid & 63, wid = tid >> 6, fr = lane & 15, fq = lane >> 4;
    const bf16_t* proj = (const bf16_t*)(p.ws + OFF_PROJ); const float* loga = (const float*)(p.ws + OFF_LOGA);
    float* omix = (float*)(p.ws + OFF_X);
    constexpr int P = 72;
    for (int u = blockIdx.x; u < 256; u += gridDim.x) {
        const int vs = u & 3, mx = (u >> 2) & 1, h = (u >> 3) & 3, b = u >> 5;
        const int qoff = (mx ? 1792 : 0) + h * 64, koff = (mx ? 2048 : 256) + h * 64, voff = (mx ? 2304 : 512) + h * 128 + vs * 32;
        const float lg = log1pf(-exp2f(-5.0f - (float)h));
        float inv[4];
#pragma unroll
        for (int e = 0; e < 4; ++e) inv[e] = exp2f(-(float)(4 * wid + e) * (13.287712379549449f / 32.0f));
        f32x4 sacc = (f32x4){0.f, 0.f, 0.f, 0.f};
        LAS bf16_t* QE = (LAS bf16_t*)lds; LAS bf16_t* KE = (LAS bf16_t*)(lds + 9216);
        LAS bf16_t* ATT = (LAS bf16_t*)(lds + 18432);
        LAS bf16_t* ST = (LAS bf16_t*)(lds + 27648);
        for (int i = tid; i < 32 * P; i += NTHR) ST[i] = 0;
        const int ct = wid >> 2, w4 = wid & 3;
        u32x2 rq0, rq1, rk0, rk1, rv; f32x4 rl0 = (f32x4){0.f, 0.f, 0.f, 0.f}, rl1 = rl0;
        u32x4 gq, gk, gv = (u32x4){0u, 0u, 0u, 0u}; f32x4 gl0 = (f32x4){0.f, 0.f, 0.f, 0.f}, gl1 = gl0;
#define SCAN_RAW(bi) (lds + 61440 + (bi) * 40960)
#define SCAN_STAGE_LOAD(ch) do { const size_t tb_ = (size_t)b * 2048 + (ch) * 64; \
            gq = *(const u32x4*)(proj + (tb_ + (tid >> 3)) * NPROJ + qoff + (tid & 7) * 8); gk = *(const u32x4*)(proj + (tb_ + (tid >> 3)) * NPROJ + koff + (tid & 7) * 8); \
            if (tid < 256) gv = *(const u32x4*)(proj + (tb_ + (tid >> 2)) * NPROJ + voff + (tid & 3) * 8); \
            if (!mx) { gl0 = *(const f32x4*)(loga + (tb_ + (tid >> 4)) * 256 + h * 64 + (tid & 15) * 4); gl1 = *(const f32x4*)(loga + (tb_ + 32 + (tid >> 4)) * 256 + h * 64 + (tid & 15) * 4); } } while (0)
#define SCAN_STAGE_WRITE(bi) do { LAS unsigned char* r_ = SCAN_RAW(bi); \
            *(LAS u32x4*)(r_ + (tid >> 3) * 144 + (tid & 7) * 16) = gq; *(LAS u32x4*)(r_ + 9216 + (tid >> 3) * 144 + (tid & 7) * 16) = gk; \
            if (tid < 256) *(LAS u32x4*)(r_ + 18432 + (tid >> 2) * 80 + (tid & 3) * 16) = gv; \
            if (!mx) { *(LAS f32x4*)(r_ + 23552 + (tid >> 4) * 272 + (tid & 15) * 16) = gl0; *(LAS f32x4*)(r_ + 23552 + (32 + (tid >> 4)) * 272 + (tid & 15) * 16) = gl1; } } while (0)
#define SCAN_READ_RAW(bi) do { const LAS unsigned char* r_ = SCAN_RAW(bi); \
            rq0 = *(const LAS u32x2*)(r_ + lane * 144 + 8 * wid); rq1 = *(const LAS u32x2*)(r_ + lane * 144 + 64 + 8 * wid); \
            rk0 = *(const LAS u32x2*)(r_ + 9216 + lane * 144 + 8 * wid); rk1 = *(const LAS u32x2*)(r_ + 9216 + lane * 144 + 64 + 8 * wid); \
            rv = *(const LAS u32x2*)(r_ + 18432 + lane * 80 + 8 * wid); \
            if (!mx) { rl0 = *(const LAS f32x4*)(r_ + 23552 + lane * 272 + 16 * wid); rl1 = *(const LAS f32x4*)(r_ + 23552 + lane * 272 + 128 + 16 * wid); } } while (0)
        SCAN_STAGE_LOAD(0); SCAN_STAGE_WRITE(0); SCAN_STAGE_LOAD(1);
        __syncthreads();
        for (int ch = 0; ch < 32; ++ch) {
            SCAN_READ_RAW(ch & 1);
            LAS unsigned char* buf = lds + 32256 + (ch & 1) * 14336;
            LAS bf16_t* KDT = (LAS bf16_t*)buf; LAS bf16_t* VT = (LAS bf16_t*)(buf + 9216); LAS float* DL = (LAS float*)(buf + 13824);
            {
                float qa[4] = {bflo(rq0.x), bfhi(rq0.x), bflo(rq0.y), bfhi(rq0.y)}, qb[4] = {bflo(rq1.x), bfhi(rq1.x), bflo(rq1.y), bfhi(rq1.y)};
                float ka[4] = {bflo(rk0.x), bfhi(rk0.x), bflo(rk0.y), bfhi(rk0.y)}, kb[4] = {bflo(rk1.x), bfhi(rk1.x), bflo(rk1.y), bfhi(rk1.y)};
                float ba[4], bb[4], la[4], lb[4];
                if (mx) {
                    const float pos = (float)(ch * 64 + lane);
#pragma unroll
                    for (int e = 0; e < 4; ++e) {
                        float sn, cs; sincosf(pos * inv[e], &sn, &cs);
                        const float q1 = qa[e], q2 = qb[e], k1 = ka[e], k2 = kb[e];
                        qa[e] = q1 * cs - q2 * sn; qb[e] = q1 * sn + q2 * cs; ka[e] = k1 * cs - k2 * sn; kb[e] = k1 * sn + k2 * cs;
                        ba[e] = bb[e] = (float)(lane + 1) * lg; la[e] = lb[e] = 64.0f * lg;
                    }
                } else {
#pragma unroll
                    for (int e = 0; e < 4; ++e) { ba[e] = scan64(rl0[e], lane); bb[e] = scan64(rl1[e], lane); la[e] = __shfl(ba[e], 63); lb[e] = __shfl(bb[e], 63); }
                }
                float qea[4], qeb[4], kea[4], keb[4];
#pragma unroll
                for (int e = 0; e < 4; ++e) {
                    qea[e] = qa[e] * __expf(ba[e]); qeb[e] = qb[e] * __expf(bb[e]);
                    kea[e] = ka[e] * __expf(-ba[e]); keb[e] = kb[e] * __expf(-bb[e]);
                    const float kda = ka[e] * __expf(la[e] - ba[e]), kdb = kb[e] * __expf(lb[e] - bb[e]);
                    KDT[(4 * wid + e) * P + lane] = (bf16_t)(cvt_pk_bf16(kda, 0.f) & 0xffff);
                    KDT[(32 + 4 * wid + e) * P + lane] = (bf16_t)(cvt_pk_bf16(kdb, 0.f) & 0xffff);
                    if (lane == 63) { DL[4 * wid + e] = __expf(la[e]); DL[32 + 4 * wid + e] = __expf(lb[e]); }
                }
                u32x2 w;
                w.x = cvt_pk_bf16(qea[0], qea[1]); w.y = cvt_pk_bf16(qea[2], qea[3]); *(LAS u32x2*)(QE + lane * P + 4 * wid) = w;
                w.x = cvt_pk_bf16(qeb[0], qeb[1]); w.y = cvt_pk_bf16(qeb[2], qeb[3]); *(LAS u32x2*)(QE + lane * P + 32 + 4 * wid) = w;
                w.x = cvt_pk_bf16(kea[0], kea[1]); w.y = cvt_pk_bf16(kea[2], kea[3]); *(LAS u32x2*)(KE + lane * P + 4 * wid) = w;
                w.x = cvt_pk_bf16(keb[0], keb[1]); w.y = cvt_pk_bf16(keb[2], keb[3]); *(LAS u32x2*)(KE + lane * P + 32 + 4 * wid) = w;
                VT[(4 * wid + 0) * P + lane] = (bf16_t)(rv.x & 0xffff); VT[(4 * wid + 1) * P + lane] = (bf16_t)(rv.x >> 16);
                VT[(4 * wid + 2) * P + lane] = (bf16_t)(rv.y & 0xffff); VT[(4 * wid + 3) * P + lane] = (bf16_t)(rv.y >> 16);
            }
            SCAN_STAGE_WRITE((ch + 1) & 1);
            { const int chn = (ch + 2 < 32) ? ch + 2 : 31; SCAN_STAGE_LOAD(chn); }
            __syncthreads();
            f32x4 oacc = (f32x4){0.f, 0.f, 0.f, 0.f};
            {
#pragma unroll
                for (int q = 0; q < 2; ++q) {
                    const int idx = wid * 2 + q, sb = idx >> 2, tb = idx & 3;
                    f32x4 a = (f32x4){0.f, 0.f, 0.f, 0.f};
                    if (sb <= tb) {
#pragma unroll
                        for (int ks = 0; ks < 2; ++ks) {
                            const bf16x8 A = *(const LAS bf16x8*)(KE + (sb * 16 + fr) * P + ks * 32 + fq * 8);
                            const bf16x8 B = *(const LAS bf16x8*)(QE + (tb * 16 + fr) * P + ks * 32 + fq * 8);
                            a = MFMA16(A, B, a);
                        }
                        const int tg = tb * 16 + fr, sg = sb * 16 + fq * 4;
#pragma unroll
                        for (int jj = 0; jj < 4; ++jj) if (sg + jj > tg) a[jj] = 0.f;
                    }
                    u32x2 w; w.x = cvt_pk_bf16(a[0], a[1]); w.y = cvt_pk_bf16(a[2], a[3]);
                    *(LAS u32x2*)(ATT + (tb * 16 + fr) * P + sb * 16 + fq * 4) = w;
                }
#pragma unroll
                for (int ks = 0; ks < 2; ++ks) {
#ifdef TEST_ST
                    const bf16x8 A = *(const LAS bf16x8*)(VT + (ct * 16 + fr) * P + ks * 32 + fq * 8);
#else
                    const bf16x8 A = *(const LAS bf16x8*)(ST + (ct * 16 + fr) * P + ks * 32 + fq * 8);
#endif
#ifdef TEST_ST
                    const bf16x8 B = *(const LAS bf16x8*)(KDT + (w4 * 16 + fr) * P + ks * 32 + fq * 8);
#else
                    const bf16x8 B = *(const LAS bf16x8*)(QE + (w4 * 16 + fr) * P + ks * 32 + fq * 8);
#endif
                    oacc = MFMA16(A, B, oacc);
                }
            }
            __syncthreads();
            {
                bf16x8 Av[2];
#pragma unroll
                for (int ks = 0; ks < 2; ++ks) Av[ks] = *(const LAS bf16x8*)(VT + (ct * 16 + fr) * P + ks * 32 + fq * 8);
#pragma unroll
                for (int ks = 0; ks < 2; ++ks) {
                    const bf16x8 B = *(const LAS bf16x8*)(ATT + (w4 * 16 + fr) * P + ks * 32 + fq * 8);
#ifndef NO_ATT
                    oacc = MFMA16(Av[ks], B, oacc);
#endif
                }
                const size_t tok = (size_t)b * 2048 + ch * 64 + w4 * 16 + fr;
                *(f32x4*)(omix + tok * 1024 + mx * 512 + h * 128 + vs * 32 + ct * 16 + fq * 4) = oacc;
                const float d = DL[w4 * 16 + fr];
                sacc *= d;
#pragma unroll
                for (int ks = 0; ks < 2; ++ks) {
                    const bf16x8 B = *(const LAS bf16x8*)(KDT + (w4 * 16 + fr) * P + ks * 32 + fq * 8);
                    sacc = MFMA16(Av[ks], B, sacc);
                }
                const unsigned w0 = cvt_pk_bf16(sacc[0], sacc[1]), w1 = cvt_pk_bf16(sacc[2], sacc[3]);
                LAS bf16_t* sp = ST + (ct * 16 + fq * 4) * P + w4 * 16 + fr;
                sp[0] = (bf16_t)(w0 & 0xffff); sp[P] = (bf16_t)(w0 >> 16); sp[2 * P] = (bf16_t)(w1 & 0xffff); sp[3 * P] = (bf16_t)(w1 >> 16);
            }
        }
        *(f32x4*)(p.out + (mx ? OUT_RETP : OUT_GLAP) + ((size_t)(b * 4 + h) * 64 + w4 * 16 + fr) * 128 + vs * 32 + ct * 16 + fq * 4) = sacc;
        __syncthreads();
#undef SCAN_RAW
#undef SCAN_STAGE_LOAD
#undef SCAN_STAGE_WRITE
#undef SCAN_READ_RAW
    }
    {
        LAS float* qv = (LAS float*)lds; LAS float* kv = qv + 256; LAS float* av = kv + 256; LAS float* red = av + 256;
        for (int su = blockIdx.x; su < 1024; su += gridDim.x) {
            const int mx = su & 1, h = (su >> 1) & 3, b = su >> 3;
            const int qoff = (mx ? 1792 : 0) + h * 64, koff = (mx ? 2048 : 256) + h * 64, voff = (mx ? 2304 : 512) + h * 128;
            if (tid < 256) {
                const int t = tid >> 6, k = tid & 63; const size_t tok = (size_t)M_PR + b * 4 + t; const bf16_t* base = proj + tok * NPROJ;
                float q, kk, a;
                if (mx) {
                    const int j = k & 31;
                    const float q1 = bf2f(base[qoff + j]), q2 = bf2f(base[qoff + 32 + j]), k1 = bf2f(base[koff + j]), k2 = bf2f(base[koff + 32 + j]);
                    const float ang = (float)(16384 + t) * exp2f(-(float)j * (13.287712379549449f / 32.0f));
                    float sn, cs; sincosf(ang, &sn, &cs);
                    if (k < 32) { q = q1 * cs - q2 * sn; kk = k1 * cs - k2 * sn; } else { q = q1 * sn + q2 * cs; kk = k1 * sn + k2 * cs; }
                    a = 1.0f - exp2f(-5.0f - (float)h);
                } else { q = bf2f(base[qoff + k]); kk = bf2f(base[koff + k]); a = __expf(loga[tok * 256 + h * 64 + k]); }
                qv[tid] = q; kv[tid] = kk; av[tid] = a;
            }
            __syncthreads();
            const int v = tid & 127, kg = tid >> 7;
            const float* sin_ = (mx ? p.in[4] : p.in[3]) + ((size_t)(b * 4 + h) * 64 + kg * 16) * 128 + v;
            float S[16];
#pragma unroll
            for (int i = 0; i < 16; ++i) S[i] = sin_[(size_t)i * 128];
#pragma unroll
            for (int t = 0; t < 4; ++t) {
                const float vt = bf2f(proj[((size_t)M_PR + b * 4 + t) * NPROJ + voff + v]);
                float part = 0.f;
#pragma unroll
                for (int i = 0; i < 16; ++i) { const int k = t * 64 + kg * 16 + i; S[i] = av[k] * S[i] + kv[k] * vt; part += qv[k] * S[i]; }
                red[(t * 4 + kg) * 128 + v] = part;
            }
            float* sout = p.out + (mx ? OUT_RETS : OUT_GLAS) + ((size_t)(b * 4 + h) * 64 + kg * 16) * 128 + v;
#pragma unroll
            for (int i = 0; i < 16; ++i) sout[(size_t)i * 128] = S[i];
            __syncthreads();
            {
                const int t = tid >> 7;
                const float o = (red[(t * 4 + 0) * 128 + v] + red[(t * 4 + 1) * 128 + v]) + (red[(t * 4 + 2) * 128 + v] + red[(t * 4 + 3) * 128 + v]);
                omix[((size_t)M_PR + b * 4 + t) * 1024 + mx * 512 + h * 128 + v] = o;
            }
            __syncthreads();
        }
    }
}

__device__ void phase_onorm(const Params& p) {
    int tid_ = threadIdx.x; asm volatile("" : "+v"(tid_)); const int tid = tid_, lane = tid & 63, wid = tid >> 6;
    const bf16_t* proj = (const bf16_t*)(p.ws + OFF_PROJ); const float* omix = (const float*)(p.ws + OFF_X); bf16_t* a2 = (bf16_t*)(p.ws + OFF_A2);
    for (int wt = blockIdx.x * 8 + wid; wt < M_TOK * 2; wt += gridDim.x * 8) {
        const int tok = wt >> 1, mx = wt & 1, c = lane * 8;
        const f32x4 o0 = *(const f32x4*)(omix + (size_t)tok * 1024 + mx * 512 + c), o1 = *(const f32x4*)(omix + (size_t)tok * 1024 + mx * 512 + c + 4);
        float ss = (o0[0] * o0[0] + o0[1] * o0[1]) + (o0[2] * o0[2] + o0[3] * o0[3]) + (o1[0] * o1[0] + o1[1] * o1[1]) + (o1[2] * o1[2] + o1[3] * o1[3]);
        ss += __shfl_xor(ss, 1); ss += __shfl_xor(ss, 2); ss += __shfl_xor(ss, 4); ss += __shfl_xor(ss, 8);
        const float r = rsqrtf(ss * (1.0f / 128.0f) + EPS);
        const float* g = (mx ? p.in[12] : p.in[11]) + c;
        const f32x4 g0 = *(const f32x4*)g, g1 = *(const f32x4*)(g + 4);
        const u32x4 gt = *(const u32x4*)(proj + (size_t)tok * NPROJ + (mx ? 2816 : 1280) + c);
        u32x4 w;
        w.x = cvt_pk_bf16(o0[0] * r * g0[0] * bflo(gt.x), o0[1] * r * g0[1] * bfhi(gt.x));
        w.y = cvt_pk_bf16(o0[2] * r * g0[2] * bflo(gt.y), o0[3] * r * g0[3] * bfhi(gt.y));
        w.z = cvt_pk_bf16(o1[0] * r * g1[0] * bflo(gt.z), o1[1] * r * g1[1] * bfhi(gt.z));
        w.w = cvt_pk_bf16(o1[2] * r * g1[2] * bflo(gt.w), o1[3] * r * g1[3] * bfhi(gt.w));
        *(u32x4*)(a2 + (size_t)tok * 1024 + mx * 512 + c) = w;
    }
}

__device__ void phase_attn(const Params& p, LAS unsigned char* lds) {
    int tid_ = threadIdx.x; asm volatile("" : "+v"(tid_)); const int tid = tid_, lane = tid & 63, wid = tid >> 6, fr = lane & 15, fq = lane >> 4;
    const bf16_t* Q = (const bf16_t*)(p.ws + OFF_Q); const bf16_t* KB = (const bf16_t*)(p.ws + OFF_KB); const bf16_t* VTB = (const bf16_t*)(p.ws + OFF_VTB);
    bf16_t* AO = (bf16_t*)(p.ws + OFF_AO);
    const bool sample_first = (blockIdx.x & 8) != 0;
#pragma unroll 1
    for (int part = 0; part < 2; ++part) {
    if ((part == 0) != sample_first) {
    constexpr int KP = 528;
    for (int du0 = blockIdx.x; du0 < 256; du0 += gridDim.x) {
        int du = du0;
        if (gridDim.x == 256) { const int xcd = du0 & 7, slot = du0 >> 3; du = (xcd * 4 + (slot >> 3)) * 8 + (slot & 7); }
        const int q8 = du & 7, h = (du >> 3) & 3, b = du >> 5;
        {
            const bf16_t* src = KB + (size_t)b * 256 * 1024 + h * 256 + (tid & 31) * 8;
#pragma unroll 2
            for (int ps = 0; ps < 16; ++ps) {
                const int r = ps * 16 + (tid >> 5);
                *(LAS u32x4*)(lds + r * KP + (tid & 31) * 16) = *(const u32x4*)(src + (size_t)r * 1024);
            }
        }
        __syncthreads();
        bf16x8 pf[2][8]; float rinv2[2];
#pragma unroll
        for (int sub = 0; sub < 2; ++sub) {
            const size_t row0 = (size_t)b * 2048 + q8 * 256 + sub * 128 + wid * 16;
            bf16x8 qf[8];
#pragma unroll
            for (int ks = 0; ks < 8; ++ks) qf[ks] = *(const bf16x8*)(Q + (row0 + fr) * 1024 + h * 256 + ks * 32 + fq * 8);
            float mxv = -3.0e38f;
#pragma unroll 2
            for (int mb = 0; mb < 16; ++mb) {
                f32x4 a = (f32x4){0.f, 0.f, 0.f, 0.f};
#pragma unroll
                for (int ks = 0; ks < 8; ++ks) a = MFMA16(*(const LAS bf16x8*)(lds + (mb * 16 + fr) * KP + ks * 64 + fq * 16), qf[ks], a);
                mxv = fmaxf(fmaxf(mxv, fmaxf(a[0], a[1])), fmaxf(a[2], a[3]));
                asm volatile("" ::: "memory");
            }
            mxv = fmaxf(mxv, __shfl_xor(mxv, 16)); mxv = fmaxf(mxv, __shfl_xor(mxv, 32));
            float sm = 0.f;
#pragma unroll
            for (int kk = 0; kk < 8; ++kk) {
                f32x4 a0 = (f32x4){0.f, 0.f, 0.f, 0.f}, a1 = a0;
#pragma unroll
                for (int ks = 0; ks < 8; ++ks) {
                    a0 = MFMA16(*(const LAS bf16x8*)(lds + ((2 * kk) * 16 + fr) * KP + ks * 64 + fq * 16), qf[ks], a0);
                    a1 = MFMA16(*(const LAS bf16x8*)(lds + ((2 * kk + 1) * 16 + fr) * KP + ks * 64 + fq * 16), qf[ks], a1);
                }
#pragma unroll
                for (int jj = 0; jj < 4; ++jj) { a0[jj] = __expf(a0[jj] - mxv); a1[jj] = __expf(a1[jj] - mxv); sm += a0[jj] + a1[jj]; }
                u32x4 w; w.x = cvt_pk_bf16(a0[0], a0[1]); w.y = cvt_pk_bf16(a0[2], a0[3]); w.z = cvt_pk_bf16(a1[0], a1[1]); w.w = cvt_pk_bf16(a1[2], a1[3]);
                pf[sub][kk] = __builtin_bit_cast(bf16x8, w);
                asm volatile("" ::: "memory");
            }
            sm += __shfl_xor(sm, 16); sm += __shfl_xor(sm, 32);
            rinv2[sub] = 1.0f / sm;
        }
        __syncthreads();
        {
            const bf16_t* src = VTB + ((size_t)b * 1024 + h * 256) * 256 + (tid & 31) * 8;
#pragma unroll 2
            for (int ps = 0; ps < 16; ++ps) {
                const int r = ps * 16 + (tid >> 5);
                *(LAS u32x4*)(lds + r * KP + (tid & 31) * 16) = *(const u32x4*)(src + (size_t)r * 256);
            }
        }
        __syncthreads();
        {
            const size_t rowA = (size_t)b * 2048 + q8 * 256 + wid * 16 + fr;
#pragma unroll 1
            for (int db = 0; db < 16; ++db) {
                f32x4 a0 = (f32x4){0.f, 0.f, 0.f, 0.f}, a1 = a0;
#pragma unroll
                for (int kk = 0; kk < 8; ++kk) {
                    const LAS unsigned char* vp = lds + (db * 16 + fr) * KP + (kk * 32 + fq * 4) * 2;
                    const u32x2 lo = *(const LAS u32x2*)vp, hi = *(const LAS u32x2*)(vp + 32);
                    u32x4 w; w.x = lo.x; w.y = lo.y; w.z = hi.x; w.w = hi.y;
                    const bf16x8 vf = __builtin_bit_cast(bf16x8, w);
                    a0 = MFMA16(vf, pf[0][kk], a0); a1 = MFMA16(vf, pf[1][kk], a1);
                }
                a0 *= rinv2[0]; a1 *= rinv2[1];
                u32x2 w0, w1; w0.x = cvt_pk_bf16(a0[0], a0[1]); w0.y = cvt_pk_bf16(a0[2], a0[3]); w1.x = cvt_pk_bf16(a1[0], a1[1]); w1.y = cvt_pk_bf16(a1[2], a1[3]);
                *(u32x2*)(AO + rowA * 1024 + h * 256 + db * 16 + fq * 4) = w0;
                *(u32x2*)(AO + (rowA + 128) * 1024 + h * 256 + db * 16 + fq * 4) = w1;
                asm volatile("" ::: "memory");
            }
        }
        __syncthreads();
    }
    } else {
    {
        LAS float* sc = (LAS float*)lds;
        LAS float* red = sc + 2048;
        const float* CK = p.in[5]; const float* CV = p.in[6];
        for (int u = blockIdx.x; u < 256; u += gridDim.x) {
            const int b = u >> 1, hp = u & 1;
            float qr[4][2][4];
#pragma unroll
            for (int t = 0; t < 4; ++t)
#pragma unroll
                for (int hh = 0; hh < 2; ++hh) {
                    const u32x2 w = *(const u32x2*)(Q + ((size_t)M_PR + b * 4 + t) * 1024 + (hp * 2 + hh) * 256 + lane * 4);
                    qr[t][hh][0] = bflo(w.x); qr[t][hh][1] = bfhi(w.x); qr[t][hh][2] = bflo(w.y); qr[t][hh][3] = bfhi(w.y);
                }
            for (int mi = 0; mi < 32; mi += 4) {
                f32x4 kr[4][2];
#pragma unroll
                for (int i = 0; i < 4; ++i)
#pragma unroll
                    for (int hh = 0; hh < 2; ++hh) kr[i][hh] = *(const f32x4*)(CK + (((size_t)b * 256 + wid * 32 + mi + i) * 4 + hp * 2 + hh) * 256 + lane * 4);
#pragma unroll
                for (int i = 0; i < 4; ++i)
#pragma unroll
                    for (int hh = 0; hh < 2; ++hh)
#pragma unroll
                        for (int t = 0; t < 4; ++t) {
                            float s = kr[i][hh][0] * qr[t][hh][0] + kr[i][hh][1] * qr[t][hh][1] + kr[i][hh][2] * qr[t][hh][2] + kr[i][hh][3] * qr[t][hh][3];
                            s = wave_sum(s);
                            if (lane == 0) sc[(t * 2 + hh) * 256 + wid * 32 + mi + i] = s;
                        }
            }
            __syncthreads();
            {
                LAS float* r = sc + wid * 256;
                float v0 = r[lane], v1 = r[lane + 64], v2 = r[lane + 128], v3 = r[lane + 192];
                float m = fmaxf(fmaxf(v0, v1), fmaxf(v2, v3));
#pragma unroll
                for (int o = 32; o > 0; o >>= 1) m = fmaxf(m, __shfl_xor(m, o));
                v0 = __expf(v0 - m); v1 = __expf(v1 - m); v2 = __expf(v2 - m); v3 = __expf(v3 - m);
                const float s = wave_sum((v0 + v1) + (v2 + v3)), ri = 1.0f / s;
                r[lane] = v0 * ri; r[lane + 64] = v1 * ri; r[lane + 128] = v2 * ri; r[lane + 192] = v3 * ri;
            }
            __syncthreads();
            {
                f32x4 oa[4][2];
#pragma unroll
                for (int t = 0; t < 4; ++t)
#pragma unroll
                    for (int hh = 0; hh < 2; ++hh) oa[t][hh] = (f32x4){0.f, 0.f, 0.f, 0.f};
                for (int mi = 0; mi < 32; mi += 4) {
                    f32x4 vr[4][2];
#pragma unroll
                    for (int i = 0; i < 4; ++i)
#pragma unroll
                        for (int hh = 0; hh < 2; ++hh) vr[i][hh] = *(const f32x4*)(CV + (((size_t)b * 256 + wid * 32 + mi + i) * 4 + hp * 2 + hh) * 256 + lane * 4);
#pragma unroll
                    for (int i = 0; i < 4; ++i)
#pragma unroll
                        for (int hh = 0; hh < 2; ++hh)
#pragma unroll
                            for (int t = 0; t < 4; ++t) oa[t][hh] += vr[i][hh] * sc[(t * 2 + hh) * 256 + wid * 32 + mi + i];
                }
#pragma unroll
                for (int rnd = 0; rnd < 2; ++rnd) {
#pragma unroll
                    for (int t2 = 0; t2 < 2; ++t2)
#pragma unroll
                        for (int hh = 0; hh < 2; ++hh) *(LAS f32x4*)(red + ((wid * 2 + t2) * 2 + hh) * 256 + lane * 4) = oa[rnd * 2 + t2][hh];
                    __syncthreads();
#pragma unroll
                    for (int i = 0; i < 2; ++i) {
                        const int o = tid + i * 512, t2 = o >> 9, hh = (o >> 8) & 1, d = o & 255;
                        float sacc2 = 0.f;
#pragma unroll
                        for (int w = 0; w < 8; ++w) sacc2 += red[((w * 2 + t2) * 2 + hh) * 256 + d];
                        AO[((size_t)M_PR + b * 4 + rnd * 2 + t2) * 1024 + (hp * 2 + hh) * 256 + d] = (bf16_t)(cvt_pk_bf16(sacc2, 0.f) & 0xffff);
                    }
                    __syncthreads();
                }
            }
        }
    }
    }
    }
}

__device__ __forceinline__ void ins16(float (&T)[16], float x) {
#pragma unroll
    for (int i = 0; i < 16; ++i) { const float hi = fmaxf(T[i], x); x = fminf(T[i], x); T[i] = hi; }
}
__device__ __forceinline__ void sort16(float (&T)[16]) {
#pragma unroll
    for (int k = 2; k <= 16; k <<= 1)
#pragma unroll
        for (int j = k >> 1; j > 0; j >>= 1)
#pragma unroll
            for (int i = 0; i < 16; ++i) {
                const int l = i ^ j;
                if (l > i) {
                    const float hi = fmaxf(T[i], T[l]), lo = fminf(T[i], T[l]);
                    if ((i & k) == 0) { T[i] = hi; T[l] = lo; } else { T[i] = lo; T[l] = hi; }
                }
            }
}
__device__ __forceinline__ void merge16(float (&T)[16]) {
#pragma unroll
    for (int j = 8; j > 0; j >>= 1)
#pragma unroll
        for (int i = 0; i < 16; ++i) {
            const int l = i ^ j;
            if (l > i) { const float hi = fmaxf(T[i], T[l]), lo = fminf(T[i], T[l]); T[i] = hi; T[l] = lo; }
        }
}
__device__ __forceinline__ void topmerge16(float (&T)[16], const float (&G)[16]) {
#pragma unroll
    for (int i = 0; i < 16; ++i) T[i] = fmaxf(T[i], G[15 - i]);
    merge16(T);
}
__device__ __forceinline__ float pack_key(float v, unsigned code, unsigned mask) { return __uint_as_float((__float_as_uint(v) & ~mask) | code); }

__device__ __forceinline__ void peer_select(const bf16_t* PQ, const bf16_t* SKB, int tok0, int frc, int h, LAS int* sel_i, LAS float* sel_g, int fr, int fq) {
            float T1[16], T2[16];
#pragma unroll
            for (int half = 0; half < 2; ++half) {
                bf16x8 qf[4];
#pragma unroll
                for (int ks = 0; ks < 4; ++ks) qf[ks] = *(const bf16x8*)(PQ + (size_t)(tok0 + frc) * 2048 + h * 256 + half * 128 + ks * 32 + fq * 8);
                float T[16], Bk[16];
                {
                    unsigned so = (unsigned)(((h * 2 + half) * 128 + fr) * 128 + fq * 8);
                    asm volatile("" : "+v"(so));
                    const bf16_t* sp0 = SKB + so;
#pragma unroll
                    for (int kg = 0; kg < 2; ++kg) {
                        bf16x8 sf[4][4];
#pragma unroll
                        for (int kb = 0; kb < 4; ++kb)
#pragma unroll
                            for (int ks = 0; ks < 4; ++ks) sf[kb][ks] = *(const bf16x8*)(sp0 + (kg * 4 + kb) * 2048 + ks * 32);
#pragma unroll
                        for (int kb = 0; kb < 4; ++kb) {
                            f32x4 a = (f32x4){0.f, 0.f, 0.f, 0.f};
#pragma unroll
                            for (int ks = 0; ks < 4; ++ks) a = MFMA16(sf[kb][ks], qf[ks], a);
#pragma unroll
                            for (int jj = 0; jj < 4; ++jj) {
                                const float key = pack_key(a[jj], (unsigned)((kg * 4 + kb) * 16 + fq * 4 + jj), 127u);
                                if (kg == 0) T[kb * 4 + jj] = key; else Bk[kb * 4 + jj] = key;
                            }
                        }
                        asm volatile("" ::: "memory");
                    }
                }
                sort16(T); sort16(Bk); topmerge16(T, Bk);
#pragma unroll
                for (int o = 16; o <= 32; o <<= 1) {
                    float R[16];
#pragma unroll
                    for (int i = 0; i < 16; ++i) R[i] = __shfl_xor(T[i], o);
                    topmerge16(T, R);
                }
#pragma unroll
                for (int i = 0; i < 16; ++i) { if (half == 0) T1[i] = T[i]; else T2[i] = T[i]; }
            }
            float va[16], vb[16];
#pragma unroll
            for (int i = 0; i < 16; ++i) { va[i] = __uint_as_float(__float_as_uint(T1[i]) & ~127u); vb[i] = __uint_as_float(__float_as_uint(T2[i]) & ~127u); }
#define PEER_CAND(a_, b_) pack_key(va[a_] + vb[b_], (unsigned)((a_) * 16 + (b_)), 255u)
            float T3[16], X[16];
#pragma unroll
            for (int i = 0; i < 16; ++i) T3[i] = PEER_CAND(0, i);
#pragma unroll
            for (int i = 0; i < 8; ++i) { X[i] = PEER_CAND(1, i); X[8 + i] = PEER_CAND(15 - i, 0); }
            merge16(X); topmerge16(T3, X);
            X[0] = PEER_CAND(2, 0); X[1] = PEER_CAND(2, 1); X[2] = PEER_CAND(2, 2); X[3] = PEER_CAND(2, 3); X[4] = PEER_CAND(2, 4);
            X[5] = PEER_CAND(3, 0); X[6] = PEER_CAND(3, 1); X[7] = PEER_CAND(3, 2); X[8] = PEER_CAND(3, 3);
            X[9] = PEER_CAND(4, 0); X[10] = PEER_CAND(4, 1); X[11] = PEER_CAND(4, 2);
            X[12] = PEER_CAND(5, 0); X[13] = PEER_CAND(5, 1); X[14] = PEER_CAND(6, 0); X[15] = PEER_CAND(6, 1);
            sort16(X); topmerge16(T3, X);
            ins16(T3, PEER_CAND(7, 0)); ins16(T3, PEER_CAND(7, 1));
#undef PEER_CAND
            float e[16], es = 0.f;
            const float m0 = __uint_as_float(__float_as_uint(T3[0]) & ~255u);
#pragma unroll
            for (int i = 0; i < 16; ++i) { e[i] = __expf(__uint_as_float(__float_as_uint(T3[i]) & ~255u) - m0); es += e[i]; }
            const float ei = 1.0f / es;
#pragma unroll
            for (int jj = 0; jj < 4; ++jj) {
                float key = T3[0], ev = e[0];
#pragma unroll
                for (int r = 0; r < 16; ++r) { const bool s = (r == fq * 4 + jj); key = s ? T3[r] : key; ev = s ? e[r] : ev; }
                const unsigned code = __float_as_uint(key) & 255u, ca = code >> 4, cb = code & 15u;
                unsigned k1 = __float_as_uint(T1[0]), k2 = __float_as_uint(T2[0]);
#pragma unroll
                for (int r = 0; r < 16; ++r) { k1 = (ca == (unsigned)r) ? __float_as_uint(T1[r]) : k1; k2 = (cb == (unsigned)r) ? __float_as_uint(T2[r]) : k2; }
                const int idx = (int)((k1 & 127u) * 128u + (k2 & 127u));
                sel_i[fr * 128 + h * 16 + fq * 4 + jj] = idx;
                sel_g[fr * 128 + h * 16 + fq * 4 + jj] = ev * ei;
            }
        }

__device__ void phase_peer(const Params& p, LAS unsigned char* lds) {
    int tid_ = threadIdx.x; asm volatile("" : "+v"(tid_)); const int tid = tid_, lane = tid & 63, wid = tid >> 6, fr = lane & 15, fq = lane >> 4;
    const bf16_t* PQ = (const bf16_t*)(p.ws + OFF_PQ); const bf16_t* SKB = (const bf16_t*)(p.ws + OFF_SKB);
    const unsigned char* U8 = p.ws + OFF_UB; const unsigned char* V8 = p.ws + OFF_VB;
    const float* SS2 = (const float*)(p.ws + OFF_SSP2);
    const bf16_t* H2 = (const bf16_t*)(p.ws + OFF_H2B); float* Y = p.out;
    LAS int* sel_i = (LAS int*)lds;
    LAS float* sel_g = (LAS float*)(lds + 16384);
    LAS float* wv = (LAS float*)(lds + 32768);
    const int per_wg = (M_TOK + gridDim.x - 1) / gridDim.x, wg_lo = blockIdx.x * per_wg, wg_hi = (wg_lo + per_wg < M_TOK) ? wg_lo + per_wg : M_TOK;
    const int ntile = (wg_hi > wg_lo) ? (wg_hi - wg_lo + 15) / 16 : 0;
    if (ntile > 0) {
        const int nv0 = (wg_hi - wg_lo < 16) ? wg_hi - wg_lo : 16, frc0 = (fr < nv0) ? fr : nv0 - 1;
        peer_select(PQ, SKB, wg_lo, frc0, wid, sel_i, sel_g, fr, fq);
    }
    __syncthreads();
    for (int ti = 0; ti < ntile; ++ti) {
        const int tok0 = wg_lo + ti * 16;
        const int nvalid = (wg_hi - tok0 < 16) ? wg_hi - tok0 : 16;
        const LAS int* si_b = sel_i + (ti & 1) * 2048; const LAS float* sg_b = sel_g + (ti & 1) * 2048;
        if (wid >= 4) {
            if (ti + 1 < ntile) {
                const int tok1 = tok0 + 16, nv1 = (wg_hi - tok1 < 16) ? wg_hi - tok1 : 16, frc1 = (fr < nv1) ? fr : nv1 - 1;
#pragma unroll 1
                for (int hh = 0; hh < 2; ++hh) peer_select(PQ, SKB, tok1, frc1, (wid - 4) * 2 + hh, sel_i + ((ti + 1) & 1) * 2048, sel_g + ((ti + 1) & 1) * 2048, fr, fq);
            }
        } else {
    #pragma unroll 1
            for (int tt = 0; tt < 4; ++tt) {
                const int tl = tt * 4 + wid; const size_t tok = (size_t)tok0 + tl;
                if (tl >= nvalid) break;
                const float rs = rsqrtf(wave_sum(lane < 16 ? SS2[(size_t)lane * M_TOK + tok] : 0.f) * (1.0f / 1024.0f) + EPS);
                const bf16_t* hrow = H2 + tok * 1024; const float* gf = p.in[22];
                f32x2 x2[4][8];
    #pragma unroll
                for (int i = 0; i < 4; ++i) {
                    const u32x4 h0 = *(const u32x4*)(hrow + i * 256 + fr * 16), h1 = *(const u32x4*)(hrow + i * 256 + fr * 16 + 8);
    #pragma unroll
                    for (int q = 0; q < 4; ++q) {
                        const f32x4 ga = *(const f32x4*)(gf + i * 256 + fr * 16 + q * 4);
                        const unsigned w0 = (q < 2) ? h0[(q & 1) * 2] : h1[(q & 1) * 2], w1 = (q < 2) ? h0[(q & 1) * 2 + 1] : h1[(q & 1) * 2 + 1];
                        x2[i][q * 2] = (f32x2){bflo(w0) * rs * ga[0], bfhi(w0) * rs * ga[1]}; x2[i][q * 2 + 1] = (f32x2){bflo(w1) * rs * ga[2], bfhi(w1) * rs * ga[3]};
                    }
                }
                const LAS int* si = si_b + tl * 128; const LAS float* sg = sg_b + tl * 128; LAS float* wvw = wv + wid * 128;
                u32x4 bA[1][4], bB[1][4];
    #define PEER_LOADU(buf, g) do { _Pragma("unroll") for (int q_ = 0; q_ < 1; ++q_) { const int idx_ = si[((g) + q_) * 4 + fq]; \
                    const unsigned char* ur_ = U8 + (size_t)idx_ * 1024 + fr * 16; \
                    _Pragma("unroll") for (int i_ = 0; i_ < 4; ++i_) buf[q_][i_] = *(const u32x4*)(ur_ + i_ * 256); } } while (0)
    #define PEER_COMPU(buf, g) do { _Pragma("unroll") for (int q_ = 0; q_ < 1; ++q_) { f32x2 s2_ = (f32x2){0.f, 0.f}; \
                    _Pragma("unroll") for (int i_ = 0; i_ < 4; ++i_) _Pragma("unroll") for (int w_ = 0; w_ < 4; ++w_) { \
                        s2_ += x2[i_][w_ * 2] * __builtin_amdgcn_cvt_pk_f32_fp8((int)buf[q_][i_][w_], false); \
                        s2_ += x2[i_][w_ * 2 + 1] * __builtin_amdgcn_cvt_pk_f32_fp8((int)buf[q_][i_][w_], true); } \
                    float s_ = s2_.x + s2_.y; s_ += __shfl_xor(s_, 1); s_ += __shfl_xor(s_, 2); s_ += __shfl_xor(s_, 4); s_ += __shfl_xor(s_, 8); \
                    if (fr == 0) wvw[((g) + q_) * 4 + fq] = s_ * (1.0f / 1024.0f); } } while (0)
                PEER_LOADU(bA, 0);
    #pragma unroll 1
                for (int g = 0; g < 32; g += 2) {
                    PEER_LOADU(bB, g + 1);
                    PEER_COMPU(bA, g);
                    { const int gn = (g + 2 < 32) ? g + 2 : 31; PEER_LOADU(bA, gn); }
                    PEER_COMPU(bB, g + 1);
                }
                {
                    const float a0 = wvw[lane], a1 = wvw[lane + 64];
                    wvw[lane] = 0.5f * a0 * (1.0f + erff(a0 * 0.70710678118654752f)) * sg[lane] * (1.0f / 64.0f);
                    wvw[lane + 64] = 0.5f * a1 * (1.0f + erff(a1 * 0.70710678118654752f)) * sg[lane + 64] * (1.0f / 64.0f);
                }
                f32x2 acc2[8];
    #pragma unroll
                for (int e2 = 0; e2 < 8; ++e2) acc2[e2] = (f32x2){0.f, 0.f};
                u32x4 vA[8], vB[8];
    #define PEER_LOADV(buf, k0) do { _Pragma("unroll") for (int q_ = 0; q_ < 8; ++q_) buf[q_] = *(const u32x4*)(V8 + (size_t)si[(k0) + q_] * 1024 + lane * 16); } while (0)
    #define PEER_COMPV(buf, k0) do { _Pragma("unroll") for (int q_ = 0; q_ < 8; ++q_) { const float w_ = wvw[(k0) + q_]; \
                    _Pragma("unroll") for (int j_ = 0; j_ < 4; ++j_) { \
                        acc2[j_ * 2] += __builtin_amdgcn_cvt_pk_f32_fp8((int)buf[q_][j_], false) * w_; \
                        acc2[j_ * 2 + 1] += __builtin_amdgcn_cvt_pk_f32_fp8((int)buf[q_][j_], true) * w_; } } } while (0)
                PEER_LOADV(vA, 0);
    #pragma unroll 1
                for (int k0 = 0; k0 < 128; k0 += 16) {
                    PEER_LOADV(vB, k0 + 8);
                    PEER_COMPV(vA, k0);
                    { const int kn = (k0 + 16 < 128) ? k0 + 16 : 120; PEER_LOADV(vA, kn); }
                    PEER_COMPV(vB, k0 + 8);
                }
    #undef PEER_LOADU
    #undef PEER_COMPU
    #undef PEER_LOADV
    #undef PEER_COMPV
                float ss = 0.f; f32x4 hv[4];
                {
                    const u32x4 h0 = *(const u32x4*)(hrow + lane * 16), h1 = *(const u32x4*)(hrow + lane * 16 + 8);
    #pragma unroll
                    for (int q = 0; q < 4; ++q) {
                        const unsigned w0 = (q < 2) ? h0[(q & 1) * 2] : h1[(q & 1) * 2], w1 = (q < 2) ? h0[(q & 1) * 2 + 1] : h1[(q & 1) * 2 + 1];
                        hv[q][0] = bflo(w0) + acc2[q * 2].x; hv[q][1] = bfhi(w0) + acc2[q * 2].y; hv[q][2] = bflo(w1) + acc2[q * 2 + 1].x; hv[q][3] = bfhi(w1) + acc2[q * 2 + 1].y;
                        ss += (hv[q][0] * hv[q][0] + hv[q][1] * hv[q][1]) + (hv[q][2] * hv[q][2] + hv[q][3] * hv[q][3]);
                    }
                }
                ss = wave_sum(ss);
                const float rf = rsqrtf(ss * (1.0f / 1024.0f) + EPS);
                const float* nf = p.in[27];
    #pragma unroll
                for (int q = 0; q < 4; ++q) *(f32x4*)(Y + tok * 1024 + lane * 16 + q * 4) = hv[q] * rf * *(const f32x4*)(nf + lane * 16 + q * 4);
            }
        }
        __syncthreads();
    }
}

struct SmallArgs { const bf16_t* A; const bf16_t* Bt; int N; const bf16_t* proj; const bf16_t* base; bf16_t* O; int ldo; float* SSw; const float* SSr; float sc; };
template <int MODE>
__device__ __forceinline__ void small_gemm(const SmallArgs& a, LAS unsigned char* lds) {
    int tid_ = threadIdx.x; asm volatile("" : "+v"(tid_)); const int tid = tid_, lane = tid & 63, wid = tid >> 6, fr = lane & 15, fq = lane >> 4;
    const int ncb = a.N / 64;
    constexpr int SP = 1040;
    LAS unsigned char* LA = lds; LAS unsigned char* LB = lds + 32 * SP;
    LAS float* red = (LAS float*)(lds + 96 * SP);
    for (int tile = blockIdx.x; tile < 16 * ncb; tile += gridDim.x) {
        const int rb = tile / ncb, cb = tile % ncb;
        const int row = M_PR + rb * 32 + (wid >> 2) * 16 + fr;
        const int colb = cb * 64 + (wid & 3) * 16;
        const bf16_t* Ag = a.A + (size_t)(M_PR + rb * 32) * 1024 + (tid & 63) * 8;
        const bf16_t* Bg = a.Bt + (size_t)(cb * 64) * 1024 + (tid & 63) * 8;
        u32x4 ra[4], rbv[8];
#define SG_LOAD(kh_) do { _Pragma("unroll") for (int i_ = 0; i_ < 4; ++i_) ra[i_] = *(const u32x4*)(Ag + (size_t)((tid >> 6) + 8 * i_) * 1024 + (kh_) * 512); \
            _Pragma("unroll") for (int i_ = 0; i_ < 8; ++i_) rbv[i_] = *(const u32x4*)(Bg + (size_t)((tid >> 6) + 8 * i_) * 1024 + (kh_) * 512); } while (0)
        SG_LOAD(0);
        const int col = colb + fq * 4;
        u32x2 e_sa = (u32x2){0u, 0u}, e_sb = (u32x2){0u, 0u}, e_base = (u32x2){0u, 0u}; float e_t = 0.f;
        if (MODE == 0) { e_sa = *(const u32x2*)(a.proj + (size_t)row * NPROJ + 3328 + col); e_sb = *(const u32x2*)(a.proj + (size_t)row * NPROJ + 4352 + col); }
        if (MODE == 1) e_base = *(const u32x2*)(a.base + (size_t)row * 1024 + col);
        if (MODE == 2) {
#pragma unroll
            for (int q = 0; q < 4; ++q) e_t += a.SSr[(size_t)(fq * 4 + q) * M_TOK + row];
        }
        f32x4 acc = (f32x4){0.f, 0.f, 0.f, 0.f};
#pragma unroll
        for (int kh = 0; kh < 2; ++kh) {
#pragma unroll
            for (int i_ = 0; i_ < 4; ++i_) *(LAS u32x4*)(LA + ((tid >> 6) + 8 * i_) * SP + (tid & 63) * 16) = ra[i_];
#pragma unroll
            for (int i_ = 0; i_ < 8; ++i_) *(LAS u32x4*)(LB + ((tid >> 6) + 8 * i_) * SP + (tid & 63) * 16) = rbv[i_];
            __syncthreads();
            if (kh == 0) SG_LOAD(1);
            const LAS unsigned char* apl = LA + ((wid >> 2) * 16 + fr) * SP + fq * 16;
            const LAS unsigned char* bpl = LB + ((wid & 3) * 16 + fr) * SP + fq * 16;
#pragma unroll
            for (int ks = 0; ks < 16; ++ks) acc = MFMA16(*(const LAS bf16x8*)(bpl + ks * 64), *(const LAS bf16x8*)(apl + ks * 64), acc);
            if (MODE == 0 && kh == 0) {
                const u32x2 sa = e_sa, sb = e_sb;
                acc[0] *= bflo(sa.x) * __builtin_amdgcn_rcpf(bflo(sb.x)); acc[1] *= bfhi(sa.x) * __builtin_amdgcn_rcpf(bfhi(sb.x));
                acc[2] *= bflo(sa.y) * __builtin_amdgcn_rcpf(bflo(sb.y)); acc[3] *= bfhi(sa.y) * __builtin_amdgcn_rcpf(bfhi(sb.y));
            }
            __syncthreads();
        }
#undef SG_LOAD
        if (MODE == 0) {
            const u32x2 sb = e_sb;
            u32x2 w; w.x = cvt_pk_bf16(acc[0] * bflo(sb.x), acc[1] * bfhi(sb.x)); w.y = cvt_pk_bf16(acc[2] * bflo(sb.y), acc[3] * bfhi(sb.y));
            *(u32x2*)(a.O + (size_t)row * a.ldo + col) = w;
        } else if (MODE == 1) {
            const u32x2 b = e_base;
            f32x4 v = acc; v[0] += bflo(b.x); v[1] += bfhi(b.x); v[2] += bflo(b.y); v[3] += bfhi(b.y);
            float sq = (v[0] * v[0] + v[1] * v[1]) + (v[2] * v[2] + v[3] * v[3]);
            u32x2 w; w.x = cvt_pk_bf16(v[0], v[1]); w.y = cvt_pk_bf16(v[2], v[3]);
            *(u32x2*)(a.O + (size_t)row * a.ldo + col) = w;
            sq += __shfl_xor(sq, 16); sq += __shfl_xor(sq, 32);
            if (fq == 0) red[((wid >> 2) * 16 + fr) * 4 + (wid & 3)] = sq;
            __syncthreads();
            if (tid < 32) a.SSw[(size_t)cb * M_TOK + M_PR + rb * 32 + tid] = (red[tid * 4] + red[tid * 4 + 1]) + (red[tid * 4 + 2] + red[tid * 4 + 3]);
            __syncthreads();
        } else {
            float t = e_t;
            t += __shfl_xor(t, 16); t += __shfl_xor(t, 32);
            const float rs = rsqrtf(t * (1.0f / 1024.0f) + EPS) * a.sc;
            u32x2 w; w.x = cvt_pk_bf16(acc[0] * rs, acc[1] * rs); w.y = cvt_pk_bf16(acc[2] * rs, acc[3] * rs);
            *(u32x2*)(a.O + (size_t)row * a.ldo + col) = w;
        }
    }
}

#define XB_TMO      128
#define XB_XCNT(j)  (256  + 64 * (j))
#define XB_XSUB(j)  (1280 + 64 * (j))
#define XB_XGEN(j)  (2304 + 64 * (j))
#define XB_TOP      3328
#define XB_TOPGEN   3392
#define XCD_BAR_WORDS 3456
#define XB_SPIN_CAP (1u << 18)

__device__ __forceinline__ unsigned xb_ld(unsigned* p)              { return __hip_atomic_load(p, __ATOMIC_RELAXED, __HIP_MEMORY_SCOPE_AGENT); }
__device__ __forceinline__ unsigned xb_add(unsigned* p, unsigned v) { return __hip_atomic_fetch_add(p, v, __ATOMIC_RELAXED, __HIP_MEMORY_SCOPE_AGENT); }
__device__ __forceinline__ unsigned xb_xcc_id() { return (unsigned)__builtin_amdgcn_s_getreg((3 << 11) | 20) & 0xFu; }
#define XB_SPIN(cond, bar) do { unsigned _sp = 0; while (cond) { __builtin_amdgcn_s_sleep(1); \
    if ((++_sp & 255u) == 0u) { if (xb_ld(&(bar)[XB_TMO])) break; if (_sp > XB_SPIN_CAP) { atomicAdd(&(bar)[XB_TMO], 1u); break; } } } } while (0)

struct XcdBarrier {
    unsigned* bar; unsigned x;
    volatile LAS unsigned* st;
};

__device__ __forceinline__ XcdBarrier xcd_barrier_post(unsigned* bar, volatile LAS unsigned* st) {
    XcdBarrier b; b.bar = bar; b.x = xb_xcc_id(); b.st = st;
    if (threadIdx.x == 0) (void)xb_add(&bar[XB_XCNT(b.x)], 1u);
    return b;
}
__device__ __forceinline__ void xcd_barrier_complete(unsigned* bar, unsigned x, unsigned& nloc, unsigned& nx) {
    const unsigned G = gridDim.x * gridDim.y * gridDim.z;
    unsigned sum, cnt, mine, sp = 0u;
    for (;;) {
        sum = 0u; cnt = 0u; mine = 0u;
#pragma unroll
        for (unsigned j = 0; j < 16; ++j) { const unsigned c = xb_ld(&bar[XB_XCNT(j)]); sum += c; cnt += (c > 0u) ? 1u : 0u; mine = (j == x) ? c : mine; }
        if (sum == G) break;
        __builtin_amdgcn_s_sleep(1);
        if ((++sp & 255u) == 0u) { if (xb_ld(&bar[XB_TMO])) break; if (sp > XB_SPIN_CAP) { atomicAdd(&bar[XB_TMO], 1u); break; } }
    }
    nloc = mine > 0u ? mine : 1u; nx = cnt > 0u ? cnt : 1u;
}

__device__ __forceinline__ void xcd_barrier(const XcdBarrier& b) {
    asm volatile("s_waitcnt vmcnt(0)" ::: "memory");
    __syncthreads();
    if (threadIdx.x == 0) {
        unsigned* bar = b.bar;
        __builtin_amdgcn_s_waitcnt(0);
        unsigned nloc = b.st[0], nx = b.st[1];
        if (nloc == 0u) { xcd_barrier_complete(bar, b.x, nloc, nx); b.st[0] = nloc; b.st[1] = nx; }
        const unsigned old = xb_add(&bar[XB_XSUB(b.x)], 1u);
        const unsigned gen = old / nloc;
        if (old + 1u == (gen + 1u) * nloc) {
            __builtin_amdgcn_fence(__ATOMIC_RELEASE, "agent");
            asm volatile("s_waitcnt vmcnt(0)" ::: "memory");
            const unsigned og = xb_add(&bar[XB_TOP], 1u);
            const unsigned tg = og / nx;
            if (og + 1u == (tg + 1u) * nx) xb_add(&bar[XB_TOPGEN], 1u);
            else XB_SPIN(xb_ld(&bar[XB_TOPGEN]) == tg, bar);
            __builtin_amdgcn_fence(__ATOMIC_ACQUIRE, "agent");
            xb_add(&bar[XB_XGEN(b.x)], 1u);
            asm volatile("s_waitcnt vmcnt(0)" ::: "memory");
        } else {
            XB_SPIN(xb_ld(&bar[XB_XGEN(b.x)]) == gen, bar);
            __builtin_amdgcn_fence(__ATOMIC_ACQUIRE, "agent");
            asm volatile("s_waitcnt vmcnt(0)" ::: "memory");
        }
    }
    __syncthreads();
}


__device__ __forceinline__ void my_grid_sync(unsigned* bar, unsigned target) {
    asm volatile("s_waitcnt vmcnt(0) lgkmcnt(0)" ::: "memory");
    __syncthreads();
    if (threadIdx.x == 0) {
        __builtin_amdgcn_fence(__ATOMIC_RELEASE, "agent");
        asm volatile("s_waitcnt vmcnt(0)" ::: "memory");
        __hip_atomic_fetch_add(bar, 1u, __ATOMIC_RELAXED, __HIP_MEMORY_SCOPE_AGENT);
        while (__hip_atomic_load(bar, __ATOMIC_RELAXED, __HIP_MEMORY_SCOPE_AGENT) < target) __builtin_amdgcn_s_sleep(2);
    }
    __syncthreads();
    asm volatile("buffer_inv sc1\n\ts_waitcnt vmcnt(0)" ::: "memory");
}
__global__ void __launch_bounds__(NTHR) mk_fwd(Params p) {
    extern __shared__ __attribute__((aligned(16))) unsigned char lds_raw[];
    LAS unsigned char* lds = (LAS unsigned char*)lds_raw;
    cg::grid_group grid = cg::this_grid();
    if (threadIdx.x < 4) ((LAS unsigned*)(lds + LDS_BYTES - 16))[threadIdx.x] = 0u;
    __syncthreads();
    const XcdBarrier xb = xcd_barrier_post((unsigned*)(p.ws + OFF_BAR), (volatile LAS unsigned*)(lds + LDS_BYTES - 16));
#define GRID_SYNC() xcd_barrier(xb)
    unsigned char* ws = p.ws;
    const int G = gridDim.x, c = blockIdx.x;
    const bf16_t* A0 = (const bf16_t*)(ws + OFF_A0);

    if (p.ws == nullptr) grid.sync();
    PH(0) phase_prep(p, lds);
    GRID_SYNC();
    PH(1) {
        pg8::Sched S; S.init(A0, (const bf16_t*)(ws + OFF_WTIN), M_TOK, NPROJ, A0 + (size_t)M_TOK * 1024, (const bf16_t*)(ws + OFF_WTKV), 2048, 2048, G, c);
        EpiProj E{(const float*)(ws + OFF_SS0), p.in[10], (bf16_t*)(ws + OFF_PROJ), (float*)(ws + OFF_LOGA), p.out, (bf16_t*)(ws + OFF_KB), (bf16_t*)(ws + OFF_VTB)};
        pg8::gemm_phase(lds, 1024, S, E);
    }
    GRID_SYNC();
    PH(2) phase_scan(p, lds);
    GRID_SYNC();
    PH(3) phase_onorm(p);
    GRID_SYNC();
    PH(4) {
        pg8::Sched S; S.init((const bf16_t*)(ws + OFF_A2), (const bf16_t*)(ws + OFF_WTP), M_PR, 1024, nullptr, nullptr, 0, 0, G, c);
        EpiMerge E{(const bf16_t*)(ws + OFF_PROJ), (bf16_t*)(ws + OFF_X)};
        pg8::gemm_phase(lds, 1024, S, E);
        SmallArgs sa{(const bf16_t*)(ws + OFF_A2), (const bf16_t*)(ws + OFF_WTP), 1024, (const bf16_t*)(ws + OFF_PROJ), nullptr, (bf16_t*)(ws + OFF_X), 1024, nullptr, nullptr, 1.f};
        small_gemm<0>(sa, lds);
    }
    GRID_SYNC();
    PH(5) {
        pg8::Sched S; S.init((const bf16_t*)(ws + OFF_X), (const bf16_t*)(ws + OFF_WTO), M_PR, 1024, nullptr, nullptr, 0, 0, G, c);
        EpiResid E{A0, (bf16_t*)(ws + OFF_H1B), (float*)(ws + OFF_SSP1)};
        pg8::gemm_phase(lds, 1024, S, E);
        SmallArgs sa{(const bf16_t*)(ws + OFF_X), (const bf16_t*)(ws + OFF_WTO), 1024, nullptr, A0, (bf16_t*)(ws + OFF_H1B), 1024, (float*)(ws + OFF_SSP1), nullptr, 1.f};
        small_gemm<1>(sa, lds);
    }
    GRID_SYNC();
    PH(6) {
        pg8::Sched S; S.init((const bf16_t*)(ws + OFF_H1B), (const bf16_t*)(ws + OFF_WTXQ), M_PR, 1024, nullptr, nullptr, 0, 0, G, c);
        EpiScale E{(const float*)(ws + OFF_SSP1), (bf16_t*)(ws + OFF_Q), 1024, 0.0625f};
        pg8::gemm_phase(lds, 1024, S, E);
        SmallArgs sa{(const bf16_t*)(ws + OFF_H1B), (const bf16_t*)(ws + OFF_WTXQ), 1024, nullptr, nullptr, (bf16_t*)(ws + OFF_Q), 1024, nullptr, (const float*)(ws + OFF_SSP1), 0.0625f};
        small_gemm<2>(sa, lds);
    }
    GRID_SYNC();
    PH(7) phase_attn(p, lds);
    GRID_SYNC();
    PH(8) {
        pg8::Sched S; S.init((const bf16_t*)(ws + OFF_AO), (const bf16_t*)(ws + OFF_WTXO), M_PR, 1024, nullptr, nullptr, 0, 0, G, c);
        EpiResid E{(const bf16_t*)(ws + OFF_H1B), (bf16_t*)(ws + OFF_H2B), (float*)(ws + OFF_SSP2)};
        pg8::gemm_phase(lds, 1024, S, E);
        SmallArgs sa{(const bf16_t*)(ws + OFF_AO), (const bf16_t*)(ws + OFF_WTXO), 1024, nullptr, (const bf16_t*)(ws + OFF_H1B), (bf16_t*)(ws + OFF_H2B), 1024, (float*)(ws + OFF_SSP2), nullptr, 1.f};
        small_gemm<1>(sa, lds);
    }
    GRID_SYNC();
    PH(9) {
        pg8::Sched S; S.init((const bf16_t*)(ws + OFF_H2B), (const bf16_t*)(ws + OFF_WTPQ), M_PR, 2048, nullptr, nullptr, 0, 0, G, c);
        EpiScale E{(const float*)(ws + OFF_SSP2), (bf16_t*)(ws + OFF_PQ), 2048, 1.0f};
        pg8::gemm_phase(lds, 1024, S, E);
        SmallArgs sa{(const bf16_t*)(ws + OFF_H2B), (const bf16_t*)(ws + OFF_WTPQ), 2048, nullptr, nullptr, (bf16_t*)(ws + OFF_PQ), 2048, nullptr, (const float*)(ws + OFF_SSP2), 1.0f};
        small_gemm<2>(sa, lds);
    }
    GRID_SYNC();
    PH(10) phase_peer(p, lds);
#ifdef DUMP
    GRID_SYNC();
    {
        const size_t gt = (size_t)blockIdx.x * NTHR + threadIdx.x, ngt = (size_t)gridDim.x * NTHR;
        const bf16_t* srcb = (const bf16_t*)(ws + (DUMP == 1 ? OFF_A2 : (DUMP == 2 ? OFF_X : OFF_H1B)));
        const float* srcf = (const float*)(ws + OFF_X);
        if (DUMP == 4) { const bf16_t* pj = (const bf16_t*)(ws + OFF_PROJ); for (size_t i = gt; i < (size_t)M_TOK * 1024; i += ngt) p.out[i] = bf2f(pj[(i >> 10) * NPROJ + (i & 1023)]); }
        else if (DUMP == 5) { const bf16_t* pj = (const bf16_t*)(ws + OFF_PROJ); for (size_t i = gt; i < (size_t)M_TOK * 1024; i += ngt) p.out[i] = bf2f(pj[(i >> 10) * NPROJ + 1792 + (i & 1023)]); }
        else for (size_t i = gt; i < (size_t)M_PR * 1024; i += ngt) p.out[i] = (DUMP == 3) ? srcf[i] : bf2f(srcb[i]);
    }
#endif
}

extern "C" void kernel_launch(void* const* d_in, const int* in_sizes, int n_in, void* d_out, int out_size, void* d_ws, size_t ws_size, hipStream_t stream) {
    static int grid_blocks = 0;
    if (!grid_blocks) {
        int dev = 0, cus = 0, per_cu = 0;
        (void)hipGetDevice(&dev);
        (void)hipDeviceGetAttribute(&cus, hipDeviceAttributeMultiprocessorCount, dev);
        (void)hipFuncSetAttribute((const void*)mk_fwd, hipFuncAttributeMaxDynamicSharedMemorySize, LDS_BYTES);
        (void)hipOccupancyMaxActiveBlocksPerMultiprocessor(&per_cu, (const void*)mk_fwd, NTHR, LDS_BYTES);
        if (per_cu < 1) per_cu = 1;
        grid_blocks = cus * per_cu;
        if (ws_size < WS_END) fprintf(stderr, "kernel_launch: workspace too small (%zu < %zu)\n", ws_size, (size_t)WS_END);
    }
    Params p{};
    for (int i = 0; i < 28; ++i) p.in[i] = (const float*)d_in[i];
    p.out = (float*)d_out; p.ws = (unsigned char*)d_ws;
    (void)hipMemsetAsync((unsigned char*)d_ws + OFF_BAR, 0, 16384, stream);
    void* args[] = {&p};
    hipError_t e = hipLaunchCooperativeKernel((const void*)mk_fwd, dim3(grid_blocks), dim3(NTHR), args, LDS_BYTES, stream);
    if (e != hipSuccess) fprintf(stderr, "cooperative launch failed: %s (grid %d)\n", hipGetErrorString(e), grid_blocks);
}
```

```cpp
#include <hip/hip_runtime.h>
#include <hip/hip_cooperative_groups.h>
#include <cstdio>
namespace cg = cooperative_groups;

#define LAS __attribute__((address_space(3)))
typedef unsigned short bf16_t;
typedef short bf16x8 __attribute__((ext_vector_type(8)));
typedef float f32x4 __attribute__((ext_vector_type(4)));
typedef float f32x2 __attribute__((ext_vector_type(2)));
typedef unsigned u32x4 __attribute__((ext_vector_type(4)));
typedef unsigned u32x2 __attribute__((ext_vector_type(2)));

constexpr int NTHR = 512;
constexpr int M_TOK = 16896, M_PR = 16384, M_ALL = 18944, DM = 1024, NPROJ = 5376;
constexpr float EPS = 1e-6f;
constexpr int LDS_BYTES = 147456;

constexpr size_t OUT_Y = 0, OUT_GLAP = 17301504, OUT_RETP = 17563648, OUT_MK = 17825792, OUT_MV = 19922944, OUT_GLAS = 22020096, OUT_RETS = 26214400;

constexpr size_t al256(size_t x) { return (x + 255) & ~(size_t)255; }
constexpr size_t OFF_A0 = 0;
constexpr size_t OFF_SS0 = al256(OFF_A0 + (size_t)M_ALL * DM * 2);
constexpr size_t OFF_SS1 = al256(OFF_SS0 + (size_t)M_ALL * 4);
constexpr size_t OFF_SS2 = OFF_SS1 + (size_t)M_TOK * 4;
constexpr size_t OFF_WTIN = al256(OFF_SS2 + (size_t)M_TOK * 4);
constexpr size_t OFF_WTKV = OFF_WTIN + (size_t)NPROJ * DM * 2;
constexpr size_t OFF_WTP = OFF_WTKV + (size_t)2048 * DM * 2;
constexpr size_t OFF_WTO = OFF_WTP + (size_t)DM * DM * 2;
constexpr size_t OFF_WTXQ = OFF_WTO + (size_t)DM * DM * 2;
constexpr size_t OFF_WTXO = OFF_WTXQ + (size_t)DM * DM * 2;
constexpr size_t OFF_WTPQ = OFF_WTXO + (size_t)DM * DM * 2;
constexpr size_t OFF_SKB = OFF_WTPQ + (size_t)2048 * DM * 2;
constexpr size_t OFF_UB = OFF_SKB + (size_t)8 * 2 * 128 * 128 * 2;
constexpr size_t OFF_VB = OFF_UB + (size_t)16384 * DM;
constexpr size_t OFF_PROJ = OFF_VB + (size_t)16384 * DM;
constexpr size_t OFF_LOGA = OFF_PROJ + (size_t)M_TOK * NPROJ * 2;
constexpr size_t OFF_KB = OFF_LOGA + (size_t)M_TOK * 256 * 4;
constexpr size_t OFF_VTB = OFF_KB + (size_t)2048 * DM * 2;
constexpr size_t OFF_X = OFF_VTB + (size_t)2048 * DM * 2;
constexpr size_t OFF_A2 = OFF_X + (size_t)M_TOK * DM * 4;
constexpr size_t OFF_SSP1 = OFF_A2 + (size_t)M_TOK * DM * 2;
constexpr size_t OFF_SSP2 = OFF_SSP1 + (size_t)16 * M_TOK * 4;
constexpr size_t OFF_BAR = OFF_SSP2 + (size_t)16 * M_TOK * 4;
constexpr size_t WS_END = OFF_BAR + 16384;
constexpr size_t OFF_H1B = OFF_PROJ;
constexpr size_t OFF_Q = OFF_H1B + (size_t)M_TOK * DM * 2;
constexpr size_t OFF_AO = OFF_Q + (size_t)M_TOK * DM * 2;
constexpr size_t OFF_H2B = OFF_AO + (size_t)M_TOK * DM * 2;
constexpr size_t OFF_PQ = OFF_PROJ;

struct Params { const float* in[28]; float* out; unsigned char* ws; };
#ifndef PHMASK
#define PHMASK 0xFFFF
#endif
#define PH(k) if constexpr ((PHMASK >> (k)) & 1)

typedef __bf16 bf16v2_t __attribute__((ext_vector_type(2)));
__device__ __forceinline__ unsigned cvt_pk_bf16(float lo, float hi) { const f32x2 v = {lo, hi}; return __builtin_bit_cast(unsigned, __builtin_convertvector(v, bf16v2_t)); }
__device__ __forceinline__ float bflo(unsigned u) { return __uint_as_float(u << 16); }
__device__ __forceinline__ float bfhi(unsigned u) { return __uint_as_float(u & 0xffff0000u); }
__device__ __forceinline__ float bf2f(bf16_t b) { return __uint_as_float(((unsigned)b) << 16); }
__device__ __forceinline__ float wave_sum(float v) {
#pragma unroll
    for (int o = 32; o > 0; o >>= 1) v += __shfl_xor(v, o);
    return v;
}
__device__ __forceinline__ float sigmoidf_(float v) { return __builtin_amdgcn_rcpf(1.0f + __expf(-v)); }

namespace pg8 {
constexpr int BM = 256, BK = 64, HALF = 128, HTB = HALF * BK * 2, STAGE_BYTES = 8 * HTB, NXCD = 8, WGM = 8;
__device__ __forceinline__ int lds_byte(int r, int c) { const int st = (r >> 4) * 2 + (c >> 5), rr = r & 15, cc = c & 31, ob = rr * 64 + cc * 2; return st * 1024 + (ob ^ (((ob >> 9) & 1) << 5)); }
__device__ __forceinline__ void stage_rc(int b, int& R, int& C) { const int st = b / 1024, sb = b % 1024, swz = sb ^ (((sb >> 9) & 1) << 5); R = (st >> 1) * 16 + swz / 64; C = (st & 1) * 32 + (swz % 64) / 2; }

struct Unit { int pm, pn, job; };
struct Sched {
    const bf16_t* A0; const bf16_t* B0; const bf16_t* A1; const bf16_t* B1;
    int nM0, nN0, n0, nM1, nN1, n1, G, c;
    __device__ __forceinline__ void init(const bf16_t* a0, const bf16_t* b0, int M0, int N0, const bf16_t* a1, const bf16_t* b1, int M1, int N1, int G_, int c_) {
        A0 = a0; B0 = b0; A1 = a1; B1 = b1; nM0 = M0 / BM; nN0 = N0 / BM; n0 = nM0 * nN0; nM1 = M1 / BM; nN1 = N1 / BM; n1 = nM1 * nN1; G = G_; c = c_; }
    __device__ __forceinline__ void map(int wgid, int nwg, int nM, int nN, Unit& u) const {
        { const int q = nwg / NXCD, r = nwg % NXCD, xcd = wgid % NXCD, off = wgid / NXCD; wgid = (xcd < r ? xcd * (q + 1) : r * (q + 1) + (xcd - r) * q) + off; }
        const int nig = WGM * nN, gid = wgid / nig, fm = gid * WGM, gsz = (nM - fm) < WGM ? (nM - fm) : WGM;
        u.pm = fm + ((wgid % nig) % gsz); u.pn = (wgid % nig) / gsz;
    }
    __device__ __forceinline__ bool next(int i, Unit& u) const {
        int L = i * G + c;
        if (L < n0) { map(L, n0, nM0, nN0, u); u.job = 0; return true; }
        L -= n0;
        if (L < n1) { map(L, n1, nM1, nN1, u); u.job = 1; return true; }
        return false;
    }
    __device__ __forceinline__ const char* aptr(const Unit& u, size_t tstep) const { return (const char*)(u.job ? A1 : A0) + (size_t)u.pm * tstep; }
    __device__ __forceinline__ const char* bptr(const Unit& u, size_t tstep) const { return (const char*)(u.job ? B1 : B0) + (size_t)u.pn * tstep; }
};

template <class Epi>
__device__ __forceinline__ void gemm_phase(LAS unsigned char* lds, const int K, const Sched& S, const Epi& E) {
    int tid_ = threadIdx.x; asm volatile("" : "+v"(tid_)); const int tid = tid_, wid = __builtin_amdgcn_readfirstlane(tid >> 6), lane = tid & 63, wr = wid >> 2, wc = wid & 3, fr = lane & 15, fq = lane >> 4;
    const int nt = K / BK;
    unsigned voffA[2];
#pragma unroll
    for (int i = 0; i < 2; ++i) { int R, C; stage_rc(tid * 16 + i * 8192, R, C); voffA[i] = (unsigned)(R * K + C) * 2u; }
    const size_t kstep = (size_t)(BK * 2);
    const size_t hstep = (size_t)HALF * K * 2;
    const size_t tstep = 2 * hstep;
    const unsigned ldsw = (unsigned)wid * 1024u;
    const int aoff = lds_byte(wr * 64 + fr, fq * 8), boff = lds_byte(wc * 32 + fr, fq * 8);
#define PG8_SA(b, h) (((b) * 2 + (h)) * HTB)
#define PG8_SB(b, h) ((4 + (b) * 2 + (h)) * HTB)
#define PG8_STAGE(bufoff, gbase) do { _Pragma("unroll") for (int _i = 0; _i < 2; ++_i) \
        __builtin_amdgcn_global_load_lds((const unsigned*)((const char*)(gbase) + voffA[_i]), (LAS unsigned*)(lds + (bufoff) + ldsw + _i * 8192), 16, 0, 0); } while (0)
#define PG8_LDA(dst, b, h) do { _Pragma("unroll") for (int m = 0; m < 4; ++m) _Pragma("unroll") for (int k = 0; k < 2; ++k) dst[m][k] = *(const LAS bf16x8*)(lds + PG8_SA(b, h) + aoff + m * 2048 + k * 1024); } while (0)
#define PG8_LDB(dst, b, h) do { _Pragma("unroll") for (int n = 0; n < 2; ++n) _Pragma("unroll") for (int k = 0; k < 2; ++k) dst[n][k] = *(const LAS bf16x8*)(lds + PG8_SB(b, h) + boff + n * 2048 + k * 1024); } while (0)
#define PG8_MMA(ai, bj, At, Bt) do { __builtin_amdgcn_s_setprio(1); _Pragma("unroll") for (int m = 0; m < 4; ++m) _Pragma("unroll") for (int n = 0; n < 2; ++n) _Pragma("unroll") for (int k = 0; k < 2; ++k) \
        acc[ai][bj][m][n] = __builtin_amdgcn_mfma_f32_16x16x32_bf16(Bt[n][k], At[m][k], acc[ai][bj][m][n], 0, 0, 0); __builtin_amdgcn_s_setprio(0); } while (0)
#define PG8_WAIT_V(n) asm volatile("s_waitcnt vmcnt(" #n ")" ::: "memory")
#define PG8_WAIT_L(n) asm volatile("s_waitcnt lgkmcnt(" #n ")" ::: "memory")
#define PG8_BAR __builtin_amdgcn_s_barrier()
#define PG8_SCHED __builtin_amdgcn_sched_barrier(0)
    Unit cur, nxt; int ui = 0;
    if (!S.next(0, cur)) return;
    f32x4 acc[2][2][4][2];
#pragma unroll
    for (int a = 0; a < 2; ++a)
#pragma unroll
        for (int b = 0; b < 2; ++b)
#pragma unroll
            for (int m = 0; m < 4; ++m)
#pragma unroll
                for (int n = 0; n < 2; ++n) acc[a][b][m][n] = (f32x4){0.f, 0.f, 0.f, 0.f};
    bf16x8 At[4][2], B0[2][2], B1[2][2];
    const char* cA = S.aptr(cur, tstep); const char* cB = S.bptr(cur, tstep);
    PG8_STAGE(PG8_SB(0, 0), cB); PG8_STAGE(PG8_SA(0, 0), cA); PG8_STAGE(PG8_SB(0, 1), cB + hstep); PG8_STAGE(PG8_SA(0, 1), cA + hstep);
    if (wr == 1) PG8_BAR;
    PG8_WAIT_V(4); PG8_BAR;
    PG8_STAGE(PG8_SB(1, 0), cB + kstep); PG8_STAGE(PG8_SA(1, 0), cA + kstep); PG8_STAGE(PG8_SB(1, 1), cB + hstep + kstep);
    PG8_WAIT_V(6); PG8_BAR;
    for (;;) {
        const bool has_next = S.next(ui + 1, nxt);
        const char* nA = has_next ? S.aptr(nxt, tstep) : cA; const char* nB = has_next ? S.bptr(nxt, tstep) : cB;
        for (int hf = 0; hf < (Epi::HAS_MID ? 2 : 1); ++hf) {
        const int t_lo = Epi::HAS_MID ? hf * (nt / 2) : 0, t_hi = Epi::HAS_MID ? (hf + 1) * (nt / 2) : nt;
        if constexpr (Epi::HAS_MID) { if (hf == 1) { E.mid(acc, cur, wr, wc, fr, fq); PG8_SCHED; } }
#pragma unroll 1
        for (int t = t_lo; t < t_hi; t += 2) {
            const bool last = (t == nt - 2);
            const char* a1 = cA + (size_t)(t + 1) * kstep;
            const char* a2 = last ? nA : cA + (size_t)(t + 2) * kstep; const char* b2 = last ? nB : cB + (size_t)(t + 2) * kstep;
            const char* a3 = a2 + kstep; const char* b3 = b2 + kstep;
            PG8_LDB(B0, 0, 0); PG8_SCHED; PG8_LDA(At, 0, 0); PG8_STAGE(PG8_SA(1, 1), a1 + hstep);
            PG8_WAIT_L(8); PG8_BAR; PG8_WAIT_L(0); PG8_MMA(0, 0, At, B0); PG8_BAR; PG8_SCHED;
            PG8_LDB(B1, 0, 1); PG8_STAGE(PG8_SB(0, 0), b2);
            PG8_BAR; PG8_WAIT_L(0); PG8_MMA(0, 1, At, B1); PG8_BAR;
            PG8_LDA(At, 0, 1); PG8_STAGE(PG8_SA(0, 0), a2);
            PG8_BAR; PG8_WAIT_L(0); PG8_MMA(1, 0, At, B0); PG8_BAR; PG8_SCHED;
            PG8_STAGE(PG8_SB(0, 1), b2 + hstep);
            PG8_WAIT_V(6); PG8_BAR; PG8_MMA(1, 1, At, B1); PG8_BAR;
            PG8_LDB(B0, 1, 0); PG8_SCHED; PG8_LDA(At, 1, 0); PG8_STAGE(PG8_SA(0, 1), a2 + hstep);
            PG8_WAIT_L(8); PG8_BAR; PG8_WAIT_L(0); PG8_MMA(0, 0, At, B0); PG8_BAR; PG8_SCHED;
            PG8_LDB(B1, 1, 1); PG8_STAGE(PG8_SB(1, 0), b3);
            PG8_BAR; PG8_WAIT_L(0); PG8_MMA(0, 1, At, B1); PG8_BAR;
            PG8_LDA(At, 1, 1); PG8_STAGE(PG8_SA(1, 0), a3);
            PG8_BAR; PG8_WAIT_L(0); PG8_MMA(1, 0, At, B0); PG8_BAR; PG8_SCHED;
            PG8_STAGE(PG8_SB(1, 1), b3 + hstep);
            PG8_WAIT_V(6); PG8_BAR; PG8_MMA(1, 1, At, B1); PG8_BAR;
        }
        }
        E(acc, cur, wr, wc, fr, fq);
        if (!has_next) break;
#pragma unroll
        for (int a = 0; a < 2; ++a)
#pragma unroll
            for (int b = 0; b < 2; ++b)
#pragma unroll
                for (int m = 0; m < 4; ++m)
#pragma unroll
                    for (int n = 0; n < 2; ++n) acc[a][b][m][n] = (f32x4){0.f, 0.f, 0.f, 0.f};
        cur = nxt; cA = nA; cB = nB; ++ui;
    }
    PG8_WAIT_V(0);
    if (wr == 0) PG8_BAR;
    PG8_BAR;
#undef PG8_SA
#undef PG8_SB
#undef PG8_STAGE
#undef PG8_LDA
#undef PG8_LDB
#undef PG8_MMA
#undef PG8_WAIT_V
#undef PG8_WAIT_L
#undef PG8_BAR
#undef PG8_SCHED
}
}

typedef f32x4 AccT[2][2][4][2];
#define EPI_LOOP_ROWS for (int ai = 0; ai < 2; ++ai) _Pragma("unroll") for (int m = 0; m < 4; ++m)
#define EPI_LOOP_COLS for (int bj = 0; bj < 2; ++bj) _Pragma("unroll") for (int n = 0; n < 2; ++n)

struct EpiProj {
    static constexpr bool HAS_MID = false;
    const float* ss0; const float* b_a; bf16_t* proj; float* loga; float* out; bf16_t* kb; bf16_t* vtb;
    __device__ __forceinline__ void operator()(const AccT& acc, const pg8::Unit& u, int wr, int wc, int fr, int fq) const {
        const int row0 = u.pm * 256 + wr * 64 + fr, col0 = u.pn * 256 + wc * 32 + 4 * fq;
        if (u.job == 0) {
            const int pn = u.pn;
            const int kind = (pn == 4) ? 3 : ((pn == 5 || pn == 6 || pn == 11 || pn == 12) ? 1 : (pn >= 13 ? 2 : 0));
            const float sc = (pn == 0 || pn == 8) ? 0.125f : 1.0f;
            float rsv[2][4];
#pragma unroll
            EPI_LOOP_ROWS rsv[ai][m] = ss0[row0 + ai * 128 + m * 16];
#pragma unroll
            EPI_LOOP_ROWS {
                const int row = row0 + ai * 128 + m * 16;
                const float rs = rsqrtf(rsv[ai][m] * (1.0f / 1024.0f) + EPS) * sc;
#pragma unroll
                EPI_LOOP_COLS {
                    const int col = col0 + bj * 128 + n * 16;
                    f32x4 v = acc[ai][bj][m][n] * rs;
                    if (kind == 3) {
                        const f32x4 bb = *(const f32x4*)(b_a + (col - 1024));
                        f32x4 o;
#pragma unroll
                        for (int j = 0; j < 4; ++j) { const float z = v[j] + bb[j]; o[j] = (fminf(z, 0.f) - __logf(1.0f + __expf(-fabsf(z)))) * (1.0f / 16.0f); }
                        *(f32x4*)(loga + (size_t)row * 256 + (col - 1024)) = o;
                    } else {
                        if (kind == 1) {
#pragma unroll
                            for (int j = 0; j < 4; ++j) v[j] = v[j] * sigmoidf_(v[j]);
                        } else if (kind == 2) {
#pragma unroll
                            for (int j = 0; j < 4; ++j) v[j] = sigmoidf_(v[j]);
                        }
                        u32x2 w; w.x = cvt_pk_bf16(v[0], v[1]); w.y = cvt_pk_bf16(v[2], v[3]);
                        *(u32x2*)(proj + (size_t)row * NPROJ + col) = w;
                    }
                }
            }
        } else {
            float rsv[2][4];
#pragma unroll
            EPI_LOOP_ROWS rsv[ai][m] = ss0[M_TOK + row0 + ai * 128 + m * 16];
#pragma unroll
            EPI_LOOP_ROWS {
                const int row = row0 + ai * 128 + m * 16;
                const float rs = rsqrtf(rsv[ai][m] * (1.0f / 1024.0f) + EPS);
#pragma unroll
                EPI_LOOP_COLS {
                    const int col = col0 + bj * 128 + n * 16;
                    const f32x4 v = acc[ai][bj][m][n] * rs;
                    if (col < 1024) {
                        *(f32x4*)(out + OUT_MK + (size_t)row * 1024 + col) = v;
                        u32x2 w; w.x = cvt_pk_bf16(v[0], v[1]); w.y = cvt_pk_bf16(v[2], v[3]);
                        *(u32x2*)(kb + (size_t)row * 1024 + col) = w;
                    } else {
                        const int c = col - 1024;
                        *(f32x4*)(out + OUT_MV + (size_t)row * 1024 + c) = v;
                        const int b = row >> 8, mem = row & 255;
                        const unsigned w0 = cvt_pk_bf16(v[0], v[1]), w1 = cvt_pk_bf16(v[2], v[3]);
                        bf16_t* vt = vtb + ((size_t)b * 1024 + c) * 256 + mem;
                        vt[0] = (bf16_t)(w0 & 0xffff); vt[256] = (bf16_t)(w0 >> 16); vt[512] = (bf16_t)(w1 & 0xffff); vt[768] = (bf16_t)(w1 >> 16);
                    }
                }
            }
        }
    }
};

struct EpiMerge {
    static constexpr bool HAS_MID = true;
    const bf16_t* proj; bf16_t* mrg;
    __device__ __forceinline__ void mid(AccT& acc, const pg8::Unit& u, int wr, int wc, int fr, int fq) const {
        const int row0 = u.pm * 256 + wr * 64 + fr, col0 = u.pn * 256 + wc * 32 + 4 * fq;
#pragma unroll
        for (int ai = 0; ai < 2; ++ai) {
            u32x2 a[4][2][2], b[4][2][2];
#pragma unroll
            for (int m = 0; m < 4; ++m) {
                unsigned roff = (unsigned)(row0 + ai * 128 + m * 16) * (unsigned)NPROJ + (unsigned)col0;
                asm volatile("" : "+v"(roff));
                const bf16_t* rp = proj + roff;
#pragma unroll
                EPI_LOOP_COLS { a[m][bj][n] = *(const u32x2*)(rp + 3328 + bj * 128 + n * 16); b[m][bj][n] = *(const u32x2*)(rp + 4352 + bj * 128 + n * 16); }
            }
#pragma unroll
            for (int m = 0; m < 4; ++m) {
#pragma unroll
                EPI_LOOP_COLS {
                    const u32x2 av = a[m][bj][n], bv = b[m][bj][n];
                    f32x4 r;
                    r[0] = bflo(av.x) * __builtin_amdgcn_rcpf(bflo(bv.x)); r[1] = bfhi(av.x) * __builtin_amdgcn_rcpf(bfhi(bv.x));
                    r[2] = bflo(av.y) * __builtin_amdgcn_rcpf(bflo(bv.y)); r[3] = bfhi(av.y) * __builtin_amdgcn_rcpf(bfhi(bv.y));
                    acc[ai][bj][m][n] *= r;
                }
                asm volatile("" : "+v"(acc[ai][0][m][0]), "+v"(acc[ai][0][m][1]), "+v"(acc[ai][1][m][0]), "+v"(acc[ai][1][m][1]) :: "memory");
            }
        }
    }
    __device__ __forceinline__ void operator()(const AccT& acc, const pg8::Unit& u, int wr, int wc, int fr, int fq) const {
        const int row0 = u.pm * 256 + wr * 64 + fr, col0 = u.pn * 256 + wc * 32 + 4 * fq;
        u32x2 b[2][4][2][2];
#pragma unroll
        EPI_LOOP_ROWS {
            const bf16_t* rp = proj + (size_t)(row0 + ai * 128 + m * 16) * NPROJ + 4352 + col0;
#pragma unroll
            EPI_LOOP_COLS b[ai][m][bj][n] = *(const u32x2*)(rp + bj * 128 + n * 16);
        }
#pragma unroll
        EPI_LOOP_ROWS {
            const int row = row0 + ai * 128 + m * 16;
#pragma unroll
            EPI_LOOP_COLS {
                const int col = col0 + bj * 128 + n * 16;
                const u32x2 bv = b[ai][m][bj][n];
                const f32x4 v = acc[ai][bj][m][n];
                u32x2 w; w.x = cvt_pk_bf16(v[0] * bflo(bv.x), v[1] * bfhi(bv.x)); w.y = cvt_pk_bf16(v[2] * bflo(bv.y), v[3] * bfhi(bv.y));
                *(u32x2*)(mrg + (size_t)row * 1024 + col) = w;
            }
        }
    }
};

struct EpiResid {
    static constexpr bool HAS_MID = false;
    const bf16_t* base; bf16_t* HB; float* SS;
    __device__ __forceinline__ void operator()(const AccT& acc, const pg8::Unit& u, int wr, int wc, int fr, int fq) const {
        const int row0 = u.pm * 256 + wr * 64 + fr, col0 = u.pn * 256 + wc * 32 + 4 * fq;
        u32x2 bv[2][4][2][2];
#pragma unroll
        EPI_LOOP_ROWS {
            const bf16_t* rp = base + (size_t)(row0 + ai * 128 + m * 16) * 1024 + col0;
#pragma unroll
            EPI_LOOP_COLS bv[ai][m][bj][n] = *(const u32x2*)(rp + bj * 128 + n * 16);
        }
#pragma unroll
        EPI_LOOP_ROWS {
            const int row = row0 + ai * 128 + m * 16;
            float s = 0.f;
#pragma unroll
            EPI_LOOP_COLS {
                const int col = col0 + bj * 128 + n * 16;
                const u32x2 b = bv[ai][m][bj][n];
                f32x4 v = acc[ai][bj][m][n];
                v[0] += bflo(b.x); v[1] += bfhi(b.x); v[2] += bflo(b.y); v[3] += bfhi(b.y);
                s += (v[0] * v[0] + v[1] * v[1]) + (v[2] * v[2] + v[3] * v[3]);
                u32x2 w; w.x = cvt_pk_bf16(v[0], v[1]); w.y = cvt_pk_bf16(v[2], v[3]);
                *(u32x2*)(HB + (size_t)row * 1024 + col) = w;
            }
            s += __shfl_xor(s, 16); s += __shfl_xor(s, 32);
            if (fq == 0) SS[(size_t)(u.pn * 4 + wc) * M_TOK + row] = s;
        }
    }
};

struct EpiScale {
    static constexpr bool HAS_MID = false;
    const float* SS; bf16_t* O; int ldo; float sc;
    __device__ __forceinline__ void operator()(const AccT& acc, const pg8::Unit& u, int wr, int wc, int fr, int fq) const {
        const int row0 = u.pm * 256 + wr * 64 + fr, col0 = u.pn * 256 + wc * 32 + 4 * fq;
        float part[2][4];
#pragma unroll
        EPI_LOOP_ROWS {
            const int row = row0 + ai * 128 + m * 16;
            float t = 0.f;
#pragma unroll
            for (int q = 0; q < 4; ++q) t += SS[(size_t)(fq * 4 + q) * M_TOK + row];
            part[ai][m] = t;
        }
#pragma unroll
        EPI_LOOP_ROWS {
            const int row = row0 + ai * 128 + m * 16;
            float ssum = part[ai][m];
            ssum += __shfl_xor(ssum, 16); ssum += __shfl_xor(ssum, 32);
            const float rs = rsqrtf(ssum * (1.0f / 1024.0f) + EPS) * sc;
#pragma unroll
            EPI_LOOP_COLS {
                const int col = col0 + bj * 128 + n * 16;
                const f32x4 v = acc[ai][bj][m][n] * rs;
                u32x2 w; w.x = cvt_pk_bf16(v[0], v[1]); w.y = cvt_pk_bf16(v[2], v[3]);
                *(u32x2*)(O + (size_t)row * ldo + col) = w;
            }
        }
    }
};

struct TJob { const float* src; int ld, c0, tn, K; bf16_t* dst; int Kd, kofs; const float* gain; };
__device__ __forceinline__ void tjob_get(const Params& p, int T, TJob& j, int& tile) {
    unsigned char* ws = p.ws;
    if (T < 256) { j = TJob{p.in[8], 5136, 0, 16, 1024, (bf16_t*)(ws + OFF_WTIN), 1024, 0, p.in[7]}; tile = T; return; }
    T -= 256;
    if (T < 1024) { j = TJob{p.in[8], 5136, 1040, 64, 1024, (bf16_t*)(ws + OFF_WTIN) + (size_t)1280 * 1024, 1024, 0, p.in[7]}; tile = T; return; }
    T -= 1024;
    if (T < 128) { j = TJob{p.in[13], 1024, 0, 16, 512, (bf16_t*)(ws + OFF_WTP), 1024, 0, nullptr}; tile = T; return; }
    T -= 128;
    if (T < 128) { j = TJob{p.in[14], 1024, 0, 16, 512, (bf16_t*)(ws + OFF_WTP), 1024, 512, nullptr}; tile = T; return; }
    T -= 128;
    if (T < 256) { j = TJob{p.in[15], 1024, 0, 16, 1024, (bf16_t*)(ws + OFF_WTO), 1024, 0, nullptr}; tile = T; return; }
    T -= 256;
    if (T < 256) { j = TJob{p.in[18], 1024, 0, 16, 1024, (bf16_t*)(ws + OFF_WTXQ), 1024, 0, p.in[16]}; tile = T; return; }
    T -= 256;
    if (T < 256) { j = TJob{p.in[19], 1024, 0, 16, 1024, (bf16_t*)(ws + OFF_WTKV), 1024, 0, p.in[17]}; tile = T; return; }
    T -= 256;
    if (T < 256) { j = TJob{p.in[20], 1024, 0, 16, 1024, (bf16_t*)(ws + OFF_WTKV) + (size_t)1024 * 1024, 1024, 0, p.in[17]}; tile = T; return; }
    T -= 256;
    if (T < 256) { j = TJob{p.in[21], 1024, 0, 16, 1024, (bf16_t*)(ws + OFF_WTXO), 1024, 0, nullptr}; tile = T; return; }
    T -= 256;
    j = TJob{p.in[23], 2048, 0, 32, 1024, (bf16_t*)(ws + OFF_WTPQ), 1024, 0, p.in[22]}; tile = T;
}
constexpr int N_TTILES = 256 + 1024 + 128 + 128 + 256 * 5 + 512;

__device__ void phase_prep(const Params& p, LAS unsigned char* lds) {
    int tid_ = threadIdx.x; asm volatile("" : "+v"(tid_)); const int tid = tid_, lane = tid & 63, wid = tid >> 6;
    const int gw = blockIdx.x * 8 + wid, nw = gridDim.x * 8;
    const size_t gt = (size_t)blockIdx.x * NTHR + tid, ngt = (size_t)gridDim.x * NTHR;
    unsigned char* ws = p.ws;
    {
        bf16_t* A0 = (bf16_t*)(ws + OFF_A0); float* ss0 = (float*)(ws + OFF_SS0);
        for (int r = gw; r < M_ALL; r += nw) {
            const float* src = r < M_PR ? p.in[0] + (size_t)r * 1024 : (r < M_TOK ? p.in[1] + (size_t)(r - M_PR) * 1024 : p.in[2] + (size_t)(r - M_TOK) * 1024);
            float s = 0.f;
#pragma unroll
            for (int i = 0; i < 4; ++i) {
                const f32x4 v = *(const f32x4*)(src + i * 256 + lane * 4);
                s += (v[0] * v[0] + v[1] * v[1]) + (v[2] * v[2] + v[3] * v[3]);
                u32x2 w; w.x = cvt_pk_bf16(v[0], v[1]); w.y = cvt_pk_bf16(v[2], v[3]);
                *(u32x2*)(A0 + (size_t)r * 1024 + i * 256 + lane * 4) = w;
            }
            s = wave_sum(s);
            if (lane == 0) ss0[r] = s;
        }
    }
    { float* z = (float*)(ws + OFF_SS1); for (size_t i = gt; i < (size_t)2 * M_TOK; i += ngt) z[i] = 0.f; }
    {
        const size_t n_sk = (size_t)8 * 2 * 128 * 128 / 8;
        for (size_t k = gt; k < n_sk; k += ngt) {
            const float* src = p.in[24]; bf16_t* dst = (bf16_t*)(ws + OFF_SKB);
            const f32x4 a = *(const f32x4*)(src + k * 8), b = *(const f32x4*)(src + k * 8 + 4);
            u32x4 w; w.x = cvt_pk_bf16(a[0], a[1]); w.y = cvt_pk_bf16(a[2], a[3]); w.z = cvt_pk_bf16(b[0], b[1]); w.w = cvt_pk_bf16(b[2], b[3]);
            *(u32x4*)(dst + k * 8) = w;
        }
        const size_t n_u = (size_t)16384 * 1024 / 16;
        for (size_t i = gt; i < 2 * n_u; i += ngt) {
            const bool isv = i >= n_u; const size_t k = isv ? i - n_u : i;
            const float* src = (isv ? p.in[26] : p.in[25]) + k * 16; unsigned char* dst = ws + (isv ? OFF_VB : OFF_UB) + k * 16;
            const float sc = isv ? 64.0f : 1024.0f;
            u32x4 w;
#pragma unroll
            for (int q = 0; q < 4; ++q) {
                f32x4 a = *(const f32x4*)(src + q * 4) * sc;
#pragma unroll
                for (int e = 0; e < 4; ++e) a[e] = fminf(fmaxf(a[e], -448.0f), 448.0f);
                int t = 0;
                t = __builtin_amdgcn_cvt_pk_fp8_f32(a[0], a[1], t, false);
                t = __builtin_amdgcn_cvt_pk_fp8_f32(a[2], a[3], t, true);
                w[q] = (unsigned)t;
            }
            *(u32x4*)dst = w;
        }
    }
    {
        const float* w_in = p.in[8]; const float* w_a2 = p.in[9]; const float* g = p.in[7];
        bf16_t* dst = (bf16_t*)(ws + OFF_WTIN) + (size_t)1024 * 1024;
        for (size_t i = gt; i < (size_t)256 * 128; i += ngt) {
            const int j = (int)(i >> 7), k0 = (int)(i & 127) * 8;
            float wa[16];
#pragma unroll
            for (int r = 0; r < 16; ++r) wa[r] = w_a2[r * 256 + j];
            float o[8];
#pragma unroll
            for (int e = 0; e < 8; ++e) {
                const float* wr_ = w_in + (size_t)(k0 + e) * 5136 + 1024;
                float s = 0.f;
#pragma unroll
                for (int r4 = 0; r4 < 4; ++r4) { const f32x4 v = *(const f32x4*)(wr_ + r4 * 4); s += v[0] * wa[r4 * 4] + v[1] * wa[r4 * 4 + 1] + v[2] * wa[r4 * 4 + 2] + v[3] * wa[r4 * 4 + 3]; }
                o[e] = s * g[k0 + e];
            }
            u32x4 w; w.x = cvt_pk_bf16(o[0], o[1]); w.y = cvt_pk_bf16(o[2], o[3]); w.z = cvt_pk_bf16(o[4], o[5]); w.w = cvt_pk_bf16(o[6], o[7]);
            *(u32x4*)(dst + (size_t)j * 1024 + k0) = w;
        }
    }
    {
        LAS float* tl = (LAS float*)lds;
        const int kr = tid >> 4, nc = (tid & 15) * 4;
        if ((int)blockIdx.x < N_TTILES) {
            TJob jn; int tilen; tjob_get(p, blockIdx.x, jn, tilen);
            f32x4 nv[2]; float ng[2];
#define PREP_TLOAD() do { const int k0_ = (tilen / jn.tn) * 64, n0_ = (tilen % jn.tn) * 64; \
                _Pragma("unroll") for (int pp_ = 0; pp_ < 2; ++pp_) { const int k_ = k0_ + kr + 32 * pp_; \
                    nv[pp_] = *(const f32x4*)(jn.src + (size_t)k_ * jn.ld + jn.c0 + n0_ + nc); ng[pp_] = jn.gain ? jn.gain[k_] : 1.0f; } } while (0)
            PREP_TLOAD();
            for (int T = blockIdx.x; T < N_TTILES; T += gridDim.x) {
                const TJob j = jn; const int tile = tilen;
                const f32x4 v0 = nv[0] * ng[0], v1 = nv[1] * ng[1];
                if (T + (int)gridDim.x < N_TTILES) tjob_get(p, T + gridDim.x, jn, tilen);
                PREP_TLOAD();
                const int tk = tile / j.tn, tnn = tile % j.tn, k0 = tk * 64, n0 = tnn * 64;
                {
                    LAS float* d = tl + kr * 65 + nc;
                    d[0] = v0[0]; d[1] = v0[1]; d[2] = v0[2]; d[3] = v0[3];
                    d += 32 * 65;
                    d[0] = v1[0]; d[1] = v1[1]; d[2] = v1[2]; d[3] = v1[3];
                }
                __syncthreads();
                {
                    const int n = tid >> 3, kq = (tid & 7) * 8;
                    float o[8];
#pragma unroll
                    for (int e = 0; e < 8; ++e) o[e] = tl[(kq + e) * 65 + n];
                    u32x4 w; w.x = cvt_pk_bf16(o[0], o[1]); w.y = cvt_pk_bf16(o[2], o[3]); w.z = cvt_pk_bf16(o[4], o[5]); w.w = cvt_pk_bf16(o[6], o[7]);
                    *(u32x4*)(j.dst + (size_t)(n0 + n) * j.Kd + j.kofs + k0 + kq) = w;
                }
                __syncthreads();
            }
#undef PREP_TLOAD
        }
    }
}

#define MFMA16(a, b, c) __builtin_amdgcn_mfma_f32_16x16x32_bf16((a), (b), (c), 0, 0, 0)
__device__ __forceinline__ float scan64(float v, int lane) {
#pragma unroll
    for (int o = 1; o < 64; o <<= 1) { const float t = __shfl_up(v, o); if (lane >= o) v += t; }
    return v;
}
__device__ void phase_scan(const Params& p, LAS unsigned char* lds) {
    int tid_ = threadIdx.x; asm volatile("" : "+v"(tid_)); const int tid = tid_, lane = tid & 63, wid = tid >> 6, fr = lane & 15, fq = lane >> 4;
    const bf16_t* proj = (const bf16_t*)(p.ws + OFF_PROJ); const float* loga = (const float*)(p.ws + OFF_LOGA);
    float* omix = (float*)(p.ws + OFF_X);
    constexpr int P = 72;
    for (int u = blockIdx.x; u < 256; u += gridDim.x) {
        const int vs = u & 3, mx = (u >> 2) & 1, h = (u >> 3) & 3, b = u >> 5;
        const int qoff = (mx ? 1792 : 0) + h * 64, koff = (mx ? 2048 : 256) + h * 64, voff = (mx ? 2304 : 512) + h * 128 + vs * 32;
        const float lg = log1pf(-exp2f(-5.0f - (float)h));
        float inv[4];
#pragma unroll
        for (int e = 0; e < 4; ++e) inv[e] = exp2f(-(float)(4 * wid + e) * (13.287712379549449f / 32.0f));
        f32x4 sacc = (f32x4){0.f, 0.f, 0.f, 0.f};
        LAS bf16_t* QE = (LAS bf16_t*)lds; LAS bf16_t* KE = (LAS bf16_t*)(lds + 9216);
        LAS bf16_t* ATT = (LAS bf16_t*)(lds + 18432);
        LAS bf16_t* ST = (LAS bf16_t*)(lds + 27648);
        for (int i = tid; i < 32 * P; i += NTHR) ST[i] = 0;
        const int ct = wid >> 2, w4 = wid & 3;
        u32x2 rq0, rq1, rk0, rk1, rv; f32x4 rl0 = (f32x4){0.f, 0.f, 0.f, 0.f}, rl1 = rl0;
        u32x4 gq, gk, gv = (u32x4){0u, 0u, 0u, 0u}; f32x4 gl0 = (f32x4){0.f, 0.f, 0.f, 0.f}, gl1 = gl0;
#define SCAN_RAW(bi) (lds + 61440 + (bi) * 40960)
#define SCAN_STAGE_LOAD(ch) do { const size_t tb_ = (size_t)b * 2048 + (ch) * 64; \
            gq = *(const u32x4*)(proj + (tb_ + (tid >> 3)) * NPROJ + qoff + (tid & 7) * 8); gk = *(const u32x4*)(proj + (tb_ + (tid >> 3)) * NPROJ + koff + (tid & 7) * 8); \
            if (tid < 256) gv = *(const u32x4*)(proj + (tb_ + (tid >> 2)) * NPROJ + voff + (tid & 3) * 8); \
            if (!mx) { gl0 = *(const f32x4*)(loga + (tb_ + (tid >> 4)) * 256 + h * 64 + (tid & 15) * 4); gl1 = *(const f32x4*)(loga + (tb_ + 32 + (tid >> 4)) * 256 + h * 64 + (tid & 15) * 4); } } while (0)
#define SCAN_STAGE_WRITE(bi) do { LAS unsigned char* r_ = SCAN_RAW(bi); \
            *(LAS u32x4*)(r_ + (tid >> 3) * 144 + (tid & 7) * 16) = gq; *(LAS u32x4*)(r_ + 9216 + (tid >> 3) * 144 + (tid & 7) * 16) = gk; \
            if (tid < 256) *(LAS u32x4*)(r_ + 18432 + (tid >> 2) * 80 + (tid & 3) * 16) = gv; \
            if (!mx) { *(LAS f32x4*)(r_ + 23552 + (tid >> 4) * 272 + (tid & 15) * 16) = gl0; *(LAS f32x4*)(r_ + 23552 + (32 + (tid >> 4)) * 272 + (tid & 15) * 16) = gl1; } } while (0)
#define SCAN_READ_RAW(bi) do { const LAS unsigned char* r_ = SCAN_RAW(bi); \
            rq0 = *(const LAS u32x2*)(r_ + lane * 144 + 8 * wid); rq1 = *(const LAS u32x2*)(r_ + lane * 144 + 64 + 8 * wid); \
            rk0 = *(const LAS u32x2*)(r_ + 9216 + lane * 144 + 8 * wid); rk1 = *(const LAS u32x2*)(r_ + 9216 + lane * 144 + 64 + 8 * wid); \
            rv = *(const LAS u32x2*)(r_ + 18432 + lane * 80 + 8 * wid); \
            if (!mx) { rl0 = *(const LAS f32x4*)(r_ + 23552 + lane * 272 + 16 * wid); rl1 = *(const LAS f32x4*)(r_ + 23552 + lane * 272 + 128 + 16 * wid); } } while (0)
        SCAN_STAGE_LOAD(0); SCAN_STAGE_WRITE(0); SCAN_STAGE_LOAD(1);
        __syncthreads();
        for (int ch = 0; ch < 32; ++ch) {
            SCAN_READ_RAW(ch & 1);
            LAS unsigned char* buf = lds + 32256 + (ch & 1) * 14336;
            LAS bf16_t* KDT = (LAS bf16_t*)buf; LAS bf16_t* VT = (LAS bf16_t*)(buf + 9216); LAS float* DL = (LAS float*)(buf + 13824);
            {
                float qa[4] = {bflo(rq0.x), bfhi(rq0.x), bflo(rq0.y), bfhi(rq0.y)}, qb[4] = {bflo(rq1.x), bfhi(rq1.x), bflo(rq1.y), bfhi(rq1.y)};
                float ka[4] = {bflo(rk0.x), bfhi(rk0.x), bflo(rk0.y), bfhi(rk0.y)}, kb[4] = {bflo(rk1.x), bfhi(rk1.x), bflo(rk1.y), bfhi(rk1.y)};
                float ba[4], bb[4], la[4], lb[4];
                if (mx) {
                    const float pos = (float)(ch * 64 + lane);
#pragma unroll
                    for (int e = 0; e < 4; ++e) {
                        float sn, cs; sincosf(pos * inv[e], &sn, &cs);
                        const float q1 = qa[e], q2 = qb[e], k1 = ka[e], k2 = kb[e];
                        qa[e] = q1 * cs - q2 * sn; qb[e] = q1 * sn + q2 * cs; ka[e] = k1 * cs - k2 * sn; kb[e] = k1 * sn + k2 * cs;
                        ba[e] = bb[e] = (float)(lane + 1) * lg; la[e] = lb[e] = 64.0f * lg;
                    }
                } else {
#pragma unroll
                    for (int e = 0; e < 4; ++e) { ba[e] = scan64(rl0[e], lane); bb[e] = scan64(rl1[e], lane); la[e] = __shfl(ba[e], 63); lb[e] = __shfl(bb[e], 63); }
                }
                float qea[4], qeb[4], kea[4], keb[4];
#pragma unroll
                for (int e = 0; e < 4; ++e) {
                    qea[e] = qa[e] * __expf(ba[e]); qeb[e] = qb[e] * __expf(bb[e]);
                    kea[e] = ka[e] * __expf(-ba[e]); keb[e] = kb[e] * __expf(-bb[e]);
                    const float kda = ka[e] * __expf(la[e] - ba[e]), kdb = kb[e] * __expf(lb[e] - bb[e]);
                    KDT[(4 * wid + e) * P + lane] = (bf16_t)(cvt_pk_bf16(kda, 0.f) & 0xffff);
                    KDT[(32 + 4 * wid + e) * P + lane] = (bf16_t)(cvt_pk_bf16(kdb, 0.f) & 0xffff);
                    if (lane == 63) { DL[4 * wid + e] = __expf(la[e]); DL[32 + 4 * wid + e] = __expf(lb[e]); }
                }
                u32x2 w;
                w.x = cvt_pk_bf16(qea[0], qea[1]); w.y = cvt_pk_bf16(qea[2], qea[3]); *(LAS u32x2*)(QE + lane * P + 4 * wid) = w;
                w.x = cvt_pk_bf16(qeb[0], qeb[1]); w.y = cvt_pk_bf16(qeb[2], qeb[3]); *(LAS u32x2*)(QE + lane * P + 32 + 4 * wid) = w;
                w.x = cvt_pk_bf16(kea[0], kea[1]); w.y = cvt_pk_bf16(kea[2], kea[3]); *(LAS u32x2*)(KE + lane * P + 4 * wid) = w;
                w.x = cvt_pk_bf16(keb[0], keb[1]); w.y = cvt_pk_bf16(keb[2], keb[3]); *(LAS u32x2*)(KE + lane * P + 32 + 4 * wid) = w;
                VT[(4 * wid + 0) * P + lane] = (bf16_t)(rv.x & 0xffff); VT[(4 * wid + 1) * P + lane] = (bf16_t)(rv.x >> 16);
                VT[(4 * wid + 2) * P + lane] = (bf16_t)(rv.y & 0xffff); VT[(4 * wid + 3) * P + lane] = (bf16_t)(rv.y >> 16);
            }
            SCAN_STAGE_WRITE((ch + 1) & 1);
            { const int chn = (ch + 2 < 32) ? ch + 2 : 31; SCAN_STAGE_LOAD(chn); }
            __syncthreads();
            f32x4 oacc = (f32x4){0.f, 0.f, 0.f, 0.f};
            {
#pragma unroll
                for (int q = 0; q < 2; ++q) {
                    const int idx = wid * 2 + q, sb = idx >> 2, tb = idx & 3;
                    f32x4 a = (f32x4){0.f, 0.f, 0.f, 0.f};
                    if (sb <= tb) {
#pragma unroll
                        for (int ks = 0; ks < 2; ++ks) {
                            const bf16x8 A = *(const LAS bf16x8*)(KE + (sb * 16 + fr) * P + ks * 32 + fq * 8);
                            const bf16x8 B = *(const LAS bf16x8*)(QE + (tb * 16 + fr) * P + ks * 32 + fq * 8);
                            a = MFMA16(A, B, a);
                        }
                        const int tg = tb * 16 + fr, sg = sb * 16 + fq * 4;
#pragma unroll
                        for (int jj = 0; jj < 4; ++jj) if (sg + jj > tg) a[jj] = 0.f;
                    }
                    u32x2 w; w.x = cvt_pk_bf16(a[0], a[1]); w.y = cvt_pk_bf16(a[2], a[3]);
                    *(LAS u32x2*)(ATT + (tb * 16 + fr) * P + sb * 16 + fq * 4) = w;
                }
#pragma unroll
                for (int ks = 0; ks < 2; ++ks) {
#ifdef TEST_ST
                    const bf16x8 A = *(const LAS bf16x8*)(VT + (ct * 16 + fr) * P + ks * 32 + fq * 8);
#else
                    const bf16x8 A = *(const LAS bf16x8*)(ST + (ct * 16 + fr) * P + ks * 32 + fq * 8);
#endif
#ifdef TEST_ST
                    const bf16x8 B = *(const LAS bf16x8*)(KDT + (w4 * 16 + fr) * P + ks * 32 + fq * 8);
#else
                    const bf16x8 B = *(const LAS bf16x8*)(QE + (w4 * 16 + fr) * P + ks * 32 + fq * 8);
#endif
                    oacc = MFMA16(A, B, oacc);
                }
            }
            __syncthreads();
            {
                bf16x8 Av[2];
#pragma unroll
                for (int ks = 0; ks < 2; ++ks) Av[ks] = *(const LAS bf16x8*)(VT + (ct * 16 + fr) * P + ks * 32 + fq * 8);
#pragma unroll
                for (int ks = 0; ks < 2; ++ks) {
                    const bf16x8 B = *(const LAS bf16x8*)(ATT + (w4 * 16 + fr) * P + ks * 32 + fq * 8);
#ifndef NO_ATT
                    oacc = MFMA16(Av[ks], B, oacc);
#endif
                }
                const size_t tok = (size_t)b * 2048 + ch * 64 + w4 * 16 + fr;
                *(f32x4*)(omix + tok * 1024 + mx * 512 + h * 128 + vs * 32 + ct * 16 + fq * 4) = oacc;
                const float d = DL[w4 * 16 + fr];
                sacc *= d;
#pragma unroll
                for (int ks = 0; ks < 2; ++ks) {
                    const bf16x8 B = *(const LAS bf16x8*)(KDT + (w4 * 16 + fr) * P + ks * 32 + fq * 8);
                    sacc = MFMA16(Av[ks], B, sacc);
                }
                const unsigned w0 = cvt_pk_bf16(sacc[0], sacc[1]), w1 = cvt_pk_bf16(sacc[2], sacc[3]);
                LAS bf16_t* sp = ST + (ct * 16 + fq * 4) * P + w4 * 16 + fr;
                sp[0] = (bf16_t)(w0 & 0xffff); sp[P] = (bf16_t)(w0 >> 16); sp[2 * P] = (bf16_t)(w1 & 0xffff); sp[3 * P] = (bf16_t)(w1 >> 16);
            }
        }
        *(f32x4*)(p.out + (mx ? OUT_RETP : OUT_GLAP) + ((size_t)(b * 4 + h) * 64 + w4 * 16 + fr) * 128 + vs * 32 + ct * 16 + fq * 4) = sacc;
        __syncthreads();
#undef SCAN_RAW
#undef SCAN_STAGE_LOAD
#undef SCAN_STAGE_WRITE
#undef SCAN_READ_RAW
    }
    {
        LAS float* qv = (LAS float*)lds; LAS float* kv = qv + 256; LAS float* av = kv + 256; LAS float* red = av + 256;
        for (int su = blockIdx.x; su < 1024; su += gridDim.x) {
            const int mx = su & 1, h = (su >> 1) & 3, b = su >> 3;
            const int qoff = (mx ? 1792 : 0) + h * 64, koff = (mx ? 2048 : 256) + h * 64, voff = (mx ? 2304 : 512) + h * 128;
            if (tid < 256) {
                const int t = tid >> 6, k = tid & 63; const size_t tok = (size_t)M_PR + b * 4 + t; const bf16_t* base = proj + tok * NPROJ;
                float q, kk, a;
                if (mx) {
                    const int j = k & 31;
                    const float q1 = bf2f(base[qoff + j]), q2 = bf2f(base[qoff + 32 + j]), k1 = bf2f(base[koff + j]), k2 = bf2f(base[koff + 32 + j]);
                    const float ang = (float)(16384 + t) * exp2f(-(float)j * (13.287712379549449f / 32.0f));
                    float sn, cs; sincosf(ang, &sn, &cs);
                    if (k < 32) { q = q1 * cs - q2 * sn; kk = k1 * cs - k2 * sn; } else { q = q1 * sn + q2 * cs; kk = k1 * sn + k2 * cs; }
                    a = 1.0f - exp2f(-5.0f - (float)h);
                } else { q = bf2f(base[qoff + k]); kk = bf2f(base[koff + k]); a = __expf(loga[tok * 256 + h * 64 + k]); }
                qv[tid] = q; kv[tid] = kk; av[tid] = a;
            }
            __syncthreads();
            const int v = tid & 127, kg = tid >> 7;
            const float* sin_ = (mx ? p.in[4] : p.in[3]) + ((size_t)(b * 4 + h) * 64 + kg * 16) * 128 + v;
            float S[16];
#pragma unroll
            for (int i = 0; i < 16; ++i) S[i] = sin_[(size_t)i * 128];
#pragma unroll
            for (int t = 0; t < 4; ++t) {
                const float vt = bf2f(proj[((size_t)M_PR + b * 4 + t) * NPROJ + voff + v]);
                float part = 0.f;
#pragma unroll
                for (int i = 0; i < 16; ++i) { const int k = t * 64 + kg * 16 + i; S[i] = av[k] * S[i] + kv[k] * vt; part += qv[k] * S[i]; }
                red[(t * 4 + kg) * 128 + v] = part;
            }
            float* sout = p.out + (mx ? OUT_RETS : OUT_GLAS) + ((size_t)(b * 4 + h) * 64 + kg * 16) * 128 + v;
#pragma unroll
            for (int i = 0; i < 16; ++i) sout[(size_t)i * 128] = S[i];
            __syncthreads();
            {
                const int t = tid >> 7;
                const float o = (red[(t * 4 + 0) * 128 + v] + red[(t * 4 + 1) * 128 + v]) + (red[(t * 4 + 2) * 128 + v] + red[(t * 4 + 3) * 128 + v]);
                omix[((size_t)M_PR + b * 4 + t) * 1024 + mx * 512 + h * 128 + v] = o;
            }
            __syncthreads();
        }
    }
}

__device__ void phase_onorm(const Params& p) {
    int tid_ = threadIdx.x; asm volatile("" : "+v"(tid_)); const int tid = tid_, lane = tid & 63, wid = tid >> 6;
    const bf16_t* proj = (const bf16_t*)(p.ws + OFF_PROJ); const float* omix = (const float*)(p.ws + OFF_X); bf16_t* a2 = (bf16_t*)(p.ws + OFF_A2);
    for (int wt = blockIdx.x * 8 + wid; wt < M_TOK * 2; wt += gridDim.x * 8) {
        const int tok = wt >> 1, mx = wt & 1, c = lane * 8;
        const f32x4 o0 = *(const f32x4*)(omix + (size_t)tok * 1024 + mx * 512 + c), o1 = *(const f32x4*)(omix + (size_t)tok * 1024 + mx * 512 + c + 4);
        float ss = (o0[0] * o0[0] + o0[1] * o0[1]) + (o0[2] * o0[2] + o0[3] * o0[3]) + (o1[0] * o1[0] + o1[1] * o1[1]) + (o1[2] * o1[2] + o1[3] * o1[3]);
        ss += __shfl_xor(ss, 1); ss += __shfl_xor(ss, 2); ss += __shfl_xor(ss, 4); ss += __shfl_xor(ss, 8);
        const float r = rsqrtf(ss * (1.0f / 128.0f) + EPS);
        const float* g = (mx ? p.in[12] : p.in[11]) + c;
        const f32x4 g0 = *(const f32x4*)g, g1 = *(const f32x4*)(g + 4);
        const u32x4 gt = *(const u32x4*)(proj + (size_t)tok * NPROJ + (mx ? 2816 : 1280) + c);
        u32x4 w;
        w.x = cvt_pk_bf16(o0[0] * r * g0[0] * bflo(gt.x), o0[1] * r * g0[1] * bfhi(gt.x));
        w.y = cvt_pk_bf16(o0[2] * r * g0[2] * bflo(gt.y), o0[3] * r * g0[3] * bfhi(gt.y));
        w.z = cvt_pk_bf16(o1[0] * r * g1[0] * bflo(gt.z), o1[1] * r * g1[1] * bfhi(gt.z));
        w.w = cvt_pk_bf16(o1[2] * r * g1[2] * bflo(gt.w), o1[3] * r * g1[3] * bfhi(gt.w));
        *(u32x4*)(a2 + (size_t)tok * 1024 + mx * 512 + c) = w;
    }
}

__device__ void phase_attn(const Params& p, LAS unsigned char* lds) {
    int tid_ = threadIdx.x; asm volatile("" : "+v"(tid_)); const int tid = tid_, lane = tid & 63, wid = tid >> 6, fr = lane & 15, fq = lane >> 4;
    const bf16_t* Q = (const bf16_t*)(p.ws + OFF_Q); const bf16_t* KB = (const bf16_t*)(p.ws + OFF_KB); const bf16_t* VTB = (const bf16_t*)(p.ws + OFF_VTB);
    bf16_t* AO = (bf16_t*)(p.ws + OFF_AO);
    const bool sample_first = (blockIdx.x & 8) != 0;
#pragma unroll 1
    for (int part = 0; part < 2; ++part) {
    if ((part == 0) != sample_first) {
    constexpr int KP = 528;
    for (int du0 = blockIdx.x; du0 < 256; du0 += gridDim.x) {
        int du = du0;
        if (gridDim.x == 256) { const int xcd = du0 & 7, slot = du0 >> 3; du = (xcd * 4 + (slot >> 3)) * 8 + (slot & 7); }
        const int q8 = du & 7, h = (du >> 3) & 3, b = du >> 5;
        {
            const bf16_t* src = KB + (size_t)b * 256 * 1024 + h * 256 + (tid & 31) * 8;
#pragma unroll 2
            for (int ps = 0; ps < 16; ++ps) {
                const int r = ps * 16 + (tid >> 5);
                *(LAS u32x4*)(lds + r * KP + (tid & 31) * 16) = *(const u32x4*)(src + (size_t)r * 1024);
            }
        }
        __syncthreads();
        bf16x8 pf[2][8]; float rinv2[2];
#pragma unroll
        for (int sub = 0; sub < 2; ++sub) {
            const size_t row0 = (size_t)b * 2048 + q8 * 256 + sub * 128 + wid * 16;
            bf16x8 qf[8];
#pragma unroll
            for (int ks = 0; ks < 8; ++ks) qf[ks] = *(const bf16x8*)(Q + (row0 + fr) * 1024 + h * 256 + ks * 32 + fq * 8);
            float mxv = -3.0e38f;
#pragma unroll 2
            for (int mb = 0; mb < 16; ++mb) {
                f32x4 a = (f32x4){0.f, 0.f, 0.f, 0.f};
#pragma unroll
                for (int ks = 0; ks < 8; ++ks) a = MFMA16(*(const LAS bf16x8*)(lds + (mb * 16 + fr) * KP + ks * 64 + fq * 16), qf[ks], a);
                mxv = fmaxf(fmaxf(mxv, fmaxf(a[0], a[1])), fmaxf(a[2], a[3]));
                asm volatile("" ::: "memory");
            }
            mxv = fmaxf(mxv, __shfl_xor(mxv, 16)); mxv = fmaxf(mxv, __shfl_xor(mxv, 32));
            float sm = 0.f;
#pragma unroll
            for (int kk = 0; kk < 8; ++kk) {
                f32x4 a0 = (f32x4){0.f, 0.f, 0.f, 0.f}, a1 = a0;
#pragma unroll
                for (int ks = 0; ks < 8; ++ks) {
                    a0 = MFMA16(*(const LAS bf16x8*)(lds + ((2 * kk) * 16 + fr) * KP + ks * 64 + fq * 16), qf[ks], a0);
                    a1 = MFMA16(*(const LAS bf16x8*)(lds + ((2 * kk + 1) * 16 + fr) * KP + ks * 64 + fq * 16), qf[ks], a1);
                }
#pragma unroll
                for (int jj = 0; jj < 4; ++jj) { a0[jj] = __expf(a0[jj] - mxv); a1[jj] = __expf(a1[jj] - mxv); sm += a0[jj] + a1[jj]; }
                u32x4 w; w.x = cvt_pk_bf16(a0[0], a0[1]); w.y = cvt_pk_bf16(a0[2], a0[3]); w.z = cvt_pk_bf16(a1[0], a1[1]); w.w = cvt_pk_bf16(a1[2], a1[3]);
                pf[sub][kk] = __builtin_bit_cast(bf16x8, w);
                asm volatile("" ::: "memory");
            }
            sm += __shfl_xor(sm, 16); sm += __shfl_xor(sm, 32);
            rinv2[sub] = 1.0f / sm;
        }
        __syncthreads();
        {
            const bf16_t* src = VTB + ((size_t)b * 1024 + h * 256) * 256 + (tid & 31) * 8;
#pragma unroll 2
            for (int ps = 0; ps < 16; ++ps) {
                const int r = ps * 16 + (tid >> 5);
                *(LAS u32x4*)(lds + r * KP + (tid & 31) * 16) = *(const u32x4*)(src + (size_t)r * 256);
            }
        }
        __syncthreads();
        {
            const size_t rowA = (size_t)b * 2048 + q8 * 256 + wid * 16 + fr;
#pragma unroll 1
            for (int db = 0; db < 16; ++db) {
                f32x4 a0 = (f32x4){0.f, 0.f, 0.f, 0.f}, a1 = a0;
#pragma unroll
                for (int kk = 0; kk < 8; ++kk) {
                    const LAS unsigned char* vp = lds + (db * 16 + fr) * KP + (kk * 32 + fq * 4) * 2;
                    const u32x2 lo = *(const LAS u32x2*)vp, hi = *(const LAS u32x2*)(vp + 32);
                    u32x4 w; w.x = lo.x; w.y = lo.y; w.z = hi.x; w.w = hi.y;
                    const bf16x8 vf = __builtin_bit_cast(bf16x8, w);
                    a0 = MFMA16(vf, pf[0][kk], a0); a1 = MFMA16(vf, pf[1][kk], a1);
                }
                a0 *= rinv2[0]; a1 *= rinv2[1];
                u32x2 w0, w1; w0.x = cvt_pk_bf16(a0[0], a0[1]); w0.y = cvt_pk_bf16(a0[2], a0[3]); w1.x = cvt_pk_bf16(a1[0], a1[1]); w1.y = cvt_pk_bf16(a1[2], a1[3]);
                *(u32x2*)(AO + rowA * 1024 + h * 256 + db * 16 + fq * 4) = w0;
                *(u32x2*)(AO + (rowA + 128) * 1024 + h * 256 + db * 16 + fq * 4) = w1;
                asm volatile("" ::: "memory");
            }
        }
        __syncthreads();
    }
    } else {
    {
        LAS float* sc = (LAS float*)lds;
        LAS float* red = sc + 2048;
        const float* CK = p.in[5]; const float* CV = p.in[6];
        for (int u = blockIdx.x; u < 256; u += gridDim.x) {
            const int b = u >> 1, hp = u & 1;
            float qr[4][2][4];
#pragma unroll
            for (int t = 0; t < 4; ++t)
#pragma unroll
                for (int hh = 0; hh < 2; ++hh) {
                    const u32x2 w = *(const u32x2*)(Q + ((size_t)M_PR + b * 4 + t) * 1024 + (hp * 2 + hh) * 256 + lane * 4);
                    qr[t][hh][0] = bflo(w.x); qr[t][hh][1] = bfhi(w.x); qr[t][hh][2] = bflo(w.y); qr[t][hh][3] = bfhi(w.y);
                }
            for (int mi = 0; mi < 32; mi += 4) {
                f32x4 kr[4][2];
#pragma unroll
                for (int i = 0; i < 4; ++i)
#pragma unroll
                    for (int hh = 0; hh < 2; ++hh) kr[i][hh] = *(const f32x4*)(CK + (((size_t)b * 256 + wid * 32 + mi + i) * 4 + hp * 2 + hh) * 256 + lane * 4);
#pragma unroll
                for (int i = 0; i < 4; ++i)
#pragma unroll
                    for (int hh = 0; hh < 2; ++hh)
#pragma unroll
                        for (int t = 0; t < 4; ++t) {
                            float s = kr[i][hh][0] * qr[t][hh][0] + kr[i][hh][1] * qr[t][hh][1] + kr[i][hh][2] * qr[t][hh][2] + kr[i][hh][3] * qr[t][hh][3];
                            s = wave_sum(s);
                            if (lane == 0) sc[(t * 2 + hh) * 256 + wid * 32 + mi + i] = s;
                        }
            }
            __syncthreads();
            {
                LAS float* r = sc + wid * 256;
                float v0 = r[lane], v1 = r[lane + 64], v2 = r[lane + 128], v3 = r[lane + 192];
                float m = fmaxf(fmaxf(v0, v1), fmaxf(v2, v3));
#pragma unroll
                for (int o = 32; o > 0; o >>= 1) m = fmaxf(m, __shfl_xor(m, o));
                v0 = __expf(v0 - m); v1 = __expf(v1 - m); v2 = __expf(v2 - m); v3 = __expf(v3 - m);
                const float s = wave_sum((v0 + v1) + (v2 + v3)), ri = 1.0f / s;
                r[lane] = v0 * ri; r[lane + 64] = v1 * ri; r[lane + 128] = v2 * ri; r[lane + 192] = v3 * ri;
            }
            __syncthreads();
            {
                f32x4 oa[4][2];
#pragma unroll
                for (int t = 0; t < 4; ++t)
#pragma unroll
                    for (int hh = 0; hh < 2; ++hh) oa[t][hh] = (f32x4){0.f, 0.f, 0.f, 0.f};
                for (int mi = 0; mi < 32; mi += 4) {
                    f32x4 vr[4][2];
#pragma unroll
                    for (int i = 0; i < 4; ++i)
#pragma unroll
                        for (int hh = 0; hh < 2; ++hh) vr[i][hh] = *(const f32x4*)(CV + (((size_t)b * 256 + wid * 32 + mi + i) * 4 + hp * 2 + hh) * 256 + lane * 4);
#pragma unroll
                    for (int i = 0; i < 4; ++i)
#pragma unroll
                        for (int hh = 0; hh < 2; ++hh)
#pragma unroll
                            for (int t = 0; t < 4; ++t) oa[t][hh] += vr[i][hh] * sc[(t * 2 + hh) * 256 + wid * 32 + mi + i];
                }
#pragma unroll
                for (int rnd = 0; rnd < 2; ++rnd) {
#pragma unroll
                    for (int t2 = 0; t2 < 2; ++t2)
#pragma unroll
                        for (int hh = 0; hh < 2; ++hh) *(LAS f32x4*)(red + ((wid * 2 + t2) * 2 + hh) * 256 + lane * 4) = oa[rnd * 2 + t2][hh];
                    __syncthreads();
#pragma unroll
                    for (int i = 0; i < 2; ++i) {
                        const int o = tid + i * 512, t2 = o >> 9, hh = (o >> 8) & 1, d = o & 255;
                        float sacc2 = 0.f;
#pragma unroll
                        for (int w = 0; w < 8; ++w) sacc2 += red[((w * 2 + t2) * 2 + hh) * 256 + d];
                        AO[((size_t)M_PR + b * 4 + rnd * 2 + t2) * 1024 + (hp * 2 + hh) * 256 + d] = (bf16_t)(cvt_pk_bf16(sacc2, 0.f) & 0xffff);
                    }
                    __syncthreads();
                }
            }
        }
    }
    }
    }
}

__device__ __forceinline__ void ins16(float (&T)[16], float x) {
#pragma unroll
    for (int i = 0; i < 16; ++i) { const float hi = fmaxf(T[i], x); x = fminf(T[i], x); T[i] = hi; }
}
__device__ __forceinline__ void sort16(float (&T)[16]) {
#pragma unroll
    for (int k = 2; k <= 16; k <<= 1)
#pragma unroll
        for (int j = k >> 1; j > 0; j >>= 1)
#pragma unroll
            for (int i = 0; i < 16; ++i) {
                const int l = i ^ j;
                if (l > i) {
                    const float hi = fmaxf(T[i], T[l]), lo = fminf(T[i], T[l]);
                    if ((i & k) == 0) { T[i] = hi; T[l] = lo; } else { T[i] = lo; T[l] = hi; }
                }
            }
}
__device__ __forceinline__ void merge16(float (&T)[16]) {
#pragma unroll
    for (int j = 8; j > 0; j >>= 1)
#pragma unroll
        for (int i = 0; i < 16; ++i) {
            const int l = i ^ j;
            if (l > i) { const float hi = fmaxf(T[i], T[l]), lo = fminf(T[i], T[l]); T[i] = hi; T[l] = lo; }
        }
}
__device__ __forceinline__ void topmerge16(float (&T)[16], const float (&G)[16]) {
#pragma unroll
    for (int i = 0; i < 16; ++i) T[i] = fmaxf(T[i], G[15 - i]);
    merge16(T);
}
__device__ __forceinline__ float pack_key(float v, unsigned code, unsigned mask) { return __uint_as_float((__float_as_uint(v) & ~mask) | code); }

__device__ __forceinline__ void peer_select(const bf16_t* PQ, const bf16_t* SKB, int tok0, int frc, int h, LAS int* sel_i, LAS float* sel_g, int fr, int fq) {
            float T1[16], T2[16];
#pragma unroll
            for (int half = 0; half < 2; ++half) {
                bf16x8 qf[4];
#pragma unroll
                for (int ks = 0; ks < 4; ++ks) qf[ks] = *(const bf16x8*)(PQ + (size_t)(tok0 + frc) * 2048 + h * 256 + half * 128 + ks * 32 + fq * 8);
                float T[16], Bk[16];
                {
                    unsigned so = (unsigned)(((h * 2 + half) * 128 + fr) * 128 + fq * 8);
                    asm volatile("" : "+v"(so));
                    const bf16_t* sp0 = SKB + so;
#pragma unroll
                    for (int kg = 0; kg < 2; ++kg) {
                        bf16x8 sf[4][4];
#pragma unroll
                        for (int kb = 0; kb < 4; ++kb)
#pragma unroll
                            for (int ks = 0; ks < 4; ++ks) sf[kb][ks] = *(const bf16x8*)(sp0 + (kg * 4 + kb) * 2048 + ks * 32);
#pragma unroll
                        for (int kb = 0; kb < 4; ++kb) {
                            f32x4 a = (f32x4){0.f, 0.f, 0.f, 0.f};
#pragma unroll
                            for (int ks = 0; ks < 4; ++ks) a = MFMA16(sf[kb][ks], qf[ks], a);
#pragma unroll
                            for (int jj = 0; jj < 4; ++jj) {
                                const float key = pack_key(a[jj], (unsigned)((kg * 4 + kb) * 16 + fq * 4 + jj), 127u);
                                if (kg == 0) T[kb * 4 + jj] = key; else Bk[kb * 4 + jj] = key;
                            }
                        }
                        asm volatile("" ::: "memory");
                    }
                }
                sort16(T); sort16(Bk); topmerge16(T, Bk);
#pragma unroll
                for (int o = 16; o <= 32; o <<= 1) {
                    float R[16];
#pragma unroll
                    for (int i = 0; i < 16; ++i) R[i] = __shfl_xor(T[i], o);
                    topmerge16(T, R);
                }
#pragma unroll
                for (int i = 0; i < 16; ++i) { if (half == 0) T1[i] = T[i]; else T2[i] = T[i]; }
            }
            float va[16], vb[16];
#pragma unroll
            for (int i = 0; i < 16; ++i) { va[i] = __uint_as_float(__float_as_uint(T1[i]) & ~127u); vb[i] = __uint_as_float(__float_as_uint(T2[i]) & ~127u); }
#define PEER_CAND(a_, b_) pack_key(va[a_] + vb[b_], (unsigned)((a_) * 16 + (b_)), 255u)
            float T3[16], X[16];
#pragma unroll
            for (int i = 0; i < 16; ++i) T3[i] = PEER_CAND(0, i);
#pragma unroll
            for (int i = 0; i < 8; ++i) { X[i] = PEER_CAND(1, i); X[8 + i] = PEER_CAND(15 - i, 0); }
            merge16(X); topmerge16(T3, X);
            X[0] = PEER_CAND(2, 0); X[1] = PEER_CAND(2, 1); X[2] = PEER_CAND(2, 2); X[3] = PEER_CAND(2, 3); X[4] = PEER_CAND(2, 4);
            X[5] = PEER_CAND(3, 0); X[6] = PEER_CAND(3, 1); X[7] = PEER_CAND(3, 2); X[8] = PEER_CAND(3, 3);
            X[9] = PEER_CAND(4, 0); X[10] = PEER_CAND(4, 1); X[11] = PEER_CAND(4, 2);
            X[12] = PEER_CAND(5, 0); X[13] = PEER_CAND(5, 1); X[14] = PEER_CAND(6, 0); X[15] = PEER_CAND(6, 1);
            sort16(X); topmerge16(T3, X);
            ins16(T3, PEER_CAND(7, 0)); ins16(T3, PEER_CAND(7, 1));
#undef PEER_CAND
            float e[16], es = 0.f;
            const float m0 = __uint_as_float(__float_as_uint(T3[0]) & ~255u);
#pragma unroll
            for (int i = 0; i < 16; ++i) { e[i] = __expf(__uint_as_float(__float_as_uint(T3[i]) & ~255u) - m0); es += e[i]; }
            const float ei = 1.0f / es;
#pragma unroll
            for (int jj = 0; jj < 4; ++jj) {
                float key = T3[0], ev = e[0];
#pragma unroll
                for (int r = 0; r < 16; ++r) { const bool s = (r == fq * 4 + jj); key = s ? T3[r] : key; ev = s ? e[r] : ev; }
                const unsigned code = __float_as_uint(key) & 255u, ca = code >> 4, cb = code & 15u;
                unsigned k1 = __float_as_uint(T1[0]), k2 = __float_as_uint(T2[0]);
#pragma unroll
                for (int r = 0; r < 16; ++r) { k1 = (ca == (unsigned)r) ? __float_as_uint(T1[r]) : k1; k2 = (cb == (unsigned)r) ? __float_as_uint(T2[r]) : k2; }
                const int idx = (int)((k1 & 127u) * 128u + (k2 & 127u));
                sel_i[fr * 128 + h * 16 + fq * 4 + jj] = idx;
                sel_g[fr * 128 + h * 16 + fq * 4 + jj] = ev * ei;
            }
        }

__device__ void phase_peer(const Params& p, LAS unsigned char* lds) {
    int tid_ = threadIdx.x; asm volatile("" : "+v"(tid_)); const int tid = tid_, lane = tid & 63, wid = tid >> 6, fr = lane & 15, fq = lane >> 4;
    const bf16_t* PQ = (const bf16_t*)(p.ws + OFF_PQ); const bf16_t* SKB = (const bf16_t*)(p.ws + OFF_SKB);
    const unsigned char* U8 = p.ws + OFF_UB; const unsigned char* V8 = p.ws + OFF_VB;
    const float* SS2 = (const float*)(p.ws + OFF_SSP2);
    const bf16_t* H2 = (const bf16_t*)(p.ws + OFF_H2B); float* Y = p.out;
    LAS int* sel_i = (LAS int*)lds;
    LAS float* sel_g = (LAS float*)(lds + 16384);
    LAS float* wv = (LAS float*)(lds + 32768);
    const int per_wg = (M_TOK + gridDim.x - 1) / gridDim.x, wg_lo = blockIdx.x * per_wg, wg_hi = (wg_lo + per_wg < M_TOK) ? wg_lo + per_wg : M_TOK;
    const int ntile = (wg_hi > wg_lo) ? (wg_hi - wg_lo + 15) / 16 : 0;
    if (ntile > 0) {
        const int nv0 = (wg_hi - wg_lo < 16) ? wg_hi - wg_lo : 16, frc0 = (fr < nv0) ? fr : nv0 - 1;
        peer_select(PQ, SKB, wg_lo, frc0, wid, sel_i, sel_g, fr, fq);
    }
    __syncthreads();
    for (int ti = 0; ti < ntile; ++ti) {
        const int tok0 = wg_lo + ti * 16;
        const int nvalid = (wg_hi - tok0 < 16) ? wg_hi - tok0 : 16;
        const LAS int* si_b = sel_i + (ti & 1) * 2048; const LAS float* sg_b = sel_g + (ti & 1) * 2048;
        if (wid >= 4) {
            if (ti + 1 < ntile) {
                const int tok1 = tok0 + 16, nv1 = (wg_hi - tok1 < 16) ? wg_hi - tok1 : 16, frc1 = (fr < nv1) ? fr : nv1 - 1;
#pragma unroll 1
                for (int hh = 0; hh < 2; ++hh) peer_select(PQ, SKB, tok1, frc1, (wid - 4) * 2 + hh, sel_i + ((ti + 1) & 1) * 2048, sel_g + ((ti + 1) & 1) * 2048, fr, fq);
            }
        } else {
    #pragma unroll 1
            for (int tt = 0; tt < 4; ++tt) {
                const int tl = tt * 4 + wid; const size_t tok = (size_t)tok0 + tl;
                if (tl >= nvalid) break;
                const float rs = rsqrtf(wave_sum(lane < 16 ? SS2[(size_t)lane * M_TOK + tok] : 0.f) * (1.0f / 1024.0f) + EPS);
                const bf16_t* hrow = H2 + tok * 1024; const float* gf = p.in[22];
                f32x2 x2[4][8];
    #pragma unroll
                for (int i = 0; i < 4; ++i) {
                    const u32x4 h0 = *(const u32x4*)(hrow + i * 256 + fr * 16), h1 = *(const u32x4*)(hrow + i * 256 + fr * 16 + 8);
    #pragma unroll
                    for (int q = 0; q < 4; ++q) {
                        const f32x4 ga = *(const f32x4*)(gf + i * 256 + fr * 16 + q * 4);
                        const unsigned w0 = (q < 2) ? h0[(q & 1) * 2] : h1[(q & 1) * 2], w1 = (q < 2) ? h0[(q & 1) * 2 + 1] : h1[(q & 1) * 2 + 1];
                        x2[i][q * 2] = (f32x2){bflo(w0) * rs * ga[0], bfhi(w0) * rs * ga[1]}; x2[i][q * 2 + 1] = (f32x2){bflo(w1) * rs * ga[2], bfhi(w1) * rs * ga[3]};
                    }
                }
                const LAS int* si = si_b + tl * 128; const LAS float* sg = sg_b + tl * 128; LAS float* wvw = wv + wid * 128;
                u32x4 bA[1][4], bB[1][4];
    #define PEER_LOADU(buf, g) do { _Pragma("unroll") for (int q_ = 0; q_ < 1; ++q_) { const int idx_ = si[((g) + q_) * 4 + fq]; \
                    const unsigned char* ur_ = U8 + (size_t)idx_ * 1024 + fr * 16; \
                    _Pragma("unroll") for (int i_ = 0; i_ < 4; ++i_) buf[q_][i_] = *(const u32x4*)(ur_ + i_ * 256); } } while (0)
    #define PEER_COMPU(buf, g) do { _Pragma("unroll") for (int q_ = 0; q_ < 1; ++q_) { f32x2 s2_ = (f32x2){0.f, 0.f}; \
                    _Pragma("unroll") for (int i_ = 0; i_ < 4; ++i_) _Pragma("unroll") for (int w_ = 0; w_ < 4; ++w_) { \
                        s2_ += x2[i_][w_ * 2] * __builtin_amdgcn_cvt_pk_f32_fp8((int)buf[q_][i_][w_], false); \
                        s2_ += x2[i_][w_ * 2 + 1] * __builtin_amdgcn_cvt_pk_f32_fp8((int)buf[q_][i_][w_], true); } \
                    float s_ = s2_.x + s2_.y; s_ += __shfl_xor(s_, 1); s_ += __shfl_xor(s_, 2); s_ += __shfl_xor(s_, 4); s_ += __shfl_xor(s_, 8); \
                    if (fr == 0) wvw[((g) + q_) * 4 + fq] = s_ * (1.0f / 1024.0f); } } while (0)
                PEER_LOADU(bA, 0);
    #pragma unroll 1
                for (int g = 0; g < 32; g += 2) {
                    PEER_LOADU(bB, g + 1);
                    PEER_COMPU(bA, g);
                    { const int gn = (g + 2 < 32) ? g + 2 : 31; PEER_LOADU(bA, gn); }
                    PEER_COMPU(bB, g + 1);
                }
                {
                    const float a0 = wvw[lane], a1 = wvw[lane + 64];
                    wvw[lane] = 0.5f * a0 * (1.0f + erff(a0 * 0.70710678118654752f)) * sg[lane] * (1.0f / 64.0f);
                    wvw[lane + 64] = 0.5f * a1 * (1.0f + erff(a1 * 0.70710678118654752f)) * sg[lane + 64] * (1.0f / 64.0f);
                }
                f32x2 acc2[8];
    #pragma unroll
                for (int e2 = 0; e2 < 8; ++e2) acc2[e2] = (f32x2){0.f, 0.f};
                u32x4 vA[8], vB[8];
    #define PEER_LOADV(buf, k0) do { _Pragma("unroll") for (int q_ = 0; q_ < 8; ++q_) buf[q_] = *(const u32x4*)(V8 + (size_t)si[(k0) + q_] * 1024 + lane * 16); } while (0)
    #define PEER_COMPV(buf, k0) do { _Pragma("unroll") for (int q_ = 0; q_ < 8; ++q_) { const float w_ = wvw[(k0) + q_]; \
                    _Pragma("unroll") for (int j_ = 0; j_ < 4; ++j_) { \
                        acc2[j_ * 2] += __builtin_amdgcn_cvt_pk_f32_fp8((int)buf[q_][j_], false) * w_; \
                        acc2[j_ * 2 + 1] += __builtin_amdgcn_cvt_pk_f32_fp8((int)buf[q_][j_], true) * w_; } } } while (0)
                PEER_LOADV(vA, 0);
    #pragma unroll 1
                for (int k0 = 0; k0 < 128; k0 += 16) {
                    PEER_LOADV(vB, k0 + 8);
                    PEER_COMPV(vA, k0);
                    { const int kn = (k0 + 16 < 128) ? k0 + 16 : 120; PEER_LOADV(vA, kn); }
                    PEER_COMPV(vB, k0 + 8);
                }
    #undef PEER_LOADU
    #undef PEER_COMPU
    #undef PEER_LOADV
    #undef PEER_COMPV
                float ss = 0.f; f32x4 hv[4];
                {
                    const u32x4 h0 = *(const u32x4*)(hrow + lane * 16), h1 = *(const u32x4*)(hrow + lane * 16 + 8);
    #pragma unroll
                    for (int q = 0; q < 4; ++q) {
                        const unsigned w0 = (q < 2) ? h0[(q & 1) * 2] : h1[(q & 1) * 2], w1 = (q < 2) ? h0[(q & 1) * 2 + 1] : h1[(q & 1) * 2 + 1];
                        hv[q][0] = bflo(w0) + acc2[q * 2].x; hv[q][1] = bfhi(w0) + acc2[q * 2].y; hv[q][2] = bflo(w1) + acc2[q * 2 + 1].x; hv[q][3] = bfhi(w1) + acc2[q * 2 + 1].y;
                        ss += (hv[q][0] * hv[q][0] + hv[q][1] * hv[q][1]) + (hv[q][2] * hv[q][2] + hv[q][3] * hv[q][3]);
                    }
                }
                ss = wave_sum(ss);
                const float rf = rsqrtf(ss * (1.0f / 1024.0f) + EPS);
                const float* nf = p.in[27];
    #pragma unroll
                for (int q = 0; q < 4; ++q) *(f32x4*)(Y + tok * 1024 + lane * 16 + q * 4) = hv[q] * rf * *(const f32x4*)(nf + lane * 16 + q * 4);
            }
        }
        __syncthreads();
    }
}

struct SmallArgs { const bf16_t* A; const bf16_t* Bt; int N; const bf16_t* proj; const bf16_t* base; bf16_t* O; int ldo; float* SSw; const float* SSr; float sc; };
template <int MODE>
__device__ __forceinline__ void small_gemm(const SmallArgs& a, LAS unsigned char* lds) {
    int tid_ = threadIdx.x; asm volatile("" : "+v"(tid_)); const int tid = tid_, lane = tid & 63, wid = tid >> 6, fr = lane & 15, fq = lane >> 4;
    const int ncb = a.N / 64;
    constexpr int SP = 1040;
    LAS unsigned char* LA = lds; LAS unsigned char* LB = lds + 32 * SP;
    LAS float* red = (LAS float*)(lds + 96 * SP);
    for (int tile = blockIdx.x; tile < 16 * ncb; tile += gridDim.x) {
        const int rb = tile / ncb, cb = tile % ncb;
        const int row = M_PR + rb * 32 + (wid >> 2) * 16 + fr;
        const int colb = cb * 64 + (wid & 3) * 16;
        const bf16_t* Ag = a.A + (size_t)(M_PR + rb * 32) * 1024 + (tid & 63) * 8;
        const bf16_t* Bg = a.Bt + (size_t)(cb * 64) * 1024 + (tid & 63) * 8;
        u32x4 ra[4], rbv[8];
#define SG_LOAD(kh_) do { _Pragma("unroll") for (int i_ = 0; i_ < 4; ++i_) ra[i_] = *(const u32x4*)(Ag + (size_t)((tid >> 6) + 8 * i_) * 1024 + (kh_) * 512); \
            _Pragma("unroll") for (int i_ = 0; i_ < 8; ++i_) rbv[i_] = *(const u32x4*)(Bg + (size_t)((tid >> 6) + 8 * i_) * 1024 + (kh_) * 512); } while (0)
        SG_LOAD(0);
        f32x4 acc = (f32x4){0.f, 0.f, 0.f, 0.f};
#pragma unroll
        for (int kh = 0; kh < 2; ++kh) {
#pragma unroll
            for (int i_ = 0; i_ < 4; ++i_) *(LAS u32x4*)(LA + ((tid >> 6) + 8 * i_) * SP + (tid & 63) * 16) = ra[i_];
#pragma unroll
            for (int i_ = 0; i_ < 8; ++i_) *(LAS u32x4*)(LB + ((tid >> 6) + 8 * i_) * SP + (tid & 63) * 16) = rbv[i_];
            __syncthreads();
            if (kh == 0) SG_LOAD(1);
            const LAS unsigned char* apl = LA + ((wid >> 2) * 16 + fr) * SP + fq * 16;
            const LAS unsigned char* bpl = LB + ((wid & 3) * 16 + fr) * SP + fq * 16;
#pragma unroll
            for (int ks = 0; ks < 16; ++ks) acc = MFMA16(*(const LAS bf16x8*)(bpl + ks * 64), *(const LAS bf16x8*)(apl + ks * 64), acc);
            if (MODE == 0 && kh == 0) {
                const u32x2 sa = *(const u32x2*)(a.proj + (size_t)row * NPROJ + 3328 + colb + fq * 4), sb = *(const u32x2*)(a.proj + (size_t)row * NPROJ + 4352 + colb + fq * 4);
                acc[0] *= bflo(sa.x) * __builtin_amdgcn_rcpf(bflo(sb.x)); acc[1] *= bfhi(sa.x) * __builtin_amdgcn_rcpf(bfhi(sb.x));
                acc[2] *= bflo(sa.y) * __builtin_amdgcn_rcpf(bflo(sb.y)); acc[3] *= bfhi(sa.y) * __builtin_amdgcn_rcpf(bfhi(sb.y));
            }
            __syncthreads();
        }
#undef SG_LOAD
        const int col = colb + fq * 4;
        if (MODE == 0) {
            const u32x2 sb = *(const u32x2*)(a.proj + (size_t)row * NPROJ + 4352 + col);
            u32x2 w; w.x = cvt_pk_bf16(acc[0] * bflo(sb.x), acc[1] * bfhi(sb.x)); w.y = cvt_pk_bf16(acc[2] * bflo(sb.y), acc[3] * bfhi(sb.y));
            *(u32x2*)(a.O + (size_t)row * a.ldo + col) = w;
        } else if (MODE == 1) {
            const u32x2 b = *(const u32x2*)(a.base + (size_t)row * 1024 + col);
            f32x4 v = acc; v[0] += bflo(b.x); v[1] += bfhi(b.x); v[2] += bflo(b.y); v[3] += bfhi(b.y);
            float sq = (v[0] * v[0] + v[1] * v[1]) + (v[2] * v[2] + v[3] * v[3]);
            u32x2 w; w.x = cvt_pk_bf16(v[0], v[1]); w.y = cvt_pk_bf16(v[2], v[3]);
            *(u32x2*)(a.O + (size_t)row * a.ldo + col) = w;
            sq += __shfl_xor(sq, 16); sq += __shfl_xor(sq, 32);
            if (fq == 0) red[((wid >> 2) * 16 + fr) * 4 + (wid & 3)] = sq;
            __syncthreads();
            if (tid < 32) a.SSw[(size_t)cb * M_TOK + M_PR + rb * 32 + tid] = (red[tid * 4] + red[tid * 4 + 1]) + (red[tid * 4 + 2] + red[tid * 4 + 3]);
            __syncthreads();
        } else {
            float t = 0.f;
#pragma unroll
            for (int q = 0; q < 4; ++q) t += a.SSr[(size_t)(fq * 4 + q) * M_TOK + row];
            t += __shfl_xor(t, 16); t += __shfl_xor(t, 32);
            const float rs = rsqrtf(t * (1.0f / 1024.0f) + EPS) * a.sc;
            u32x2 w; w.x = cvt_pk_bf16(acc[0] * rs, acc[1] * rs); w.y = cvt_pk_bf16(acc[2] * rs, acc[3] * rs);
            *(u32x2*)(a.O + (size_t)row * a.ldo + col) = w;
        }
    }
}

#define XB_TMO      128
#define XB_XCNT(j)  (256  + 64 * (j))
#define XB_XSUB(j)  (1280 + 64 * (j))
#define XB_XGEN(j)  (2304 + 64 * (j))
#define XB_TOP      3328
#define XB_TOPGEN   3392
#define XCD_BAR_WORDS 3456
#define XB_SPIN_CAP (1u << 18)

__device__ __forceinline__ unsigned xb_ld(unsigned* p)              { return __hip_atomic_load(p, __ATOMIC_RELAXED, __HIP_MEMORY_SCOPE_AGENT); }
__device__ __forceinline__ unsigned xb_add(unsigned* p, unsigned v) { return __hip_atomic_fetch_add(p, v, __ATOMIC_RELAXED, __HIP_MEMORY_SCOPE_AGENT); }
__device__ __forceinline__ unsigned xb_xcc_id() { return (unsigned)__builtin_amdgcn_s_getreg((3 << 11) | 20) & 0xFu; }
#define XB_SPIN(cond, bar) do { unsigned _sp = 0; while (cond) { __builtin_amdgcn_s_sleep(1); \
    if ((++_sp & 255u) == 0u) { if (xb_ld(&(bar)[XB_TMO])) break; if (_sp > XB_SPIN_CAP) { atomicAdd(&(bar)[XB_TMO], 1u); break; } } } } while (0)

struct XcdBarrier {
    unsigned* bar; unsigned x;
    volatile LAS unsigned* st;
};

__device__ __forceinline__ XcdBarrier xcd_barrier_post(unsigned* bar, volatile LAS unsigned* st) {
    XcdBarrier b; b.bar = bar; b.x = xb_xcc_id(); b.st = st;
    if (threadIdx.x == 0) (void)xb_add(&bar[XB_XCNT(b.x)], 1u);
    return b;
}
__device__ __forceinline__ void xcd_barrier_complete(unsigned* bar, unsigned x, unsigned& nloc, unsigned& nx) {
    const unsigned G = gridDim.x * gridDim.y * gridDim.z;
    unsigned sum, cnt, mine, sp = 0u;
    for (;;) {
        sum = 0u; cnt = 0u; mine = 0u;
#pragma unroll
        for (unsigned j = 0; j < 16; ++j) { const unsigned c = xb_ld(&bar[XB_XCNT(j)]); sum += c; cnt += (c > 0u) ? 1u : 0u; mine = (j == x) ? c : mine; }
        if (sum == G) break;
        __builtin_amdgcn_s_sleep(1);
        if ((++sp & 255u) == 0u) { if (xb_ld(&bar[XB_TMO])) break; if (sp > XB_SPIN_CAP) { atomicAdd(&bar[XB_TMO], 1u); break; } }
    }
    nloc = mine > 0u ? mine : 1u; nx = cnt > 0u ? cnt : 1u;
}

__device__ __forceinline__ void xcd_barrier(const XcdBarrier& b) {
    asm volatile("s_waitcnt vmcnt(0)" ::: "memory");
    __syncthreads();
    if (threadIdx.x == 0) {
        unsigned* bar = b.bar;
        __builtin_amdgcn_s_waitcnt(0);
        unsigned nloc = b.st[0], nx = b.st[1];
        if (nloc == 0u) { xcd_barrier_complete(bar, b.x, nloc, nx); b.st[0] = nloc; b.st[1] = nx; }
        const unsigned old = xb_add(&bar[XB_XSUB(b.x)], 1u);
        const unsigned gen = old / nloc;
        if (old + 1u == (gen + 1u) * nloc) {
            __builtin_amdgcn_fence(__ATOMIC_RELEASE, "agent");
            asm volatile("s_waitcnt vmcnt(0)" ::: "memory");
            const unsigned og = xb_add(&bar[XB_TOP], 1u);
            const unsigned tg = og / nx;
            if (og + 1u == (tg + 1u) * nx) xb_add(&bar[XB_TOPGEN], 1u);
            else XB_SPIN(xb_ld(&bar[XB_TOPGEN]) == tg, bar);
            __builtin_amdgcn_fence(__ATOMIC_ACQUIRE, "agent");
            xb_add(&bar[XB_XGEN(b.x)], 1u);
            asm volatile("s_waitcnt vmcnt(0)" ::: "memory");
        } else {
            XB_SPIN(xb_ld(&bar[XB_XGEN(b.x)]) == gen, bar);
            __builtin_amdgcn_fence(__ATOMIC_ACQUIRE, "agent");
            asm volatile("s_waitcnt vmcnt(0)" ::: "memory");
        }
    }
    __syncthreads();
}


__device__ __forceinline__ void my_grid_sync(unsigned* bar, unsigned target) {
    asm volatile("s_waitcnt vmcnt(0) lgkmcnt(0)" ::: "memory");
    __syncthreads();
    if (threadIdx.x == 0) {
        __builtin_amdgcn_fence(__ATOMIC_RELEASE, "agent");
        asm volatile("s_waitcnt vmcnt(0)" ::: "memory");
        __hip_atomic_fetch_add(bar, 1u, __ATOMIC_RELAXED, __HIP_MEMORY_SCOPE_AGENT);
        while (__hip_atomic_load(bar, __ATOMIC_RELAXED, __HIP_MEMORY_SCOPE_AGENT) < target) __builtin_amdgcn_s_sleep(2);
    }
    __syncthreads();
    asm volatile("buffer_inv sc1\n\ts_waitcnt vmcnt(0)" ::: "memory");
}
__global__ void __launch_bounds__(NTHR) mk_fwd(Params p) {
    extern __shared__ __attribute__((aligned(16))) unsigned char lds_raw[];
    LAS unsigned char* lds = (LAS unsigned char*)lds_raw;
    cg::grid_group grid = cg::this_grid();
    if (threadIdx.x < 4) ((LAS unsigned*)(lds + LDS_BYTES - 16))[threadIdx.x] = 0u;
    __syncthreads();
    const XcdBarrier xb = xcd_barrier_post((unsigned*)(p.ws + OFF_BAR), (volatile LAS unsigned*)(lds + LDS_BYTES - 16));
#define GRID_SYNC() xcd_barrier(xb)
    unsigned char* ws = p.ws;
    const int G = gridDim.x, c = blockIdx.x;
    const bf16_t* A0 = (const bf16_t*)(ws + OFF_A0);

    if (p.ws == nullptr) grid.sync();
    PH(0) phase_prep(p, lds);
    GRID_SYNC();
    PH(1) {
        pg8::Sched S; S.init(A0, (const bf16_t*)(ws + OFF_WTIN), M_TOK, NPROJ, A0 + (size_t)M_TOK * 1024, (const bf16_t*)(ws + OFF_WTKV), 2048, 2048, G, c);
        EpiProj E{(const float*)(ws + OFF_SS0), p.in[10], (bf16_t*)(ws + OFF_PROJ), (float*)(ws + OFF_LOGA), p.out, (bf16_t*)(ws + OFF_KB), (bf16_t*)(ws + OFF_VTB)};
        pg8::gemm_phase(lds, 1024, S, E);
    }
    GRID_SYNC();
    PH(2) phase_scan(p, lds);
    GRID_SYNC();
    PH(3) phase_onorm(p);
    GRID_SYNC();
    PH(4) {
        pg8::Sched S; S.init((const bf16_t*)(ws + OFF_A2), (const bf16_t*)(ws + OFF_WTP), M_PR, 1024, nullptr, nullptr, 0, 0, G, c);
        EpiMerge E{(const bf16_t*)(ws + OFF_PROJ), (bf16_t*)(ws + OFF_X)};
        pg8::gemm_phase(lds, 1024, S, E);
        SmallArgs sa{(const bf16_t*)(ws + OFF_A2), (const bf16_t*)(ws + OFF_WTP), 1024, (const bf16_t*)(ws + OFF_PROJ), nullptr, (bf16_t*)(ws + OFF_X), 1024, nullptr, nullptr, 1.f};
        small_gemm<0>(sa, lds);
    }
    GRID_SYNC();
    PH(5) {
        pg8::Sched S; S.init((const bf16_t*)(ws + OFF_X), (const bf16_t*)(ws + OFF_WTO), M_PR, 1024, nullptr, nullptr, 0, 0, G, c);
        EpiResid E{A0, (bf16_t*)(ws + OFF_H1B), (float*)(ws + OFF_SSP1)};
        pg8::gemm_phase(lds, 1024, S, E);
        SmallArgs sa{(const bf16_t*)(ws + OFF_X), (const bf16_t*)(ws + OFF_WTO), 1024, nullptr, A0, (bf16_t*)(ws + OFF_H1B), 1024, (float*)(ws + OFF_SSP1), nullptr, 1.f};
        small_gemm<1>(sa, lds);
    }
    GRID_SYNC();
    PH(6) {
        pg8::Sched S; S.init((const bf16_t*)(ws + OFF_H1B), (const bf16_t*)(ws + OFF_WTXQ), M_PR, 1024, nullptr, nullptr, 0, 0, G, c);
        EpiScale E{(const float*)(ws + OFF_SSP1), (bf16_t*)(ws + OFF_Q), 1024, 0.0625f};
        pg8::gemm_phase(lds, 1024, S, E);
        SmallArgs sa{(const bf16_t*)(ws + OFF_H1B), (const bf16_t*)(ws + OFF_WTXQ), 1024, nullptr, nullptr, (bf16_t*)(ws + OFF_Q), 1024, nullptr, (const float*)(ws + OFF_SSP1), 0.0625f};
        small_gemm<2>(sa, lds);
    }
    GRID_SYNC();
    PH(7) phase_attn(p, lds);
    GRID_SYNC();
    PH(8) {
        pg8::Sched S; S.init((const bf16_t*)(ws + OFF_AO), (const bf16_t*)(ws + OFF_WTXO), M_PR, 1024, nullptr, nullptr, 0, 0, G, c);
        EpiResid E{(const bf16_t*)(ws + OFF_H1B), (bf16_t*)(ws + OFF_H2B), (float*)(ws + OFF_SSP2)};
        pg8::gemm_phase(lds, 1024, S, E);
        SmallArgs sa{(const bf16_t*)(ws + OFF_AO), (const bf16_t*)(ws + OFF_WTXO), 1024, nullptr, (const bf16_t*)(ws + OFF_H1B), (bf16_t*)(ws + OFF_H2B), 1024, (float*)(ws + OFF_SSP2), nullptr, 1.f};
        small_gemm<1>(sa, lds);
    }
    GRID_SYNC();
    PH(9) {
        pg8::Sched S; S.init((const bf16_t*)(ws + OFF_H2B), (const bf16_t*)(ws + OFF_WTPQ), M_PR, 2048, nullptr, nullptr, 0, 0, G, c);
        EpiScale E{(const float*)(ws + OFF_SSP2), (bf16_t*)(ws + OFF_PQ), 2048, 1.0f};
        pg8::gemm_phase(lds, 1024, S, E);
        SmallArgs sa{(const bf16_t*)(ws + OFF_H2B), (const bf16_t*)(ws + OFF_WTPQ), 2048, nullptr, nullptr, (bf16_t*)(ws + OFF_PQ), 2048, nullptr, (const float*)(ws + OFF_SSP2), 1.0f};
        small_gemm<2>(sa, lds);
    }
    GRID_SYNC();
    PH(10) phase_peer(p, lds);
#ifdef DUMP
    GRID_SYNC();
    {
        const size_t gt = (size_t)blockIdx.x * NTHR + threadIdx.x, ngt = (size_t)gridDim.x * NTHR;
        const bf16_t* srcb = (const bf16_t*)(ws + (DUMP == 1 ? OFF_A2 : (DUMP == 2 ? OFF_X : OFF_H1B)));
        const float* srcf = (const float*)(ws + OFF_X);
        if (DUMP == 4) { const bf16_t* pj = (const bf16_t*)(ws + OFF_PROJ); for (size_t i = gt; i < (size_t)M_TOK * 1024; i += ngt) p.out[i] = bf2f(pj[(i >> 10) * NPROJ + (i & 1023)]); }
        else if (DUMP == 5) { const bf16_t* pj = (const bf16_t*)(ws + OFF_PROJ); for (size_t i = gt; i < (size_t)M_TOK * 1024; i += ngt) p.out[i] = bf2f(pj[(i >> 10) * NPROJ + 1792 + (i & 1023)]); }
        else for (size_t i = gt; i < (size_t)M_PR * 1024; i += ngt) p.out[i] = (DUMP == 3) ? srcf[i] : bf2f(srcb[i]);
    }
#endif
}

extern "C" void kernel_launch(void* const* d_in, const int* in_sizes, int n_in, void* d_out, int out_size, void* d_ws, size_t ws_size, hipStream_t stream) {
    static int grid_blocks = 0;
    if (!grid_blocks) {
        int dev = 0, cus = 0, per_cu = 0;
        (void)hipGetDevice(&dev);
        (void)hipDeviceGetAttribute(&cus, hipDeviceAttributeMultiprocessorCount, dev);
        (void)hipFuncSetAttribute((const void*)mk_fwd, hipFuncAttributeMaxDynamicSharedMemorySize, LDS_BYTES);
        (void)hipOccupancyMaxActiveBlocksPerMultiprocessor(&per_cu, (const void*)mk_fwd, NTHR, LDS_BYTES);
        if (per_cu < 1) per_cu = 1;
        grid_blocks = cus * per_cu;
        if (ws_size < WS_END) fprintf(stderr, "kernel_launch: workspace too small (%zu < %zu)\n", ws_size, (size_t)WS_END);
    }
    Params p{};
    for (int i = 0; i < 28; ++i) p.in[i] = (const float*)d_in[i];
    p.out = (float*)d_out; p.ws = (unsigned char*)d_ws;
    (void)hipMemsetAsync((unsigned char*)d_ws + OFF_BAR, 0, 16384, stream);
    void* args[] = {&p};
    hipError_t e = hipLaunchCooperativeKernel((const void*)mk_fwd, dim3(grid_blocks), dim3(NTHR), args, LDS_BYTES, stream);
    if (e != hipSuccess) fprintf(stderr, "cooperative launch failed: %s (grid %d)\n", hipGetErrorString(e), grid_blocks);
}
```

```cpp
#include <hip/hip_runtime.h>
#include <hip/hip_cooperative_groups.h>
#include <cstdio>
namespace cg = cooperative_groups;

#define LAS __attribute__((address_space(3)))
typedef unsigned short bf16_t;
typedef short bf16x8 __attribute__((ext_vector_type(8)));
typedef float f32x4 __attribute__((ext_vector_type(4)));
typedef float f32x2 __attribute__((ext_vector_type(2)));
typedef unsigned u32x4 __attribute__((ext_vector_type(4)));
typedef unsigned u32x2 __attribute__((ext_vector_type(2)));

constexpr int NTHR = 512;
constexpr int M_TOK = 16896, M_PR = 16384, M_ALL = 18944, DM = 1024, NPROJ = 5376;
constexpr float EPS = 1e-6f;
constexpr int LDS_BYTES = 147456;

constexpr size_t OUT_Y = 0, OUT_GLAP = 17301504, OUT_RETP = 17563648, OUT_MK = 17825792, OUT_MV = 19922944, OUT_GLAS = 22020096, OUT_RETS = 26214400;

constexpr size_t al256(size_t x) { return (x + 255) & ~(size_t)255; }
constexpr size_t OFF_A0 = 0;
constexpr size_t OFF_SS0 = al256(OFF_A0 + (size_t)M_ALL * DM * 2);
constexpr size_t OFF_SS1 = al256(OFF_SS0 + (size_t)M_ALL * 4);
constexpr size_t OFF_SS2 = OFF_SS1 + (size_t)M_TOK * 4;
constexpr size_t OFF_WTIN = al256(OFF_SS2 + (size_t)M_TOK * 4);
constexpr size_t OFF_WTKV = OFF_WTIN + (size_t)NPROJ * DM * 2;
constexpr size_t OFF_WTP = OFF_WTKV + (size_t)2048 * DM * 2;
constexpr size_t OFF_WTO = OFF_WTP + (size_t)DM * DM * 2;
constexpr size_t OFF_WTXQ = OFF_WTO + (size_t)DM * DM * 2;
constexpr size_t OFF_WTXO = OFF_WTXQ + (size_t)DM * DM * 2;
constexpr size_t OFF_WTPQ = OFF_WTXO + (size_t)DM * DM * 2;
constexpr size_t OFF_SKB = OFF_WTPQ + (size_t)2048 * DM * 2;
constexpr size_t OFF_UB = OFF_SKB + (size_t)8 * 2 * 128 * 128 * 2;
constexpr size_t OFF_VB = OFF_UB + (size_t)16384 * DM;
constexpr size_t OFF_PROJ = OFF_VB + (size_t)16384 * DM;
constexpr size_t OFF_LOGA = OFF_PROJ + (size_t)M_TOK * NPROJ * 2;
constexpr size_t OFF_KB = OFF_LOGA + (size_t)M_TOK * 256 * 4;
constexpr size_t OFF_VTB = OFF_KB + (size_t)2048 * DM * 2;
constexpr size_t OFF_X = OFF_VTB + (size_t)2048 * DM * 2;
constexpr size_t OFF_A2 = OFF_X + (size_t)M_TOK * DM * 4;
constexpr size_t OFF_SSP1 = OFF_A2 + (size_t)M_TOK * DM * 2;
constexpr size_t OFF_SSP2 = OFF_SSP1 + (size_t)16 * M_TOK * 4;
constexpr size_t OFF_BAR = OFF_SSP2 + (size_t)16 * M_TOK * 4;
constexpr size_t WS_END = OFF_BAR + 16384;
constexpr size_t OFF_H1B = OFF_PROJ;
constexpr size_t OFF_Q = OFF_H1B + (size_t)M_TOK * DM * 2;
constexpr size_t OFF_AO = OFF_Q + (size_t)M_TOK * DM * 2;
constexpr size_t OFF_H2B = OFF_AO + (size_t)M_TOK * DM * 2;
constexpr size_t OFF_PQ = OFF_PROJ;

struct Params { const float* in[28]; float* out; unsigned char* ws; };
#ifndef PHMASK
#define PHMASK 0xFFFF
#endif
#define PH(k) if constexpr ((PHMASK >> (k)) & 1)

typedef __bf16 bf16v2_t __attribute__((ext_vector_type(2)));
__device__ __forceinline__ unsigned cvt_pk_bf16(float lo, float hi) { const f32x2 v = {lo, hi}; return __builtin_bit_cast(unsigned, __builtin_convertvector(v, bf16v2_t)); }
__device__ __forceinline__ float bflo(unsigned u) { return __uint_as_float(u << 16); }
__device__ __forceinline__ float bfhi(unsigned u) { return __uint_as_float(u & 0xffff0000u); }
__device__ __forceinline__ float bf2f(bf16_t b) { return __uint_as_float(((unsigned)b) << 16); }
__device__ __forceinline__ float wave_sum(float v) {
#pragma unroll
    for (int o = 32; o > 0; o >>= 1) v += __shfl_xor(v, o);
    return v;
}
__device__ __forceinline__ float sigmoidf_(float v) { return __builtin_amdgcn_rcpf(1.0f + __expf(-v)); }

namespace pg8 {
constexpr int BM = 256, BK = 64, HALF = 128, HTB = HALF * BK * 2, STAGE_BYTES = 8 * HTB, NXCD = 8, WGM = 8;
__device__ __forceinline__ int lds_byte(int r, int c) { const int st = (r >> 4) * 2 + (c >> 5), rr = r & 15, cc = c & 31, ob = rr * 64 + cc * 2; return st * 1024 + (ob ^ (((ob >> 9) & 1) << 5)); }
__device__ __forceinline__ void stage_rc(int b, int& R, int& C) { const int st = b / 1024, sb = b % 1024, swz = sb ^ (((sb >> 9) & 1) << 5); R = (st >> 1) * 16 + swz / 64; C = (st & 1) * 32 + (swz % 64) / 2; }

struct Unit { int pm, pn, job; };
struct Sched {
    const bf16_t* A0; const bf16_t* B0; const bf16_t* A1; const bf16_t* B1;
    int nM0, nN0, n0, nM1, nN1, n1, G, c;
    __device__ __forceinline__ void init(const bf16_t* a0, const bf16_t* b0, int M0, int N0, const bf16_t* a1, const bf16_t* b1, int M1, int N1, int G_, int c_) {
        A0 = a0; B0 = b0; A1 = a1; B1 = b1; nM0 = M0 / BM; nN0 = N0 / BM; n0 = nM0 * nN0; nM1 = M1 / BM; nN1 = N1 / BM; n1 = nM1 * nN1; G = G_; c = c_; }
    __device__ __forceinline__ void map(int wgid, int nwg, int nM, int nN, Unit& u) const {
        { const int q = nwg / NXCD, r = nwg % NXCD, xcd = wgid % NXCD, off = wgid / NXCD; wgid = (xcd < r ? xcd * (q + 1) : r * (q + 1) + (xcd - r) * q) + off; }
        const int nig = WGM * nN, gid = wgid / nig, fm = gid * WGM, gsz = (nM - fm) < WGM ? (nM - fm) : WGM;
        u.pm = fm + ((wgid % nig) % gsz); u.pn = (wgid % nig) / gsz;
    }
    __device__ __forceinline__ bool next(int i, Unit& u) const {
        int L = i * G + c;
        if (L < n0) { map(L, n0, nM0, nN0, u); u.job = 0; return true; }
        L -= n0;
        if (L < n1) { map(L, n1, nM1, nN1, u); u.job = 1; return true; }
        return false;
    }
    __device__ __forceinline__ const char* aptr(const Unit& u, size_t tstep) const { return (const char*)(u.job ? A1 : A0) + (size_t)u.pm * tstep; }
    __device__ __forceinline__ const char* bptr(const Unit& u, size_t tstep) const { return (const char*)(u.job ? B1 : B0) + (size_t)u.pn * tstep; }
};

template <class Epi>
__device__ __forceinline__ void gemm_phase(LAS unsigned char* lds, const int K, const Sched& S, const Epi& E) {
    int tid_ = threadIdx.x; asm volatile("" : "+v"(tid_)); const int tid = tid_, wid = __builtin_amdgcn_readfirstlane(tid >> 6), lane = tid & 63, wr = wid >> 2, wc = wid & 3, fr = lane & 15, fq = lane >> 4;
    const int nt = K / BK;
    unsigned voffA[2], voffB[2];
#pragma unroll
    for (int i = 0; i < 2; ++i) { int R, C; stage_rc(tid * 16 + i * 8192, R, C); voffA[i] = (unsigned)(R * K + C) * 2u;
        { const int rho = R & 31, pn_ = rho >> 4, pi_ = rho & 15, Rb = (R & ~31) + 8 * (pi_ >> 2) + 4 * pn_ + (pi_ & 3); voffB[i] = (unsigned)(Rb * K + C) * 2u; } }
    const size_t kstep = (size_t)(BK * 2);
    const size_t hstep = (size_t)HALF * K * 2;
    const size_t tstep = 2 * hstep;
    const unsigned ldsw = (unsigned)wid * 1024u;
    const int aoff = lds_byte(wr * 64 + fr, fq * 8), boff = lds_byte(wc * 32 + fr, fq * 8);
#define PG8_SA(b, h) (((b) * 2 + (h)) * HTB)
#define PG8_SB(b, h) ((4 + (b) * 2 + (h)) * HTB)
#define PG8_STAGE(bufoff, gbase) do { _Pragma("unroll") for (int _i = 0; _i < 2; ++_i) \
        __builtin_amdgcn_global_load_lds((const unsigned*)((const char*)(gbase) + (((bufoff) >= 4 * HTB) ? voffB[_i] : voffA[_i])), (LAS unsigned*)(lds + (bufoff) + ldsw + _i * 8192), 16, 0, 0); } while (0)
#define PG8_LDA(dst, b, h) do { _Pragma("unroll") for (int m = 0; m < 4; ++m) _Pragma("unroll") for (int k = 0; k < 2; ++k) dst[m][k] = *(const LAS bf16x8*)(lds + PG8_SA(b, h) + aoff + m * 2048 + k * 1024); } while (0)
#define PG8_LDB(dst, b, h) do { _Pragma("unroll") for (int n = 0; n < 2; ++n) _Pragma("unroll") for (int k = 0; k < 2; ++k) dst[n][k] = *(const LAS bf16x8*)(lds + PG8_SB(b, h) + boff + n * 2048 + k * 1024); } while (0)
#define PG8_MMA(ai, bj, At, Bt) do { __builtin_amdgcn_s_setprio(1); _Pragma("unroll") for (int m = 0; m < 4; ++m) _Pragma("unroll") for (int n = 0; n < 2; ++n) _Pragma("unroll") for (int k = 0; k < 2; ++k) \
        acc[ai][bj][m][n] = __builtin_amdgcn_mfma_f32_16x16x32_bf16(Bt[n][k], At[m][k], acc[ai][bj][m][n], 0, 0, 0); __builtin_amdgcn_s_setprio(0); } while (0)
#define PG8_WAIT_V(n) asm volatile("s_waitcnt vmcnt(" #n ")" ::: "memory")
#define PG8_WAIT_L(n) asm volatile("s_waitcnt lgkmcnt(" #n ")" ::: "memory")
#define PG8_BAR __builtin_amdgcn_s_barrier()
#define PG8_SCHED __builtin_amdgcn_sched_barrier(0)
    Unit cur, nxt; int ui = 0;
    if (!S.next(0, cur)) return;
    f32x4 acc[2][2][4][2];
#pragma unroll
    for (int a = 0; a < 2; ++a)
#pragma unroll
        for (int b = 0; b < 2; ++b)
#pragma unroll
            for (int m = 0; m < 4; ++m)
#pragma unroll
                for (int n = 0; n < 2; ++n) acc[a][b][m][n] = (f32x4){0.f, 0.f, 0.f, 0.f};
    bf16x8 At[4][2], B0[2][2], B1[2][2];
    const char* cA = S.aptr(cur, tstep); const char* cB = S.bptr(cur, tstep);
    PG8_STAGE(PG8_SB(0, 0), cB); PG8_STAGE(PG8_SA(0, 0), cA); PG8_STAGE(PG8_SB(0, 1), cB + hstep); PG8_STAGE(PG8_SA(0, 1), cA + hstep);
    if (wr == 1) PG8_BAR;
    PG8_WAIT_V(4); PG8_BAR;
    PG8_STAGE(PG8_SB(1, 0), cB + kstep); PG8_STAGE(PG8_SA(1, 0), cA + kstep); PG8_STAGE(PG8_SB(1, 1), cB + hstep + kstep);
    PG8_WAIT_V(6); PG8_BAR;
    for (;;) {
        const bool has_next = S.next(ui + 1, nxt);
        const char* nA = has_next ? S.aptr(nxt, tstep) : cA; const char* nB = has_next ? S.bptr(nxt, tstep) : cB;
        for (int hf = 0; hf < (Epi::HAS_MID ? 2 : 1); ++hf) {
        const int t_lo = Epi::HAS_MID ? hf * (nt / 2) : 0, t_hi = Epi::HAS_MID ? (hf + 1) * (nt / 2) : nt;
        if constexpr (Epi::HAS_MID) { if (hf == 1) { E.mid(acc, cur, wr, wc, fr, fq); PG8_SCHED; } }
#pragma unroll 1
        for (int t = t_lo; t < t_hi; t += 2) {
            const bool last = (t == nt - 2);
            const char* a1 = cA + (size_t)(t + 1) * kstep;
            const char* a2 = last ? nA : cA + (size_t)(t + 2) * kstep; const char* b2 = last ? nB : cB + (size_t)(t + 2) * kstep;
            const char* a3 = a2 + kstep; const char* b3 = b2 + kstep;
            PG8_LDB(B0, 0, 0); PG8_SCHED; PG8_LDA(At, 0, 0); PG8_STAGE(PG8_SA(1, 1), a1 + hstep);
            PG8_WAIT_L(8); PG8_BAR; PG8_WAIT_L(0); PG8_MMA(0, 0, At, B0); PG8_BAR; PG8_SCHED;
            PG8_LDB(B1, 0, 1); PG8_STAGE(PG8_SB(0, 0), b2);
            PG8_BAR; PG8_WAIT_L(0); PG8_MMA(0, 1, At, B1); PG8_BAR;
            PG8_LDA(At, 0, 1); PG8_STAGE(PG8_SA(0, 0), a2);
            PG8_BAR; PG8_WAIT_L(0); PG8_MMA(1, 0, At, B0); PG8_BAR; PG8_SCHED;
            PG8_STAGE(PG8_SB(0, 1), b2 + hstep);
            PG8_WAIT_V(6); PG8_BAR; PG8_MMA(1, 1, At, B1); PG8_BAR;
            PG8_LDB(B0, 1, 0); PG8_SCHED; PG8_LDA(At, 1, 0); PG8_STAGE(PG8_SA(0, 1), a2 + hstep);
            PG8_WAIT_L(8); PG8_BAR; PG8_WAIT_L(0); PG8_MMA(0, 0, At, B0); PG8_BAR; PG8_SCHED;
            PG8_LDB(B1, 1, 1); PG8_STAGE(PG8_SB(1, 0), b3);
            PG8_BAR; PG8_WAIT_L(0); PG8_MMA(0, 1, At, B1); PG8_BAR;
            PG8_LDA(At, 1, 1); PG8_STAGE(PG8_SA(1, 0), a3);
            PG8_BAR; PG8_WAIT_L(0); PG8_MMA(1, 0, At, B0); PG8_BAR; PG8_SCHED;
            PG8_STAGE(PG8_SB(1, 1), b3 + hstep);
            PG8_WAIT_V(6); PG8_BAR; PG8_MMA(1, 1, At, B1); PG8_BAR;
        }
        }
        E(acc, cur, wr, wc, fr, fq);
        if (!has_next) break;
#pragma unroll
        for (int a = 0; a < 2; ++a)
#pragma unroll
            for (int b = 0; b < 2; ++b)
#pragma unroll
                for (int m = 0; m < 4; ++m)
#pragma unroll
                    for (int n = 0; n < 2; ++n) acc[a][b][m][n] = (f32x4){0.f, 0.f, 0.f, 0.f};
        cur = nxt; cA = nA; cB = nB; ++ui;
    }
    PG8_WAIT_V(0);
    if (wr == 0) PG8_BAR;
    PG8_BAR;
#undef PG8_SA
#undef PG8_SB
#undef PG8_STAGE
#undef PG8_LDA
#undef PG8_LDB
#undef PG8_MMA
#undef PG8_WAIT_V
#undef PG8_WAIT_L
#undef PG8_BAR
#undef PG8_SCHED
}
}

typedef f32x4 AccT[2][2][4][2];
#define EPI_LOOP_ROWS for (int ai = 0; ai < 2; ++ai) _Pragma("unroll") for (int m = 0; m < 4; ++m)
#define EPI_LOOP_COLS for (int bj = 0; bj < 2; ++bj) _Pragma("unroll") for (int n = 0; n < 2; ++n)

struct EpiProj {
    static constexpr bool HAS_MID = false;
    const float* ss0; const float* b_a; bf16_t* proj; float* loga; float* out; bf16_t* kb; bf16_t* vtb;
    __device__ __forceinline__ void operator()(const AccT& acc, const pg8::Unit& u, int wr, int wc, int fr, int fq) const {
        const int row0 = u.pm * 256 + wr * 64 + fr, col0 = u.pn * 256 + wc * 32 + 8 * fq;
        if (u.job == 0) {
            const int pn = u.pn;
            const int kind = (pn == 4) ? 3 : ((pn == 5 || pn == 6 || pn == 11 || pn == 12) ? 1 : (pn >= 13 ? 2 : 0));
            const float sc = (pn == 0 || pn == 8) ? 0.125f : 1.0f;
            float rsv[2][4];
#pragma unroll
            EPI_LOOP_ROWS rsv[ai][m] = ss0[row0 + ai * 128 + m * 16];
#pragma unroll
            EPI_LOOP_ROWS {
                const int row = row0 + ai * 128 + m * 16;
                const float rs = rsqrtf(rsv[ai][m] * (1.0f / 1024.0f) + EPS) * sc;
                u32x2 wp = (u32x2){0u, 0u};
#pragma unroll
                EPI_LOOP_COLS {
                    const int col = col0 + bj * 128 + n * 4;
                    f32x4 v = acc[ai][bj][m][n] * rs;
                    if (kind == 3) {
                        const f32x4 bb = *(const f32x4*)(b_a + (col - 1024));
                        f32x4 o;
#pragma unroll
                        for (int j = 0; j < 4; ++j) { const float z = v[j] + bb[j]; o[j] = (fminf(z, 0.f) - __logf(1.0f + __expf(-fabsf(z)))) * (1.0f / 16.0f); }
                        *(f32x4*)(loga + (size_t)row * 256 + (col - 1024)) = o;
                    } else {
                        if (kind == 1) {
#pragma unroll
                            for (int j = 0; j < 4; ++j) v[j] = v[j] * sigmoidf_(v[j]);
                        } else if (kind == 2) {
#pragma unroll
                            for (int j = 0; j < 4; ++j) v[j] = sigmoidf_(v[j]);
                        }
                        u32x2 w; w.x = cvt_pk_bf16(v[0], v[1]); w.y = cvt_pk_bf16(v[2], v[3]);
                        if (n == 0) wp = w; else { u32x4 W_; W_.x = wp.x; W_.y = wp.y; W_.z = w.x; W_.w = w.y; *(u32x4*)(proj + (size_t)row * NPROJ + col - 4) = W_; }
                    }
                }
            }
        } else {
            float rsv[2][4];
#pragma unroll
            EPI_LOOP_ROWS rsv[ai][m] = ss0[M_TOK + row0 + ai * 128 + m * 16];
#pragma unroll
            EPI_LOOP_ROWS {
                const int row = row0 + ai * 128 + m * 16;
                const float rs = rsqrtf(rsv[ai][m] * (1.0f / 1024.0f) + EPS);
#pragma unroll
                EPI_LOOP_COLS {
                    const int col = col0 + bj * 128 + n * 4;
                    const f32x4 v = acc[ai][bj][m][n] * rs;
                    if (col < 1024) {
                        *(f32x4*)(out + OUT_MK + (size_t)row * 1024 + col) = v;
                        u32x2 w; w.x = cvt_pk_bf16(v[0], v[1]); w.y = cvt_pk_bf16(v[2], v[3]);
                        *(u32x2*)(kb + (size_t)row * 1024 + col) = w;
                    } else {
                        const int c = col - 1024;
                        *(f32x4*)(out + OUT_MV + (size_t)row * 1024 + c) = v;
                        const int b = row >> 8, mem = row & 255;
                        const unsigned w0 = cvt_pk_bf16(v[0], v[1]), w1 = cvt_pk_bf16(v[2], v[3]);
                        bf16_t* vt = vtb + ((size_t)b * 1024 + c) * 256 + mem;
                        vt[0] = (bf16_t)(w0 & 0xffff); vt[256] = (bf16_t)(w0 >> 16); vt[512] = (bf16_t)(w1 & 0xffff); vt[768] = (bf16_t)(w1 >> 16);
                    }
                }
            }
        }
    }
};

struct EpiMerge {
    static constexpr bool HAS_MID = true;
    const bf16_t* proj; bf16_t* mrg;
    __device__ __forceinline__ void mid(AccT& acc, const pg8::Unit& u, int wr, int wc, int fr, int fq) const {
        const int row0 = u.pm * 256 + wr * 64 + fr, col0 = u.pn * 256 + wc * 32 + 8 * fq;
#pragma unroll
        for (int ai = 0; ai < 2; ++ai) {
            u32x2 a[4][2][2], b[4][2][2];
#pragma unroll
            for (int m = 0; m < 4; ++m) {
                unsigned roff = (unsigned)(row0 + ai * 128 + m * 16) * (unsigned)NPROJ + (unsigned)col0;
                asm volatile("" : "+v"(roff));
                const bf16_t* rp = proj + roff;
#pragma unroll
                for (int bj = 0; bj < 2; ++bj) { const u32x4 ta_ = *(const u32x4*)(rp + 3328 + bj * 128), tb_ = *(const u32x4*)(rp + 4352 + bj * 128);
                    a[m][bj][0] = (u32x2){ta_.x, ta_.y}; a[m][bj][1] = (u32x2){ta_.z, ta_.w}; b[m][bj][0] = (u32x2){tb_.x, tb_.y}; b[m][bj][1] = (u32x2){tb_.z, tb_.w}; }
            }
#pragma unroll
            for (int m = 0; m < 4; ++m) {
#pragma unroll
                EPI_LOOP_COLS {
                    const u32x2 av = a[m][bj][n], bv = b[m][bj][n];
                    f32x4 r;
                    r[0] = bflo(av.x) * __builtin_amdgcn_rcpf(bflo(bv.x)); r[1] = bfhi(av.x) * __builtin_amdgcn_rcpf(bfhi(bv.x));
                    r[2] = bflo(av.y) * __builtin_amdgcn_rcpf(bflo(bv.y)); r[3] = bfhi(av.y) * __builtin_amdgcn_rcpf(bfhi(bv.y));
                    acc[ai][bj][m][n] *= r;
                }
                asm volatile("" : "+v"(acc[ai][0][m][0]), "+v"(acc[ai][0][m][1]), "+v"(acc[ai][1][m][0]), "+v"(acc[ai][1][m][1]) :: "memory");
            }
        }
    }
    __device__ __forceinline__ void operator()(const AccT& acc, const pg8::Unit& u, int wr, int wc, int fr, int fq) const {
        const int row0 = u.pm * 256 + wr * 64 + fr, col0 = u.pn * 256 + wc * 32 + 8 * fq;
        u32x2 b[2][4][2][2];
#pragma unroll
        EPI_LOOP_ROWS {
            const bf16_t* rp = proj + (size_t)(row0 + ai * 128 + m * 16) * NPROJ + 4352 + col0;
#pragma unroll
            for (int bj = 0; bj < 2; ++bj) { const u32x4 t_ = *(const u32x4*)(rp + bj * 128); b[ai][m][bj][0] = (u32x2){t_.x, t_.y}; b[ai][m][bj][1] = (u32x2){t_.z, t_.w}; }
        }
#pragma unroll
        EPI_LOOP_ROWS {
            const int row = row0 + ai * 128 + m * 16;
            u32x2 wp = (u32x2){0u, 0u};
#pragma unroll
            EPI_LOOP_COLS {
                const int col = col0 + bj * 128 + n * 4;
                const u32x2 bv = b[ai][m][bj][n];
                const f32x4 v = acc[ai][bj][m][n];
                u32x2 w; w.x = cvt_pk_bf16(v[0] * bflo(bv.x), v[1] * bfhi(bv.x)); w.y = cvt_pk_bf16(v[2] * bflo(bv.y), v[3] * bfhi(bv.y));
                if (n == 0) wp = w; else { u32x4 W_; W_.x = wp.x; W_.y = wp.y; W_.z = w.x; W_.w = w.y; *(u32x4*)(mrg + (size_t)row * 1024 + col - 4) = W_; }
            }
        }
    }
};

struct EpiResid {
    static constexpr bool HAS_MID = false;
    const bf16_t* base; bf16_t* HB; float* SS;
    __device__ __forceinline__ void operator()(const AccT& acc, const pg8::Unit& u, int wr, int wc, int fr, int fq) const {
        const int row0 = u.pm * 256 + wr * 64 + fr, col0 = u.pn * 256 + wc * 32 + 8 * fq;
        u32x2 bv[2][4][2][2];
#pragma unroll
        EPI_LOOP_ROWS {
            const bf16_t* rp = base + (size_t)(row0 + ai * 128 + m * 16) * 1024 + col0;
#pragma unroll
            for (int bj = 0; bj < 2; ++bj) { const u32x4 t_ = *(const u32x4*)(rp + bj * 128); bv[ai][m][bj][0] = (u32x2){t_.x, t_.y}; bv[ai][m][bj][1] = (u32x2){t_.z, t_.w}; }
        }
#pragma unroll
        EPI_LOOP_ROWS {
            const int row = row0 + ai * 128 + m * 16;
            float s = 0.f; u32x2 wp = (u32x2){0u, 0u};
#pragma unroll
            EPI_LOOP_COLS {
                const int col = col0 + bj * 128 + n * 4;
                const u32x2 b = bv[ai][m][bj][n];
                f32x4 v = acc[ai][bj][m][n];
                v[0] += bflo(b.x); v[1] += bfhi(b.x); v[2] += bflo(b.y); v[3] += bfhi(b.y);
                s += (v[0] * v[0] + v[1] * v[1]) + (v[2] * v[2] + v[3] * v[3]);
                u32x2 w; w.x = cvt_pk_bf16(v[0], v[1]); w.y = cvt_pk_bf16(v[2], v[3]);
                if (n == 0) wp = w; else { u32x4 W_; W_.x = wp.x; W_.y = wp.y; W_.z = w.x; W_.w = w.y; *(u32x4*)(HB + (size_t)row * 1024 + col - 4) = W_; }
            }
            s += __shfl_xor(s, 16); s += __shfl_xor(s, 32);
            if (fq == 0) SS[(size_t)(u.pn * 4 + wc) * M_TOK + row] = s;
        }
    }
};

struct EpiScale {
    static constexpr bool HAS_MID = false;
    const float* SS; bf16_t* O; int ldo; float sc;
    __device__ __forceinline__ void operator()(const AccT& acc, const pg8::Unit& u, int wr, int wc, int fr, int fq) const {
        const int row0 = u.pm * 256 + wr * 64 + fr, col0 = u.pn * 256 + wc * 32 + 8 * fq;
        float part[2][4];
#pragma unroll
        EPI_LOOP_ROWS {
            const int row = row0 + ai * 128 + m * 16;
            float t = 0.f;
#pragma unroll
            for (int q = 0; q < 4; ++q) t += SS[(size_t)(fq * 4 + q) * M_TOK + row];
            part[ai][m] = t;
        }
#pragma unroll
        EPI_LOOP_ROWS {
            const int row = row0 + ai * 128 + m * 16;
            float ssum = part[ai][m];
            ssum += __shfl_xor(ssum, 16); ssum += __shfl_xor(ssum, 32);
            const float rs = rsqrtf(ssum * (1.0f / 1024.0f) + EPS) * sc;
            u32x2 wp = (u32x2){0u, 0u};
#pragma unroll
            EPI_LOOP_COLS {
                const int col = col0 + bj * 128 + n * 4;
                const f32x4 v = acc[ai][bj][m][n] * rs;
                u32x2 w; w.x = cvt_pk_bf16(v[0], v[1]); w.y = cvt_pk_bf16(v[2], v[3]);
                if (n == 0) wp = w; else { u32x4 W_; W_.x = wp.x; W_.y = wp.y; W_.z = w.x; W_.w = w.y; *(u32x4*)(O + (size_t)row * ldo + col - 4) = W_; }
            }
        }
    }
};

struct TJob { const float* src; int ld, c0, tn, K; bf16_t* dst; int Kd, kofs; const float* gain; };
__device__ __forceinline__ void tjob_get(const Params& p, int T, TJob& j, int& tile) {
    unsigned char* ws = p.ws;
    if (T < 256) { j = TJob{p.in[8], 5136, 0, 16, 1024, (bf16_t*)(ws + OFF_WTIN), 1024, 0, p.in[7]}; tile = T; return; }
    T -= 256;
    if (T < 1024) { j = TJob{p.in[8], 5136, 1040, 64, 1024, (bf16_t*)(ws + OFF_WTIN) + (size_t)1280 * 1024, 1024, 0, p.in[7]}; tile = T; return; }
    T -= 1024;
    if (T < 128) { j = TJob{p.in[13], 1024, 0, 16, 512, (bf16_t*)(ws + OFF_WTP), 1024, 0, nullptr}; tile = T; return; }
    T -= 128;
    if (T < 128) { j = TJob{p.in[14], 1024, 0, 16, 512, (bf16_t*)(ws + OFF_WTP), 1024, 512, nullptr}; tile = T; return; }
    T -= 128;
    if (T < 256) { j = TJob{p.in[15], 1024, 0, 16, 1024, (bf16_t*)(ws + OFF_WTO), 1024, 0, nullptr}; tile = T; return; }
    T -= 256;
    if (T < 256) { j = TJob{p.in[18], 1024, 0, 16, 1024, (bf16_t*)(ws + OFF_WTXQ), 1024, 0, p.in[16]}; tile = T; return; }
    T -= 256;
    if (T < 256) { j = TJob{p.in[19], 1024, 0, 16, 1024, (bf16_t*)(ws + OFF_WTKV), 1024, 0, p.in[17]}; tile = T; return; }
    T -= 256;
    if (T < 256) { j = TJob{p.in[20], 1024, 0, 16, 1024, (bf16_t*)(ws + OFF_WTKV) + (size_t)1024 * 1024, 1024, 0, p.in[17]}; tile = T; return; }
    T -= 256;
    if (T < 256) { j = TJob{p.in[21], 1024, 0, 16, 1024, (bf16_t*)(ws + OFF_WTXO), 1024, 0, nullptr}; tile = T; return; }
    T -= 256;
    j = TJob{p.in[23], 2048, 0, 32, 1024, (bf16_t*)(ws + OFF_WTPQ), 1024, 0, p.in[22]}; tile = T;
}
constexpr int N_TTILES = 256 + 1024 + 128 + 128 + 256 * 5 + 512;

__device__ void phase_prep(const Params& p, LAS unsigned char* lds) {
    int tid_ = threadIdx.x; asm volatile("" : "+v"(tid_)); const int tid = tid_, lane = tid & 63, wid = tid >> 6;
    const int gw = blockIdx.x * 8 + wid, nw = gridDim.x * 8;
    const size_t gt = (size_t)blockIdx.x * NTHR + tid, ngt = (size_t)gridDim.x * NTHR;
    unsigned char* ws = p.ws;
    {
        bf16_t* A0 = (bf16_t*)(ws + OFF_A0); float* ss0 = (float*)(ws + OFF_SS0);
        for (int r = gw; r < M_ALL; r += nw) {
            const float* src = r < M_PR ? p.in[0] + (size_t)r * 1024 : (r < M_TOK ? p.in[1] + (size_t)(r - M_PR) * 1024 : p.in[2] + (size_t)(r - M_TOK) * 1024);
            float s = 0.f;
#pragma unroll
            for (int i = 0; i < 4; ++i) {
                const f32x4 v = *(const f32x4*)(src + i * 256 + lane * 4);
                s += (v[0] * v[0] + v[1] * v[1]) + (v[2] * v[2] + v[3] * v[3]);
                u32x2 w; w.x = cvt_pk_bf16(v[0], v[1]); w.y = cvt_pk_bf16(v[2], v[3]);
                *(u32x2*)(A0 + (size_t)r * 1024 + i * 256 + lane * 4) = w;
            }
            s = wave_sum(s);
            if (lane == 0) ss0[r] = s;
        }
    }
    { float* z = (float*)(ws + OFF_SS1); for (size_t i = gt; i < (size_t)2 * M_TOK; i += ngt) z[i] = 0.f; }
    {
        const size_t n_sk = (size_t)8 * 2 * 128 * 128 / 8;
        for (size_t k = gt; k < n_sk; k += ngt) {
            const float* src = p.in[24]; bf16_t* dst = (bf16_t*)(ws + OFF_SKB);
            const f32x4 a = *(const f32x4*)(src + k * 8), b = *(const f32x4*)(src + k * 8 + 4);
            u32x4 w; w.x = cvt_pk_bf16(a[0], a[1]); w.y = cvt_pk_bf16(a[2], a[3]); w.z = cvt_pk_bf16(b[0], b[1]); w.w = cvt_pk_bf16(b[2], b[3]);
            *(u32x4*)(dst + k * 8) = w;
        }
        const size_t n_u = (size_t)16384 * 1024 / 16;
        for (size_t i = gt; i < 2 * n_u; i += ngt) {
            const bool isv = i >= n_u; const size_t k = isv ? i - n_u : i;
            const float* src = (isv ? p.in[26] : p.in[25]) + k * 16; unsigned char* dst = ws + (isv ? OFF_VB : OFF_UB) + k * 16;
            const float sc = isv ? 64.0f : 1024.0f;
            u32x4 w;
#pragma unroll
            for (int q = 0; q < 4; ++q) {
                f32x4 a = *(const f32x4*)(src + q * 4) * sc;
#pragma unroll
                for (int e = 0; e < 4; ++e) a[e] = fminf(fmaxf(a[e], -448.0f), 448.0f);
                int t = 0;
                t = __builtin_amdgcn_cvt_pk_fp8_f32(a[0], a[1], t, false);
                t = __builtin_amdgcn_cvt_pk_fp8_f32(a[2], a[3], t, true);
                w[q] = (unsigned)t;
            }
            *(u32x4*)dst = w;
        }
    }
    {
        const float* w_in = p.in[8]; const float* w_a2 = p.in[9]; const float* g = p.in[7];
        bf16_t* dst = (bf16_t*)(ws + OFF_WTIN) + (size_t)1024 * 1024;
        for (size_t i = gt; i < (size_t)256 * 128; i += ngt) {
            const int j = (int)(i >> 7), k0 = (int)(i & 127) * 8;
            float wa[16];
#pragma unroll
            for (int r = 0; r < 16; ++r) wa[r] = w_a2[r * 256 + j];
            float o[8];
#pragma unroll
            for (int e = 0; e < 8; ++e) {
                const float* wr_ = w_in + (size_t)(k0 + e) * 5136 + 1024;
                float s = 0.f;
#pragma unroll
                for (int r4 = 0; r4 < 4; ++r4) { const f32x4 v = *(const f32x4*)(wr_ + r4 * 4); s += v[0] * wa[r4 * 4] + v[1] * wa[r4 * 4 + 1] + v[2] * wa[r4 * 4 + 2] + v[3] * wa[r4 * 4 + 3]; }
                o[e] = s * g[k0 + e];
            }
            u32x4 w; w.x = cvt_pk_bf16(o[0], o[1]); w.y = cvt_pk_bf16(o[2], o[3]); w.z = cvt_pk_bf16(o[4], o[5]); w.w = cvt_pk_bf16(o[6], o[7]);
            *(u32x4*)(dst + (size_t)j * 1024 + k0) = w;
        }
    }
    {
        LAS float* tl = (LAS float*)lds;
        for (int T = blockIdx.x; T < N_TTILES; T += gridDim.x) {
            TJob j; int tile; tjob_get(p, T, j, tile);
            const int tk = tile / j.tn, tnn = tile % j.tn, k0 = tk * 64, n0 = tnn * 64;
            {
                const int kr = tid >> 4, nc = (tid & 15) * 4;
#pragma unroll
                for (int pp = 0; pp < 2; ++pp) {
                    const int k = k0 + kr + 32 * pp;
                    f32x4 v = *(const f32x4*)(j.src + (size_t)k * j.ld + j.c0 + n0 + nc);
                    if (j.gain) v *= j.gain[k];
                    LAS float* d = tl + (kr + 32 * pp) * 65 + nc;
                    d[0] = v[0]; d[1] = v[1]; d[2] = v[2]; d[3] = v[3];
                }
            }
            __syncthreads();
            {
                const int n = tid >> 3, kq = (tid & 7) * 8;
                float o[8];
#pragma unroll
                for (int e = 0; e < 8; ++e) o[e] = tl[(kq + e) * 65 + n];
                u32x4 w; w.x = cvt_pk_bf16(o[0], o[1]); w.y = cvt_pk_bf16(o[2], o[3]); w.z = cvt_pk_bf16(o[4], o[5]); w.w = cvt_pk_bf16(o[6], o[7]);
                *(u32x4*)(j.dst + (size_t)(n0 + n) * j.Kd + j.kofs + k0 + kq) = w;
            }
            __syncthreads();
        }
    }
}

#define MFMA16(a, b, c) __builtin_amdgcn_mfma_f32_16x16x32_bf16((a), (b), (c), 0, 0, 0)
__device__ __forceinline__ float scan64(float v, int lane) {
#pragma unroll
    for (int o = 1; o < 64; o <<= 1) { const float t = __shfl_up(v, o); if (lane >= o) v += t; }
    return v;
}
__device__ void phase_scan(const Params& p, LAS unsigned char* lds) {
    int tid_ = threadIdx.x; asm volatile("" : "+v"(tid_)); const int tid = tid_, lane = tid & 63, wid = tid >> 6, fr = lane & 15, fq = lane >> 4;
    const bf16_t* proj = (const bf16_t*)(p.ws + OFF_PROJ); const float* loga = (const float*)(p.ws + OFF_LOGA);
    float* omix = (float*)(p.ws + OFF_X);
    constexpr int P = 72;
    for (int u = blockIdx.x; u < 256; u += gridDim.x) {
        const int vs = u & 3, mx = (u >> 2) & 1, h = (u >> 3) & 3, b = u >> 5;
        const int qoff = (mx ? 1792 : 0) + h * 64, koff = (mx ? 2048 : 256) + h * 64, voff = (mx ? 2304 : 512) + h * 128 + vs * 32;
        const float lg = log1pf(-exp2f(-5.0f - (float)h));
        float inv[4];
#pragma unroll
        for (int e = 0; e < 4; ++e) inv[e] = exp2f(-(float)(4 * wid + e) * (13.287712379549449f / 32.0f));
        f32x4 sacc = (f32x4){0.f, 0.f, 0.f, 0.f};
        LAS bf16_t* QE = (LAS bf16_t*)lds; LAS bf16_t* KE = (LAS bf16_t*)(lds + 9216);
        LAS bf16_t* ATT = (LAS bf16_t*)(lds + 18432);
        LAS bf16_t* ST = (LAS bf16_t*)(lds + 27648);
        for (int i = tid; i < 32 * P; i += NTHR) ST[i] = 0;
        const int ct = wid >> 2, w4 = wid & 3;
        u32x2 rq0, rq1, rk0, rk1, rv; f32x4 rl0 = (f32x4){0.f, 0.f, 0.f, 0.f}, rl1 = rl0;
        u32x4 gq, gk, gv = (u32x4){0u, 0u, 0u, 0u}; f32x4 gl0 = (f32x4){0.f, 0.f, 0.f, 0.f}, gl1 = gl0;
#define SCAN_RAW(bi) (lds + 61440 + (bi) * 40960)
#define SCAN_STAGE_LOAD(ch) do { const size_t tb_ = (size_t)b * 2048 + (ch) * 64; \
            gq = *(const u32x4*)(proj + (tb_ + (tid >> 3)) * NPROJ + qoff + (tid & 7) * 8); gk = *(const u32x4*)(proj + (tb_ + (tid >> 3)) * NPROJ + koff + (tid & 7) * 8); \
            if (tid < 256) gv = *(const u32x4*)(proj + (tb_ + (tid >> 2)) * NPROJ + voff + (tid & 3) * 8); \
            if (!mx) { gl0 = *(const f32x4*)(loga + (tb_ + (tid >> 4)) * 256 + h * 64 + (tid & 15) * 4); gl1 = *(const f32x4*)(loga + (tb_ + 32 + (tid >> 4)) * 256 + h * 64 + (tid & 15) * 4); } } while (0)
#define SCAN_STAGE_WRITE(bi) do { LAS unsigned char* r_ = SCAN_RAW(bi); \
            *(LAS u32x4*)(r_ + (tid >> 3) * 144 + (tid & 7) * 16) = gq; *(LAS u32x4*)(r_ + 9216 + (tid >> 3) * 144 + (tid & 7) * 16) = gk; \
            if (tid < 256) *(LAS u32x4*)(r_ + 18432 + (tid >> 2) * 80 + (tid & 3) * 16) = gv; \
            if (!mx) { *(LAS f32x4*)(r_ + 23552 + (tid >> 4) * 272 + (tid & 15) * 16) = gl0; *(LAS f32x4*)(r_ + 23552 + (32 + (tid >> 4)) * 272 + (tid & 15) * 16) = gl1; } } while (0)
#define SCAN_READ_RAW(bi) do { const LAS unsigned char* r_ = SCAN_RAW(bi); \
            rq0 = *(const LAS u32x2*)(r_ + lane * 144 + 8 * wid); rq1 = *(const LAS u32x2*)(r_ + lane * 144 + 64 + 8 * wid); \
            rk0 = *(const LAS u32x2*)(r_ + 9216 + lane * 144 + 8 * wid); rk1 = *(const LAS u32x2*)(r_ + 9216 + lane * 144 + 64 + 8 * wid); \
            rv = *(const LAS u32x2*)(r_ + 18432 + lane * 80 + 8 * wid); \
            if (!mx) { rl0 = *(const LAS f32x4*)(r_ + 23552 + lane * 272 + 16 * wid); rl1 = *(const LAS f32x4*)(r_ + 23552 + lane * 272 + 128 + 16 * wid); } } while (0)
        SCAN_STAGE_LOAD(0); SCAN_STAGE_WRITE(0); SCAN_STAGE_LOAD(1);
        __syncthreads();
        for (int ch = 0; ch < 32; ++ch) {
            SCAN_READ_RAW(ch & 1);
            LAS unsigned char* buf = lds + 32256 + (ch & 1) * 14336;
            LAS bf16_t* KDT = (LAS bf16_t*)buf; LAS bf16_t* VT = (LAS bf16_t*)(buf + 9216); LAS float* DL = (LAS float*)(buf + 13824);
            {
                float qa[4] = {bflo(rq0.x), bfhi(rq0.x), bflo(rq0.y), bfhi(rq0.y)}, qb[4] = {bflo(rq1.x), bfhi(rq1.x), bflo(rq1.y), bfhi(rq1.y)};
                float ka[4] = {bflo(rk0.x), bfhi(rk0.x), bflo(rk0.y), bfhi(rk0.y)}, kb[4] = {bflo(rk1.x), bfhi(rk1.x), bflo(rk1.y), bfhi(rk1.y)};
                float ba[4], bb[4], la[4], lb[4];
                if (mx) {
                    const float pos = (float)(ch * 64 + lane);
#pragma unroll
                    for (int e = 0; e < 4; ++e) {
                        float sn, cs; sincosf(pos * inv[e], &sn, &cs);
                        const float q1 = qa[e], q2 = qb[e], k1 = ka[e], k2 = kb[e];
                        qa[e] = q1 * cs - q2 * sn; qb[e] = q1 * sn + q2 * cs; ka[e] = k1 * cs - k2 * sn; kb[e] = k1 * sn + k2 * cs;
                        ba[e] = bb[e] = (float)(lane + 1) * lg; la[e] = lb[e] = 64.0f * lg;
                    }
                } else {
#pragma unroll
                    for (int e = 0; e < 4; ++e) { ba[e] = scan64(rl0[e], lane); bb[e] = scan64(rl1[e], lane); la[e] = __shfl(ba[e], 63); lb[e] = __shfl(bb[e], 63); }
                }
                float qea[4], qeb[4], kea[4], keb[4];
#pragma unroll
                for (int e = 0; e < 4; ++e) {
                    qea[e] = qa[e] * __expf(ba[e]); qeb[e] = qb[e] * __expf(bb[e]);
                    kea[e] = ka[e] * __expf(-ba[e]); keb[e] = kb[e] * __expf(-bb[e]);
                    const float kda = ka[e] * __expf(la[e] - ba[e]), kdb = kb[e] * __expf(lb[e] - bb[e]);
                    KDT[(4 * wid + e) * P + lane] = (bf16_t)(cvt_pk_bf16(kda, 0.f) & 0xffff);
                    KDT[(32 + 4 * wid + e) * P + lane] = (bf16_t)(cvt_pk_bf16(kdb, 0.f) & 0xffff);
                    if (lane == 63) { DL[4 * wid + e] = __expf(la[e]); DL[32 + 4 * wid + e] = __expf(lb[e]); }
                }
                u32x2 w;
                w.x = cvt_pk_bf16(qea[0], qea[1]); w.y = cvt_pk_bf16(qea[2], qea[3]); *(LAS u32x2*)(QE + lane * P + 4 * wid) = w;
                w.x = cvt_pk_bf16(qeb[0], qeb[1]); w.y = cvt_pk_bf16(qeb[2], qeb[3]); *(LAS u32x2*)(QE + lane * P + 32 + 4 * wid) = w;
                w.x = cvt_pk_bf16(kea[0], kea[1]); w.y = cvt_pk_bf16(kea[2], kea[3]); *(LAS u32x2*)(KE + lane * P + 4 * wid) = w;
                w.x = cvt_pk_bf16(keb[0], keb[1]); w.y = cvt_pk_bf16(keb[2], keb[3]); *(LAS u32x2*)(KE + lane * P + 32 + 4 * wid) = w;
                VT[(4 * wid + 0) * P + lane] = (bf16_t)(rv.x & 0xffff); VT[(4 * wid + 1) * P + lane] = (bf16_t)(rv.x >> 16);
                VT[(4 * wid + 2) * P + lane] = (bf16_t)(rv.y & 0xffff); VT[(4 * wid + 3) * P + lane] = (bf16_t)(rv.y >> 16);
            }
            SCAN_STAGE_WRITE((ch + 1) & 1);
            { const int chn = (ch + 2 < 32) ? ch + 2 : 31; SCAN_STAGE_LOAD(chn); }
            __syncthreads();
            f32x4 oacc = (f32x4){0.f, 0.f, 0.f, 0.f};
            {
#pragma unroll
                for (int q = 0; q < 2; ++q) {
                    const int idx = wid * 2 + q, sb = idx >> 2, tb = idx & 3;
                    f32x4 a = (f32x4){0.f, 0.f, 0.f, 0.f};
                    if (sb <= tb) {
#pragma unroll
                        for (int ks = 0; ks < 2; ++ks) {
                            const bf16x8 A = *(const LAS bf16x8*)(KE + (sb * 16 + fr) * P + ks * 32 + fq * 8);
                            const bf16x8 B = *(const LAS bf16x8*)(QE + (tb * 16 + fr) * P + ks * 32 + fq * 8);
                            a = MFMA16(A, B, a);
                        }
                        const int tg = tb * 16 + fr, sg = sb * 16 + fq * 4;
#pragma unroll
                        for (int jj = 0; jj < 4; ++jj) if (sg + jj > tg) a[jj] = 0.f;
                    }
                    u32x2 w; w.x = cvt_pk_bf16(a[0], a[1]); w.y = cvt_pk_bf16(a[2], a[3]);
                    *(LAS u32x2*)(ATT + (tb * 16 + fr) * P + sb * 16 + fq * 4) = w;
                }
#pragma unroll
                for (int ks = 0; ks < 2; ++ks) {
#ifdef TEST_ST
                    const bf16x8 A = *(const LAS bf16x8*)(VT + (ct * 16 + fr) * P + ks * 32 + fq * 8);
#else
                    const bf16x8 A = *(const LAS bf16x8*)(ST + (ct * 16 + fr) * P + ks * 32 + fq * 8);
#endif
#ifdef TEST_ST
                    const bf16x8 B = *(const LAS bf16x8*)(KDT + (w4 * 16 + fr) * P + ks * 32 + fq * 8);
#else
                    const bf16x8 B = *(const LAS bf16x8*)(QE + (w4 * 16 + fr) * P + ks * 32 + fq * 8);
#endif
                    oacc = MFMA16(A, B, oacc);
                }
            }
            __syncthreads();
            {
                bf16x8 Av[2];
#pragma unroll
                for (int ks = 0; ks < 2; ++ks) Av[ks] = *(const LAS bf16x8*)(VT + (ct * 16 + fr) * P + ks * 32 + fq * 8);
#pragma unroll
                for (int ks = 0; ks < 2; ++ks) {
                    const bf16x8 B = *(const LAS bf16x8*)(ATT + (w4 * 16 + fr) * P + ks * 32 + fq * 8);
#ifndef NO_ATT
                    oacc = MFMA16(Av[ks], B, oacc);
#endif
                }
                const size_t tok = (size_t)b * 2048 + ch * 64 + w4 * 16 + fr;
                *(f32x4*)(omix + tok * 1024 + mx * 512 + h * 128 + vs * 32 + ct * 16 + fq * 4) = oacc;
                const float d = DL[w4 * 16 + fr];
                sacc *= d;
#pragma unroll
                for (int ks = 0; ks < 2; ++ks) {
                    const bf16x8 B = *(const LAS bf16x8*)(KDT + (w4 * 16 + fr) * P + ks * 32 + fq * 8);
                    sacc = MFMA16(Av[ks], B, sacc);
                }
                const unsigned w0 = cvt_pk_bf16(sacc[0], sacc[1]), w1 = cvt_pk_bf16(sacc[2], sacc[3]);
                LAS bf16_t* sp = ST + (ct * 16 + fq * 4) * P + w4 * 16 + fr;
                sp[0] = (bf16_t)(w0 & 0xffff); sp[P] = (bf16_t)(w0 >> 16); sp[2 * P] = (bf16_t)(w1 & 0xffff); sp[3 * P] = (bf16_t)(w1 >> 16);
            }
        }
        *(f32x4*)(p.out + (mx ? OUT_RETP : OUT_GLAP) + ((size_t)(b * 4 + h) * 64 + w4 * 16 + fr) * 128 + vs * 32 + ct * 16 + fq * 4) = sacc;
        __syncthreads();
#undef SCAN_RAW
#undef SCAN_STAGE_LOAD
#undef SCAN_STAGE_WRITE
#undef SCAN_READ_RAW
    }
    {
        LAS float* qv = (LAS float*)lds; LAS float* kv = qv + 256; LAS float* av = kv + 256; LAS float* red = av + 256;
        for (int su = blockIdx.x; su < 1024; su += gridDim.x) {
            const int mx = su & 1, h = (su >> 1) & 3, b = su >> 3;
            const int qoff = (mx ? 1792 : 0) + h * 64, koff = (mx ? 2048 : 256) + h * 64, voff = (mx ? 2304 : 512) + h * 128;
            if (tid < 256) {
                const int t = tid >> 6, k = tid & 63; const size_t tok = (size_t)M_PR + b * 4 + t; const bf16_t* base = proj + tok * NPROJ;
                float q, kk, a;
                if (mx) {
                    const int j = k & 31;
                    const float q1 = bf2f(base[qoff + j]), q2 = bf2f(base[qoff + 32 + j]), k1 = bf2f(base[koff + j]), k2 = bf2f(base[koff + 32 + j]);
                    const float ang = (float)(16384 + t) * exp2f(-(float)j * (13.287712379549449f / 32.0f));
                    float sn, cs; sincosf(ang, &sn, &cs);
                    if (k < 32) { q = q1 * cs - q2 * sn; kk = k1 * cs - k2 * sn; } else { q = q1 * sn + q2 * cs; kk = k1 * sn + k2 * cs; }
                    a = 1.0f - exp2f(-5.0f - (float)h);
                } else { q = bf2f(base[qoff + k]); kk = bf2f(base[koff + k]); a = __expf(loga[tok * 256 + h * 64 + k]); }
                qv[tid] = q; kv[tid] = kk; av[tid] = a;
            }
            __syncthreads();
            const int v = tid & 127, kg = tid >> 7;
            const float* sin_ = (mx ? p.in[4] : p.in[3]) + ((size_t)(b * 4 + h) * 64 + kg * 16) * 128 + v;
            float S[16];
#pragma unroll
            for (int i = 0; i < 16; ++i) S[i] = sin_[(size_t)i * 128];
#pragma unroll
            for (int t = 0; t < 4; ++t) {
                const float vt = bf2f(proj[((size_t)M_PR + b * 4 + t) * NPROJ + voff + v]);
                float part = 0.f;
#pragma unroll
                for (int i = 0; i < 16; ++i) { const int k = t * 64 + kg * 16 + i; S[i] = av[k] * S[i] + kv[k] * vt; part += qv[k] * S[i]; }
                red[(t * 4 + kg) * 128 + v] = part;
            }
            float* sout = p.out + (mx ? OUT_RETS : OUT_GLAS) + ((size_t)(b * 4 + h) * 64 + kg * 16) * 128 + v;
#pragma unroll
            for (int i = 0; i < 16; ++i) sout[(size_t)i * 128] = S[i];
            __syncthreads();
            {
                const int t = tid >> 7;
                const float o = (red[(t * 4 + 0) * 128 + v] + red[(t * 4 + 1) * 128 + v]) + (red[(t * 4 + 2) * 128 + v] + red[(t * 4 + 3) * 128 + v]);
                omix[((size_t)M_PR + b * 4 + t) * 1024 + mx * 512 + h * 128 + v] = o;
            }
            __syncthreads();
        }
    }
}

__device__ void phase_onorm(const Params& p) {
    int tid_ = threadIdx.x; asm volatile("" : "+v"(tid_)); const int tid = tid_, lane = tid & 63, wid = tid >> 6;
    const bf16_t* proj = (const bf16_t*)(p.ws + OFF_PROJ); const float* omix = (const float*)(p.ws + OFF_X); bf16_t* a2 = (bf16_t*)(p.ws + OFF_A2);
    for (int wt = blockIdx.x * 8 + wid; wt < M_TOK * 2; wt += gridDim.x * 8) {
        const int tok = wt >> 1, mx = wt & 1, c = lane * 8;
        const f32x4 o0 = *(const f32x4*)(omix + (size_t)tok * 1024 + mx * 512 + c), o1 = *(const f32x4*)(omix + (size_t)tok * 1024 + mx * 512 + c + 4);
        float ss = (o0[0] * o0[0] + o0[1] * o0[1]) + (o0[2] * o0[2] + o0[3] * o0[3]) + (o1[0] * o1[0] + o1[1] * o1[1]) + (o1[2] * o1[2] + o1[3] * o1[3]);
        ss += __shfl_xor(ss, 1); ss += __shfl_xor(ss, 2); ss += __shfl_xor(ss, 4); ss += __shfl_xor(ss, 8);
        const float r = rsqrtf(ss * (1.0f / 128.0f) + EPS);
        const float* g = (mx ? p.in[12] : p.in[11]) + c;
        const f32x4 g0 = *(const f32x4*)g, g1 = *(const f32x4*)(g + 4);
        const u32x4 gt = *(const u32x4*)(proj + (size_t)tok * NPROJ + (mx ? 2816 : 1280) + c);
        u32x4 w;
        w.x = cvt_pk_bf16(o0[0] * r * g0[0] * bflo(gt.x), o0[1] * r * g0[1] * bfhi(gt.x));
        w.y = cvt_pk_bf16(o0[2] * r * g0[2] * bflo(gt.y), o0[3] * r * g0[3] * bfhi(gt.y));
        w.z = cvt_pk_bf16(o1[0] * r * g1[0] * bflo(gt.z), o1[1] * r * g1[1] * bfhi(gt.z));
        w.w = cvt_pk_bf16(o1[2] * r * g1[2] * bflo(gt.w), o1[3] * r * g1[3] * bfhi(gt.w));
        *(u32x4*)(a2 + (size_t)tok * 1024 + mx * 512 + c) = w;
    }
}

__device__ void phase_attn(const Params& p, LAS unsigned char* lds) {
    int tid_ = threadIdx.x; asm volatile("" : "+v"(tid_)); const int tid = tid_, lane = tid & 63, wid = tid >> 6, fr = lane & 15, fq = lane >> 4;
    const bf16_t* Q = (const bf16_t*)(p.ws + OFF_Q); const bf16_t* KB = (const bf16_t*)(p.ws + OFF_KB); const bf16_t* VTB = (const bf16_t*)(p.ws + OFF_VTB);
    bf16_t* AO = (bf16_t*)(p.ws + OFF_AO);
    const bool sample_first = (blockIdx.x & 8) != 0;
#pragma unroll 1
    for (int part = 0; part < 2; ++part) {
    if ((part == 0) != sample_first) {
    constexpr int KP = 528;
    for (int du0 = blockIdx.x; du0 < 256; du0 += gridDim.x) {
        int du = du0;
        if (gridDim.x == 256) { const int xcd = du0 & 7, slot = du0 >> 3; du = (xcd * 4 + (slot >> 3)) * 8 + (slot & 7); }
        const int q8 = du & 7, h = (du >> 3) & 3, b = du >> 5;
        {
            const bf16_t* src = KB + (size_t)b * 256 * 1024 + h * 256 + (tid & 31) * 8;
#pragma unroll 2
            for (int ps = 0; ps < 16; ++ps) {
                const int r = ps * 16 + (tid >> 5);
                *(LAS u32x4*)(lds + r * KP + (tid & 31) * 16) = *(const u32x4*)(src + (size_t)r * 1024);
            }
        }
        __syncthreads();
        bf16x8 pf[2][8]; float rinv2[2];
#pragma unroll
        for (int sub = 0; sub < 2; ++sub) {
            const size_t row0 = (size_t)b * 2048 + q8 * 256 + sub * 128 + wid * 16;
            bf16x8 qf[8];
#pragma unroll
            for (int ks = 0; ks < 8; ++ks) qf[ks] = *(const bf16x8*)(Q + (row0 + fr) * 1024 + h * 256 + ks * 32 + fq * 8);
            float mxv = -3.0e38f;
#pragma unroll 2
            for (int mb = 0; mb < 16; ++mb) {
                f32x4 a = (f32x4){0.f, 0.f, 0.f, 0.f};
#pragma unroll
                for (int ks = 0; ks < 8; ++ks) a = MFMA16(*(const LAS bf16x8*)(lds + (mb * 16 + fr) * KP + ks * 64 + fq * 16), qf[ks], a);
                mxv = fmaxf(fmaxf(mxv, fmaxf(a[0], a[1])), fmaxf(a[2], a[3]));
                asm volatile("" ::: "memory");
            }
            mxv = fmaxf(mxv, __shfl_xor(mxv, 16)); mxv = fmaxf(mxv, __shfl_xor(mxv, 32));
            float sm = 0.f;
#pragma unroll
            for (int kk = 0; kk < 8; ++kk) {
                f32x4 a0 = (f32x4){0.f, 0.f, 0.f, 0.f}, a1 = a0;
#pragma unroll
                for (int ks = 0; ks < 8; ++ks) {
                    a0 = MFMA16(*(const LAS bf16x8*)(lds + ((2 * kk) * 16 + fr) * KP + ks * 64 + fq * 16), qf[ks], a0);
                    a1 = MFMA16(*(const LAS bf16x8*)(lds + ((2 * kk + 1) * 16 + fr) * KP + ks * 64 + fq * 16), qf[ks], a1);
                }
#pragma unroll
                for (int jj = 0; jj < 4; ++jj) { a0[jj] = __expf(a0[jj] - mxv); a1[jj] = __expf(a1[jj] - mxv); sm += a0[jj] + a1[jj]; }
                u32x4 w; w.x = cvt_pk_bf16(a0[0], a0[1]); w.y = cvt_pk_bf16(a0[2], a0[3]); w.z = cvt_pk_bf16(a1[0], a1[1]); w.w = cvt_pk_bf16(a1[2], a1[3]);
                pf[sub][kk] = __builtin_bit_cast(bf16x8, w);
                asm volatile("" ::: "memory");
            }
            sm += __shfl_xor(sm, 16); sm += __shfl_xor(sm, 32);
            rinv2[sub] = 1.0f / sm;
        }
        __syncthreads();
        {
            const bf16_t* src = VTB + ((size_t)b * 1024 + h * 256) * 256 + (tid & 31) * 8;
#pragma unroll 2
            for (int ps = 0; ps < 16; ++ps) {
                const int r = ps * 16 + (tid >> 5);
                *(LAS u32x4*)(lds + r * KP + (tid & 31) * 16) = *(const u32x4*)(src + (size_t)r * 256);
            }
        }
        __syncthreads();
        {
            const size_t rowA = (size_t)b * 2048 + q8 * 256 + wid * 16 + fr;
#pragma unroll 1
            for (int db = 0; db < 16; ++db) {
                f32x4 a0 = (f32x4){0.f, 0.f, 0.f, 0.f}, a1 = a0;
#pragma unroll
                for (int kk = 0; kk < 8; ++kk) {
                    const LAS unsigned char* vp = lds + (db * 16 + fr) * KP + (kk * 32 + fq * 4) * 2;
                    const u32x2 lo = *(const LAS u32x2*)vp, hi = *(const LAS u32x2*)(vp + 32);
                    u32x4 w; w.x = lo.x; w.y = lo.y; w.z = hi.x; w.w = hi.y;
                    const bf16x8 vf = __builtin_bit_cast(bf16x8, w);
                    a0 = MFMA16(vf, pf[0][kk], a0); a1 = MFMA16(vf, pf[1][kk], a1);
                }
                a0 *= rinv2[0]; a1 *= rinv2[1];
                u32x2 w0, w1; w0.x = cvt_pk_bf16(a0[0], a0[1]); w0.y = cvt_pk_bf16(a0[2], a0[3]); w1.x = cvt_pk_bf16(a1[0], a1[1]); w1.y = cvt_pk_bf16(a1[2], a1[3]);
                *(u32x2*)(AO + rowA * 1024 + h * 256 + db * 16 + fq * 4) = w0;
                *(u32x2*)(AO + (rowA + 128) * 1024 + h * 256 + db * 16 + fq * 4) = w1;
                asm volatile("" ::: "memory");
            }
        }
        __syncthreads();
    }
    } else {
    {
        LAS float* sc = (LAS float*)lds;
        LAS float* red = sc + 2048;
        const float* CK = p.in[5]; const float* CV = p.in[6];
        for (int u = blockIdx.x; u < 256; u += gridDim.x) {
            const int b = u >> 1, hp = u & 1;
            float qr[4][2][4];
#pragma unroll
            for (int t = 0; t < 4; ++t)
#pragma unroll
                for (int hh = 0; hh < 2; ++hh) {
                    const u32x2 w = *(const u32x2*)(Q + ((size_t)M_PR + b * 4 + t) * 1024 + (hp * 2 + hh) * 256 + lane * 4);
                    qr[t][hh][0] = bflo(w.x); qr[t][hh][1] = bfhi(w.x); qr[t][hh][2] = bflo(w.y); qr[t][hh][3] = bfhi(w.y);
                }
            for (int mi = 0; mi < 32; mi += 4) {
                f32x4 kr[4][2];
#pragma unroll
                for (int i = 0; i < 4; ++i)
#pragma unroll
                    for (int hh = 0; hh < 2; ++hh) kr[i][hh] = *(const f32x4*)(CK + (((size_t)b * 256 + wid * 32 + mi + i) * 4 + hp * 2 + hh) * 256 + lane * 4);
#pragma unroll
                for (int i = 0; i < 4; ++i)
#pragma unroll
                    for (int hh = 0; hh < 2; ++hh)
#pragma unroll
                        for (int t = 0; t < 4; ++t) {
                            float s = kr[i][hh][0] * qr[t][hh][0] + kr[i][hh][1] * qr[t][hh][1] + kr[i][hh][2] * qr[t][hh][2] + kr[i][hh][3] * qr[t][hh][3];
                            s = wave_sum(s);
                            if (lane == 0) sc[(t * 2 + hh) * 256 + wid * 32 + mi + i] = s;
                        }
            }
            __syncthreads();
            {
                LAS float* r = sc + wid * 256;
                float v0 = r[lane], v1 = r[lane + 64], v2 = r[lane + 128], v3 = r[lane + 192];
                float m = fmaxf(fmaxf(v0, v1), fmaxf(v2, v3));
#pragma unroll
                for (int o = 32; o > 0; o >>= 1) m = fmaxf(m, __shfl_xor(m, o));
                v0 = __expf(v0 - m); v1 = __expf(v1 - m); v2 = __expf(v2 - m); v3 = __expf(v3 - m);
                const float s = wave_sum((v0 + v1) + (v2 + v3)), ri = 1.0f / s;
                r[lane] = v0 * ri; r[lane + 64] = v1 * ri; r[lane + 128] = v2 * ri; r[lane + 192] = v3 * ri;
            }
            __syncthreads();
            {
                f32x4 oa[4][2];
#pragma unroll
                for (int t = 0; t < 4; ++t)
#pragma unroll
                    for (int hh = 0; hh < 2; ++hh) oa[t][hh] = (f32x4){0.f, 0.f, 0.f, 0.f};
                for (int mi = 0; mi < 32; mi += 4) {
                    f32x4 vr[4][2];
#pragma unroll
                    for (int i = 0; i < 4; ++i)
#pragma unroll
                        for (int hh = 0; hh < 2; ++hh) vr[i][hh] = *(const f32x4*)(CV + (((size_t)b * 256 + wid * 32 + mi + i) * 4 + hp * 2 + hh) * 256 + lane * 4);
#pragma unroll
                    for (int i = 0; i < 4; ++i)
#pragma unroll
                        for (int hh = 0; hh < 2; ++hh)
#pragma unroll
                            for (int t = 0; t < 4; ++t) oa[t][hh] += vr[i][hh] * sc[(t * 2 + hh) * 256 + wid * 32 + mi + i];
                }
#pragma unroll
                for (int rnd = 0; rnd < 2; ++rnd) {
#pragma unroll
                    for (int t2 = 0; t2 < 2; ++t2)
#pragma unroll
                        for (int hh = 0; hh < 2; ++hh) *(LAS f32x4*)(red + ((wid * 2 + t2) * 2 + hh) * 256 + lane * 4) = oa[rnd * 2 + t2][hh];
                    __syncthreads();
#pragma unroll
                    for (int i = 0; i < 2; ++i) {
                        const int o = tid + i * 512, t2 = o >> 9, hh = (o >> 8) & 1, d = o & 255;
                        float sacc2 = 0.f;
#pragma unroll
                        for (int w = 0; w < 8; ++w) sacc2 += red[((w * 2 + t2) * 2 + hh) * 256 + d];
                        AO[((size_t)M_PR + b * 4 + rnd * 2 + t2) * 1024 + (hp * 2 + hh) * 256 + d] = (bf16_t)(cvt_pk_bf16(sacc2, 0.f) & 0xffff);
                    }
                    __syncthreads();
                }
            }
        }
    }
    }
    }
}

__device__ __forceinline__ void ins16(float (&T)[16], float x) {
#pragma unroll
    for (int i = 0; i < 16; ++i) { const float hi = fmaxf(T[i], x); x = fminf(T[i], x); T[i] = hi; }
}
__device__ __forceinline__ void sort16(float (&T)[16]) {
#pragma unroll
    for (int k = 2; k <= 16; k <<= 1)
#pragma unroll
        for (int j = k >> 1; j > 0; j >>= 1)
#pragma unroll
            for (int i = 0; i < 16; ++i) {
                const int l = i ^ j;
                if (l > i) {
                    const float hi = fmaxf(T[i], T[l]), lo = fminf(T[i], T[l]);
                    if ((i & k) == 0) { T[i] = hi; T[l] = lo; } else { T[i] = lo; T[l] = hi; }
                }
            }
}
__device__ __forceinline__ void merge16(float (&T)[16]) {
#pragma unroll
    for (int j = 8; j > 0; j >>= 1)
#pragma unroll
        for (int i = 0; i < 16; ++i) {
            const int l = i ^ j;
            if (l > i) { const float hi = fmaxf(T[i], T[l]), lo = fminf(T[i], T[l]); T[i] = hi; T[l] = lo; }
        }
}
__device__ __forceinline__ void topmerge16(float (&T)[16], const float (&G)[16]) {
#pragma unroll
    for (int i = 0; i < 16; ++i) T[i] = fmaxf(T[i], G[15 - i]);
    merge16(T);
}
__device__ __forceinline__ float pack_key(float v, unsigned code, unsigned mask) { return __uint_as_float((__float_as_uint(v) & ~mask) | code); }

__device__ __forceinline__ void peer_select(const bf16_t* PQ, const bf16_t* SKB, int tok0, int frc, int h, LAS int* sel_i, LAS float* sel_g, int fr, int fq) {
            float T1[16], T2[16];
#pragma unroll
            for (int half = 0; half < 2; ++half) {
                bf16x8 qf[4];
#pragma unroll
                for (int ks = 0; ks < 4; ++ks) qf[ks] = *(const bf16x8*)(PQ + (size_t)(tok0 + frc) * 2048 + h * 256 + half * 128 + ks * 32 + fq * 8);
                float T[16], Bk[16];
                {
                    unsigned so = (unsigned)(((h * 2 + half) * 128 + fr) * 128 + fq * 8);
                    asm volatile("" : "+v"(so));
                    const bf16_t* sp0 = SKB + so;
#pragma unroll
                    for (int kg = 0; kg < 2; ++kg) {
                        bf16x8 sf[4][4];
#pragma unroll
                        for (int kb = 0; kb < 4; ++kb)
#pragma unroll
                            for (int ks = 0; ks < 4; ++ks) sf[kb][ks] = *(const bf16x8*)(sp0 + (kg * 4 + kb) * 2048 + ks * 32);
#pragma unroll
                        for (int kb = 0; kb < 4; ++kb) {
                            f32x4 a = (f32x4){0.f, 0.f, 0.f, 0.f};
#pragma unroll
                            for (int ks = 0; ks < 4; ++ks) a = MFMA16(sf[kb][ks], qf[ks], a);
#pragma unroll
                            for (int jj = 0; jj < 4; ++jj) {
                                const float key = pack_key(a[jj], (unsigned)((kg * 4 + kb) * 16 + fq * 4 + jj), 127u);
                                if (kg == 0) T[kb * 4 + jj] = key; else Bk[kb * 4 + jj] = key;
                            }
                        }
                        asm volatile("" ::: "memory");
                    }
                }
                sort16(T); sort16(Bk); topmerge16(T, Bk);
#pragma unroll
                for (int o = 16; o <= 32; o <<= 1) {
                    float R[16];
#pragma unroll
                    for (int i = 0; i < 16; ++i) R[i] = __shfl_xor(T[i], o);
                    topmerge16(T, R);
                }
#pragma unroll
                for (int i = 0; i < 16; ++i) { if (half == 0) T1[i] = T[i]; else T2[i] = T[i]; }
            }
            float va[16], vb[16];
#pragma unroll
            for (int i = 0; i < 16; ++i) { va[i] = __uint_as_float(__float_as_uint(T1[i]) & ~127u); vb[i] = __uint_as_float(__float_as_uint(T2[i]) & ~127u); }
#define PEER_CAND(a_, b_) pack_key(va[a_] + vb[b_], (unsigned)((a_) * 16 + (b_)), 255u)
            float T3[16], X[16];
#pragma unroll
            for (int i = 0; i < 16; ++i) T3[i] = PEER_CAND(0, i);
#pragma unroll
            for (int i = 0; i < 8; ++i) { X[i] = PEER_CAND(1, i); X[8 + i] = PEER_CAND(15 - i, 0); }
            merge16(X); topmerge16(T3, X);
            X[0] = PEER_CAND(2, 0); X[1] = PEER_CAND(2, 1); X[2] = PEER_CAND(2, 2); X[3] = PEER_CAND(2, 3); X[4] = PEER_CAND(2, 4);
            X[5] = PEER_CAND(3, 0); X[6] = PEER_CAND(3, 1); X[7] = PEER_CAND(3, 2); X[8] = PEER_CAND(3, 3);
            X[9] = PEER_CAND(4, 0); X[10] = PEER_CAND(4, 1); X[11] = PEER_CAND(4, 2);
            X[12] = PEER_CAND(5, 0); X[13] = PEER_CAND(5, 1); X[14] = PEER_CAND(6, 0); X[15] = PEER_CAND(6, 1);
            sort16(X); topmerge16(T3, X);
            ins16(T3, PEER_CAND(7, 0)); ins16(T3, PEER_CAND(7, 1));
#undef PEER_CAND
            float e[16], es = 0.f;
            const float m0 = __uint_as_float(__float_as_uint(T3[0]) & ~255u);
#pragma unroll
            for (int i = 0; i < 16; ++i) { e[i] = __expf(__uint_as_float(__float_as_uint(T3[i]) & ~255u) - m0); es += e[i]; }
            const float ei = 1.0f / es;
#pragma unroll
            for (int jj = 0; jj < 4; ++jj) {
                float key = T3[0], ev = e[0];
#pragma unroll
                for (int r = 0; r < 16; ++r) { const bool s = (r == fq * 4 + jj); key = s ? T3[r] : key; ev = s ? e[r] : ev; }
                const unsigned code = __float_as_uint(key) & 255u, ca = code >> 4, cb = code & 15u;
                unsigned k1 = __float_as_uint(T1[0]), k2 = __float_as_uint(T2[0]);
#pragma unroll
                for (int r = 0; r < 16; ++r) { k1 = (ca == (unsigned)r) ? __float_as_uint(T1[r]) : k1; k2 = (cb == (unsigned)r) ? __float_as_uint(T2[r]) : k2; }
                const int idx = (int)((k1 & 127u) * 128u + (k2 & 127u));
                sel_i[fr * 128 + h * 16 + fq * 4 + jj] = idx;
                sel_g[fr * 128 + h * 16 + fq * 4 + jj] = ev * ei;
            }
        }

__device__ void phase_peer(const Params& p, LAS unsigned char* lds) {
    int tid_ = threadIdx.x; asm volatile("" : "+v"(tid_)); const int tid = tid_, lane = tid & 63, wid = tid >> 6, fr = lane & 15, fq = lane >> 4;
    const bf16_t* PQ = (const bf16_t*)(p.ws + OFF_PQ); const bf16_t* SKB = (const bf16_t*)(p.ws + OFF_SKB);
    const unsigned char* U8 = p.ws + OFF_UB; const unsigned char* V8 = p.ws + OFF_VB;
    const float* SS2 = (const float*)(p.ws + OFF_SSP2);
    const bf16_t* H2 = (const bf16_t*)(p.ws + OFF_H2B); float* Y = p.out;
    LAS int* sel_i = (LAS int*)lds;
    LAS float* sel_g = (LAS float*)(lds + 16384);
    LAS float* wv = (LAS float*)(lds + 32768);
    const int per_wg = (M_TOK + gridDim.x - 1) / gridDim.x, wg_lo = blockIdx.x * per_wg, wg_hi = (wg_lo + per_wg < M_TOK) ? wg_lo + per_wg : M_TOK;
    const int ntile = (wg_hi > wg_lo) ? (wg_hi - wg_lo + 15) / 16 : 0;
    if (ntile > 0) {
        const int nv0 = (wg_hi - wg_lo < 16) ? wg_hi - wg_lo : 16, frc0 = (fr < nv0) ? fr : nv0 - 1;
        peer_select(PQ, SKB, wg_lo, frc0, wid, sel_i, sel_g, fr, fq);
    }
    __syncthreads();
    for (int ti = 0; ti < ntile; ++ti) {
        const int tok0 = wg_lo + ti * 16;
        const int nvalid = (wg_hi - tok0 < 16) ? wg_hi - tok0 : 16;
        const LAS int* si_b = sel_i + (ti & 1) * 2048; const LAS float* sg_b = sel_g + (ti & 1) * 2048;
        if (wid >= 4) {
            if (ti + 1 < ntile) {
                const int tok1 = tok0 + 16, nv1 = (wg_hi - tok1 < 16) ? wg_hi - tok1 : 16, frc1 = (fr < nv1) ? fr : nv1 - 1;
#pragma unroll 1
                for (int hh = 0; hh < 2; ++hh) peer_select(PQ, SKB, tok1, frc1, (wid - 4) * 2 + hh, sel_i + ((ti + 1) & 1) * 2048, sel_g + ((ti + 1) & 1) * 2048, fr, fq);
            }
        } else {
    #pragma unroll 1
            for (int tt = 0; tt < 4; ++tt) {
                const int tl = tt * 4 + wid; const size_t tok = (size_t)tok0 + tl;
                if (tl >= nvalid) break;
                const float rs = rsqrtf(wave_sum(lane < 16 ? SS2[(size_t)lane * M_TOK + tok] : 0.f) * (1.0f / 1024.0f) + EPS);
                const bf16_t* hrow = H2 + tok * 1024; const float* gf = p.in[22];
                f32x2 x2[4][8];
    #pragma unroll
                for (int i = 0; i < 4; ++i) {
                    const u32x4 h0 = *(const u32x4*)(hrow + i * 256 + fr * 16), h1 = *(const u32x4*)(hrow + i * 256 + fr * 16 + 8);
    #pragma unroll
                    for (int q = 0; q < 4; ++q) {
                        const f32x4 ga = *(const f32x4*)(gf + i * 256 + fr * 16 + q * 4);
                        const unsigned w0 = (q < 2) ? h0[(q & 1) * 2] : h1[(q & 1) * 2], w1 = (q < 2) ? h0[(q & 1) * 2 + 1] : h1[(q & 1) * 2 + 1];
                        x2[i][q * 2] = (f32x2){bflo(w0) * rs * ga[0], bfhi(w0) * rs * ga[1]}; x2[i][q * 2 + 1] = (f32x2){bflo(w1) * rs * ga[2], bfhi(w1) * rs * ga[3]};
                    }
                }
                const LAS int* si = si_b + tl * 128; const LAS float* sg = sg_b + tl * 128; LAS float* wvw = wv + wid * 128;
                u32x4 bA[1][4], bB[1][4];
    #define PEER_LOADU(buf, g) do { _Pragma("unroll") for (int q_ = 0; q_ < 1; ++q_) { const int idx_ = si[((g) + q_) * 4 + fq]; \
                    const unsigned char* ur_ = U8 + (size_t)idx_ * 1024 + fr * 16; \
                    _Pragma("unroll") for (int i_ = 0; i_ < 4; ++i_) buf[q_][i_] = *(const u32x4*)(ur_ + i_ * 256); } } while (0)
    #define PEER_COMPU(buf, g) do { _Pragma("unroll") for (int q_ = 0; q_ < 1; ++q_) { f32x2 s2_ = (f32x2){0.f, 0.f}; \
                    _Pragma("unroll") for (int i_ = 0; i_ < 4; ++i_) _Pragma("unroll") for (int w_ = 0; w_ < 4; ++w_) { \
                        s2_ += x2[i_][w_ * 2] * __builtin_amdgcn_cvt_pk_f32_fp8((int)buf[q_][i_][w_], false); \
                        s2_ += x2[i_][w_ * 2 + 1] * __builtin_amdgcn_cvt_pk_f32_fp8((int)buf[q_][i_][w_], true); } \
                    float s_ = s2_.x + s2_.y; s_ += __shfl_xor(s_, 1); s_ += __shfl_xor(s_, 2); s_ += __shfl_xor(s_, 4); s_ += __shfl_xor(s_, 8); \
                    if (fr == 0) wvw[((g) + q_) * 4 + fq] = s_ * (1.0f / 1024.0f); } } while (0)
                PEER_LOADU(bA, 0);
    #pragma unroll 1
                for (int g = 0; g < 32; g += 2) {
                    PEER_LOADU(bB, g + 1);
                    PEER_COMPU(bA, g);
                    { const int gn = (g + 2 < 32) ? g + 2 : 31; PEER_LOADU(bA, gn); }
                    PEER_COMPU(bB, g + 1);
                }
                {
                    const float a0 = wvw[lane], a1 = wvw[lane + 64];
                    wvw[lane] = 0.5f * a0 * (1.0f + erff(a0 * 0.70710678118654752f)) * sg[lane] * (1.0f / 64.0f);
                    wvw[lane + 64] = 0.5f * a1 * (1.0f + erff(a1 * 0.70710678118654752f)) * sg[lane + 64] * (1.0f / 64.0f);
                }
                f32x2 acc2[8];
    #pragma unroll
                for (int e2 = 0; e2 < 8; ++e2) acc2[e2] = (f32x2){0.f, 0.f};
                u32x4 vA[8], vB[8];
    #define PEER_LOADV(buf, k0) do { _Pragma("unroll") for (int q_ = 0; q_ < 8; ++q_) buf[q_] = *(const u32x4*)(V8 + (size_t)si[(k0) + q_] * 1024 + lane * 16); } while (0)
    #define PEER_COMPV(buf, k0) do { _Pragma("unroll") for (int q_ = 0; q_ < 8; ++q_) { const float w_ = wvw[(k0) + q_]; \
                    _Pragma("unroll") for (int j_ = 0; j_ < 4; ++j_) { \
                        acc2[j_ * 2] += __builtin_amdgcn_cvt_pk_f32_fp8((int)buf[q_][j_], false) * w_; \
                        acc2[j_ * 2 + 1] += __builtin_amdgcn_cvt_pk_f32_fp8((int)buf[q_][j_], true) * w_; } } } while (0)
                PEER_LOADV(vA, 0);
    #pragma unroll 1
                for (int k0 = 0; k0 < 128; k0 += 16) {
                    PEER_LOADV(vB, k0 + 8);
                    PEER_COMPV(vA, k0);
                    { const int kn = (k0 + 16 < 128) ? k0 + 16 : 120; PEER_LOADV(vA, kn); }
                    PEER_COMPV(vB, k0 + 8);
                }
    #undef PEER_LOADU
    #undef PEER_COMPU
    #undef PEER_LOADV
    #undef PEER_COMPV
                float ss = 0.f; f32x4 hv[4];
                {
                    const u32x4 h0 = *(const u32x4*)(hrow + lane * 16), h1 = *(const u32x4*)(hrow + lane * 16 + 8);
    #pragma unroll
                    for (int q = 0; q < 4; ++q) {
                        const unsigned w0 = (q < 2) ? h0[(q & 1) * 2] : h1[(q & 1) * 2], w1 = (q < 2) ? h0[(q & 1) * 2 + 1] : h1[(q & 1) * 2 + 1];
                        hv[q][0] = bflo(w0) + acc2[q * 2].x; hv[q][1] = bfhi(w0) + acc2[q * 2].y; hv[q][2] = bflo(w1) + acc2[q * 2 + 1].x; hv[q][3] = bfhi(w1) + acc2[q * 2 + 1].y;
                        ss += (hv[q][0] * hv[q][0] + hv[q][1] * hv[q][1]) + (hv[q][2] * hv[q][2] + hv[q][3] * hv[q][3]);
                    }
                }
                ss = wave_sum(ss);
                const float rf = rsqrtf(ss * (1.0f / 1024.0f) + EPS);
                const float* nf = p.in[27];
    #pragma unroll
                for (int q = 0; q < 4; ++q) *(f32x4*)(Y + tok * 1024 + lane * 16 + q * 4) = hv[q] * rf * *(const f32x4*)(nf + lane * 16 + q * 4);
            }
        }
        __syncthreads();
    }
}

struct SmallArgs { const bf16_t* A; const bf16_t* Bt; int N; const bf16_t* proj; const bf16_t* base; bf16_t* O; int ldo; float* SSw; const float* SSr; float sc; };
template <int MODE>
__device__ __forceinline__ void small_gemm(const SmallArgs& a, LAS unsigned char* lds) {
    int tid_ = threadIdx.x; asm volatile("" : "+v"(tid_)); const int tid = tid_, lane = tid & 63, wid = tid >> 6, fr = lane & 15, fq = lane >> 4;
    const int ncb = a.N / 64;
    constexpr int SP = 1040;
    LAS unsigned char* LA = lds; LAS unsigned char* LB = lds + 32 * SP;
    LAS float* red = (LAS float*)(lds + 96 * SP);
    for (int tile = blockIdx.x; tile < 16 * ncb; tile += gridDim.x) {
        const int rb = tile / ncb, cb = tile % ncb;
        const int row = M_PR + rb * 32 + (wid >> 2) * 16 + fr;
        const int colb = cb * 64 + (wid & 3) * 16;
        const bf16_t* Ag = a.A + (size_t)(M_PR + rb * 32) * 1024 + (tid & 63) * 8;
        const bf16_t* Bg = a.Bt + (size_t)(cb * 64) * 1024 + (tid & 63) * 8;
        u32x4 ra[4], rbv[8];
#define SG_LOAD(kh_) do { _Pragma("unroll") for (int i_ = 0; i_ < 4; ++i_) ra[i_] = *(const u32x4*)(Ag + (size_t)((tid >> 6) + 8 * i_) * 1024 + (kh_) * 512); \
            _Pragma("unroll") for (int i_ = 0; i_ < 8; ++i_) rbv[i_] = *(const u32x4*)(Bg + (size_t)((tid >> 6) + 8 * i_) * 1024 + (kh_) * 512); } while (0)
        SG_LOAD(0);
        f32x4 acc = (f32x4){0.f, 0.f, 0.f, 0.f};
#pragma unroll
        for (int kh = 0; kh < 2; ++kh) {
#pragma unroll
            for (int i_ = 0; i_ < 4; ++i_) *(LAS u32x4*)(LA + ((tid >> 6) + 8 * i_) * SP + (tid & 63) * 16) = ra[i_];
#pragma unroll
            for (int i_ = 0; i_ < 8; ++i_) *(LAS u32x4*)(LB + ((tid >> 6) + 8 * i_) * SP + (tid & 63) * 16) = rbv[i_];
            __syncthreads();
            if (kh == 0) SG_LOAD(1);
            const LAS unsigned char* apl = LA + ((wid >> 2) * 16 + fr) * SP + fq * 16;
            const LAS unsigned char* bpl = LB + ((wid & 3) * 16 + fr) * SP + fq * 16;
#pragma unroll
            for (int ks = 0; ks < 16; ++ks) acc = MFMA16(*(const LAS bf16x8*)(bpl + ks * 64), *(const LAS bf16x8*)(apl + ks * 64), acc);
            if (MODE == 0 && kh == 0) {
                const u32x2 sa = *(const u32x2*)(a.proj + (size_t)row * NPROJ + 3328 + colb + fq * 4), sb = *(const u32x2*)(a.proj + (size_t)row * NPROJ + 4352 + colb + fq * 4);
                acc[0] *= bflo(sa.x) * __builtin_amdgcn_rcpf(bflo(sb.x)); acc[1] *= bfhi(sa.x) * __builtin_amdgcn_rcpf(bfhi(sb.x));
                acc[2] *= bflo(sa.y) * __builtin_amdgcn_rcpf(bflo(sb.y)); acc[3] *= bfhi(sa.y) * __builtin_amdgcn_rcpf(bfhi(sb.y));
            }
            __syncthreads();
        }
#undef SG_LOAD
        const int col = colb + fq * 4;
        if (MODE == 0) {
            const u32x2 sb = *(const u32x2*)(a.proj + (size_t)row * NPROJ + 4352 + col);
            u32x2 w; w.x = cvt_pk_bf16(acc[0] * bflo(sb.x), acc[1] * bfhi(sb.x)); w.y = cvt_pk_bf16(acc[2] * bflo(sb.y), acc[3] * bfhi(sb.y));
            *(u32x2*)(a.O + (size_t)row * a.ldo + col) = w;
        } else if (MODE == 1) {
            const u32x2 b = *(const u32x2*)(a.base + (size_t)row * 1024 + col);
            f32x4 v = acc; v[0] += bflo(b.x); v[1] += bfhi(b.x); v[2] += bflo(b.y); v[3] += bfhi(b.y);
            float sq = (v[0] * v[0] + v[1] * v[1]) + (v[2] * v[2] + v[3] * v[3]);
            u32x2 w; w.x = cvt_pk_bf16(v[0], v[1]); w.y = cvt_pk_bf16(v[2], v[3]);
            *(u32x2*)(a.O + (size_t)row * a.ldo + col) = w;
            sq += __shfl_xor(sq, 16); sq += __shfl_xor(sq, 32);
            if (fq == 0) red[((wid >> 2) * 16 + fr) * 4 + (wid & 3)] = sq;
            __syncthreads();
            if (tid < 32) a.SSw[(size_t)cb * M_TOK + M_PR + rb * 32 + tid] = (red[tid * 4] + red[tid * 4 + 1]) + (red[tid * 4 + 2] + red[tid * 4 + 3]);
            __syncthreads();
        } else {
            float t = 0.f;
#pragma unroll
            for (int q = 0; q < 4; ++q) t += a.SSr[(size_t)(fq * 4 + q) * M_TOK + row];
            t += __shfl_xor(t, 16); t += __shfl_xor(t, 32);
            const float rs = rsqrtf(t * (1.0f / 1024.0f) + EPS) * a.sc;
            u32x2 w; w.x = cvt_pk_bf16(acc[0] * rs, acc[1] * rs); w.y = cvt_pk_bf16(acc[2] * rs, acc[3] * rs);
            *(u32x2*)(a.O + (size_t)row * a.ldo + col) = w;
        }
    }
}

#define XB_TMO      128
#define XB_XCNT(j)  (256  + 64 * (j))
#define XB_XSUB(j)  (1280 + 64 * (j))
#define XB_XGEN(j)  (2304 + 64 * (j))
#define XB_TOP      3328
#define XB_TOPGEN   3392
#define XCD_BAR_WORDS 3456
#define XB_SPIN_CAP (1u << 18)

__device__ __forceinline__ unsigned xb_ld(unsigned* p)              { return __hip_atomic_load(p, __ATOMIC_RELAXED, __HIP_MEMORY_SCOPE_AGENT); }
__device__ __forceinline__ unsigned xb_add(unsigned* p, unsigned v) { return __hip_atomic_fetch_add(p, v, __ATOMIC_RELAXED, __HIP_MEMORY_SCOPE_AGENT); }
__device__ __forceinline__ unsigned xb_xcc_id() { return (unsigned)__builtin_amdgcn_s_getreg((3 << 11) | 20) & 0xFu; }
#define XB_SPIN(cond, bar) do { unsigned _sp = 0; while (cond) { __builtin_amdgcn_s_sleep(1); \
    if ((++_sp & 255u) == 0u) { if (xb_ld(&(bar)[XB_TMO])) break; if (_sp > XB_SPIN_CAP) { atomicAdd(&(bar)[XB_TMO], 1u); break; } } } } while (0)

struct XcdBarrier {
    unsigned* bar; unsigned x;
    volatile LAS unsigned* st;
};

__device__ __forceinline__ XcdBarrier xcd_barrier_post(unsigned* bar, volatile LAS unsigned* st) {
    XcdBarrier b; b.bar = bar; b.x = xb_xcc_id(); b.st = st;
    if (threadIdx.x == 0) (void)xb_add(&bar[XB_XCNT(b.x)], 1u);
    return b;
}
__device__ __forceinline__ void xcd_barrier_complete(unsigned* bar, unsigned x, unsigned& nloc, unsigned& nx) {
    const unsigned G = gridDim.x * gridDim.y * gridDim.z;
    unsigned sum, cnt, mine, sp = 0u;
    for (;;) {
        sum = 0u; cnt = 0u; mine = 0u;
#pragma unroll
        for (unsigned j = 0; j < 16; ++j) { const unsigned c = xb_ld(&bar[XB_XCNT(j)]); sum += c; cnt += (c > 0u) ? 1u : 0u; mine = (j == x) ? c : mine; }
        if (sum == G) break;
        __builtin_amdgcn_s_sleep(1);
        if ((++sp & 255u) == 0u) { if (xb_ld(&bar[XB_TMO])) break; if (sp > XB_SPIN_CAP) { atomicAdd(&bar[XB_TMO], 1u); break; } }
    }
    nloc = mine > 0u ? mine : 1u; nx = cnt > 0u ? cnt : 1u;
}

__device__ __forceinline__ void xcd_barrier(const XcdBarrier& b) {
    asm volatile("s_waitcnt vmcnt(0)" ::: "memory");
    __syncthreads();
    if (threadIdx.x == 0) {
        unsigned* bar = b.bar;
        __builtin_amdgcn_s_waitcnt(0);
        unsigned nloc = b.st[0], nx = b.st[1];
        if (nloc == 0u) { xcd_barrier_complete(bar, b.x, nloc, nx); b.st[0] = nloc; b.st[1] = nx; }
        const unsigned old = xb_add(&bar[XB_XSUB(b.x)], 1u);
        const unsigned gen = old / nloc;
        if (old + 1u == (gen + 1u) * nloc) {
            __builtin_amdgcn_fence(__ATOMIC_RELEASE, "agent");
            asm volatile("s_waitcnt vmcnt(0)" ::: "memory");
            const unsigned og = xb_add(&bar[XB_TOP], 1u);
            const unsigned tg = og / nx;
            if (og + 1u == (tg + 1u) * nx) xb_add(&bar[XB_TOPGEN], 1u);
            else XB_SPIN(xb_ld(&bar[XB_TOPGEN]) == tg, bar);
            __builtin_amdgcn_fence(__ATOMIC_ACQUIRE, "agent");
            xb_add(&bar[XB_XGEN(b.x)], 1u);
            asm volatile("s_waitcnt vmcnt(0)" ::: "memory");
        } else {
            XB_SPIN(xb_ld(&bar[XB_XGEN(b.x)]) == gen, bar);
            __builtin_amdgcn_fence(__ATOMIC_ACQUIRE, "agent");
            asm volatile("s_waitcnt vmcnt(0)" ::: "memory");
        }
    }
    __syncthreads();
}


__device__ __forceinline__ void my_grid_sync(unsigned* bar, unsigned target) {
    asm volatile("s_waitcnt vmcnt(0) lgkmcnt(0)" ::: "memory");
    __syncthreads();
    if (threadIdx.x == 0) {
        __builtin_amdgcn_fence(__ATOMIC_RELEASE, "agent");
        asm volatile("s_waitcnt vmcnt(0)" ::: "memory");
        __hip_atomic_fetch_add(bar, 1u, __ATOMIC_RELAXED, __HIP_MEMORY_SCOPE_AGENT);
        while (__hip_atomic_load(bar, __ATOMIC_RELAXED, __HIP_MEMORY_SCOPE_AGENT) < target) __builtin_amdgcn_s_sleep(2);
    }
    __syncthreads();
    asm volatile("buffer_inv sc1\n\ts_waitcnt vmcnt(0)" ::: "memory");
}
__global__ void __launch_bounds__(NTHR) mk_fwd(Params p) {
    extern __shared__ __attribute__((aligned(16))) unsigned char lds_raw[];
    LAS unsigned char* lds = (LAS unsigned char*)lds_raw;
    cg::grid_group grid = cg::this_grid();
    if (threadIdx.x < 4) ((LAS unsigned*)(lds + LDS_BYTES - 16))[threadIdx.x] = 0u;
    __syncthreads();
    const XcdBarrier xb = xcd_barrier_post((unsigned*)(p.ws + OFF_BAR), (volatile LAS unsigned*)(lds + LDS_BYTES - 16));
#define GRID_SYNC() xcd_barrier(xb)
    unsigned char* ws = p.ws;
    const int G = gridDim.x, c = blockIdx.x;
    const bf16_t* A0 = (const bf16_t*)(ws + OFF_A0);

    if (p.ws == nullptr) grid.sync();
    PH(0) phase_prep(p, lds);
    GRID_SYNC();
    PH(1) {
        pg8::Sched S; S.init(A0, (const bf16_t*)(ws + OFF_WTIN), M_TOK, NPROJ, A0 + (size_t)M_TOK * 1024, (const bf16_t*)(ws + OFF_WTKV), 2048, 2048, G, c);
        EpiProj E{(const float*)(ws + OFF_SS0), p.in[10], (bf16_t*)(ws + OFF_PROJ), (float*)(ws + OFF_LOGA), p.out, (bf16_t*)(ws + OFF_KB), (bf16_t*)(ws + OFF_VTB)};
        pg8::gemm_phase(lds, 1024, S, E);
    }
    GRID_SYNC();
    PH(2) phase_scan(p, lds);
    GRID_SYNC();
    PH(3) phase_onorm(p);
    GRID_SYNC();
    PH(4) {
        pg8::Sched S; S.init((const bf16_t*)(ws + OFF_A2), (const bf16_t*)(ws + OFF_WTP), M_PR, 1024, nullptr, nullptr, 0, 0, G, c);
        EpiMerge E{(const bf16_t*)(ws + OFF_PROJ), (bf16_t*)(ws + OFF_X)};
        pg8::gemm_phase(lds, 1024, S, E);
        SmallArgs sa{(const bf16_t*)(ws + OFF_A2), (const bf16_t*)(ws + OFF_WTP), 1024, (const bf16_t*)(ws + OFF_PROJ), nullptr, (bf16_t*)(ws + OFF_X), 1024, nullptr, nullptr, 1.f};
        small_gemm<0>(sa, lds);
    }
    GRID_SYNC();
    PH(5) {
        pg8::Sched S; S.init((const bf16_t*)(ws + OFF_X), (const bf16_t*)(ws + OFF_WTO), M_PR, 1024, nullptr, nullptr, 0, 0, G, c);
        EpiResid E{A0, (bf16_t*)(ws + OFF_H1B), (float*)(ws + OFF_SSP1)};
        pg8::gemm_phase(lds, 1024, S, E);
        SmallArgs sa{(const bf16_t*)(ws + OFF_X), (const bf16_t*)(ws + OFF_WTO), 1024, nullptr, A0, (bf16_t*)(ws + OFF_H1B), 1024, (float*)(ws + OFF_SSP1), nullptr, 1.f};
        small_gemm<1>(sa, lds);
    }
    GRID_SYNC();
    PH(6) {
        pg8::Sched S; S.init((const bf16_t*)(ws + OFF_H1B), (const bf16_t*)(ws + OFF_WTXQ), M_PR, 1024, nullptr, nullptr, 0, 0, G, c);
        EpiScale E{(const float*)(ws + OFF_SSP1), (bf16_t*)(ws + OFF_Q), 1024, 0.0625f};
        pg8::gemm_phase(lds, 1024, S, E);
        SmallArgs sa{(const bf16_t*)(ws + OFF_H1B), (const bf16_t*)(ws + OFF_WTXQ), 1024, nullptr, nullptr, (bf16_t*)(ws + OFF_Q), 1024, nullptr, (const float*)(ws + OFF_SSP1), 0.0625f};
        small_gemm<2>(sa, lds);
    }
    GRID_SYNC();
    PH(7) phase_attn(p, lds);
    GRID_SYNC();
    PH(8) {
        pg8::Sched S; S.init((const bf16_t*)(ws + OFF_AO), (const bf16_t*)(ws + OFF_WTXO), M_PR, 1024, nullptr, nullptr, 0, 0, G, c);
        EpiResid E{(const bf16_t*)(ws + OFF_H1B), (bf16_t*)(ws + OFF_H2B), (float*)(ws + OFF_SSP2)};
        pg8::gemm_phase(lds, 1024, S, E);
        SmallArgs sa{(const bf16_t*)(ws + OFF_AO), (const bf16_t*)(ws + OFF_WTXO), 1024, nullptr, (const bf16_t*)(ws + OFF_H1B), (bf16_t*)(ws + OFF_H2B), 1024, (float*)(ws + OFF_SSP2), nullptr, 1.f};
        small_gemm<1>(sa, lds);
    }
    GRID_SYNC();
    PH(9) {
        pg8::Sched S; S.init((const bf16_t*)(ws + OFF_H2B), (const bf16_t*)(ws + OFF_WTPQ), M_PR, 2048, nullptr, nullptr, 0, 0, G, c);
        EpiScale E{(const float*)(ws + OFF_SSP2), (bf16_t*)(ws + OFF_PQ), 2048, 1.0f};
        pg8::gemm_phase(lds, 1024, S, E);
        SmallArgs sa{(const bf16_t*)(ws + OFF_H2B), (const bf16_t*)(ws + OFF_WTPQ), 2048, nullptr, nullptr, (bf16_t*)(ws + OFF_PQ), 2048, nullptr, (const float*)(ws + OFF_SSP2), 1.0f};
        small_gemm<2>(sa, lds);
    }
    GRID_SYNC();
    PH(10) phase_peer(p, lds);
#ifdef DUMP
    GRID_SYNC();
    {
        const size_t gt = (size_t)blockIdx.x * NTHR + threadIdx.x, ngt = (size_t)gridDim.x * NTHR;
        const bf16_t* srcb = (const bf16_t*)(ws + (DUMP == 1 ? OFF_A2 : (DUMP == 2 ? OFF_X : OFF_H1B)));
        const float* srcf = (const float*)(ws + OFF_X);
        if (DUMP == 4) { const bf16_t* pj = (const bf16_t*)(ws + OFF_PROJ); for (size_t i = gt; i < (size_t)M_TOK * 1024; i += ngt) p.out[i] = bf2f(pj[(i >> 10) * NPROJ + (i & 1023)]); }
        else if (DUMP == 5) { const bf16_t* pj = (const bf16_t*)(ws + OFF_PROJ); for (size_t i = gt; i < (size_t)M_TOK * 1024; i += ngt) p.out[i] = bf2f(pj[(i >> 10) * NPROJ + 1792 + (i & 1023)]); }
        else for (size_t i = gt; i < (size_t)M_PR * 1024; i += ngt) p.out[i] = (DUMP == 3) ? srcf[i] : bf2f(srcb[i]);
    }
#endif
}

extern "C" void kernel_launch(void* const* d_in, const int* in_sizes, int n_in, void* d_out, int out_size, void* d_ws, size_t ws_size, hipStream_t stream) {
    static int grid_blocks = 0;
    if (!grid_blocks) {
        int dev = 0, cus = 0, per_cu = 0;
        (void)hipGetDevice(&dev);
        (void)hipDeviceGetAttribute(&cus, hipDeviceAttributeMultiprocessorCount, dev);
        (void)hipFuncSetAttribute((const void*)mk_fwd, hipFuncAttributeMaxDynamicSharedMemorySize, LDS_BYTES);
        (void)hipOccupancyMaxActiveBlocksPerMultiprocessor(&per_cu, (const void*)mk_fwd, NTHR, LDS_BYTES);
        if (per_cu < 1) per_cu = 1;
        grid_blocks = cus * per_cu;
        if (ws_size < WS_END) fprintf(stderr, "kernel_launch: workspace too small (%zu < %zu)\n", ws_size, (size_t)WS_END);
    }
    Params p{};
    for (int i = 0; i < 28; ++i) p.in[i] = (const float*)d_in[i];
    p.out = (float*)d_out; p.ws = (unsigned char*)d_ws;
    (void)hipMemsetAsync((unsigned char*)d_ws + OFF_BAR, 0, 16384, stream);
    void* args[] = {&p};
    hipError_t e = hipLaunchCooperativeKernel((const void*)mk_fwd, dim3(grid_blocks), dim3(NTHR), args, LDS_BYTES, stream);
    if (e != hipSuccess) fprintf(stderr, "cooperative launch failed: %s (grid %d)\n", hipGetErrorString(e), grid_blocks);
}
```

```cpp
#include <hip/hip_runtime.h>
#include <hip/hip_cooperative_groups.h>
#include <cstdio>
namespace cg = cooperative_groups;

#define LAS __attribute__((address_space(3)))
typedef unsigned short bf16_t;
typedef short bf16x8 __attribute__((ext_vector_type(8)));
typedef float f32x4 __attribute__((ext_vector_type(4)));
typedef float f32x2 __attribute__((ext_vector_type(2)));
typedef unsigned u32x4 __attribute__((ext_vector_type(4)));
typedef unsigned u32x2 __attribute__((ext_vector_type(2)));

constexpr int NTHR = 512;
constexpr int M_TOK = 16896, M_PR = 16384, M_ALL = 18944, DM = 1024, NPROJ = 5376;
constexpr float EPS = 1e-6f;
constexpr int LDS_BYTES = 147456;

constexpr size_t OUT_Y = 0, OUT_GLAP = 17301504, OUT_RETP = 17563648, OUT_MK = 17825792, OUT_MV = 19922944, OUT_GLAS = 22020096, OUT_RETS = 26214400;

constexpr size_t al256(size_t x) { return (x + 255) & ~(size_t)255; }
constexpr size_t OFF_A0 = 0;
constexpr size_t OFF_SS0 = al256(OFF_A0 + (size_t)M_ALL * DM * 2);
constexpr size_t OFF_SS1 = al256(OFF_SS0 + (size_t)M_ALL * 4);
constexpr size_t OFF_SS2 = OFF_SS1 + (size_t)M_TOK * 4;
constexpr size_t OFF_WTIN = al256(OFF_SS2 + (size_t)M_TOK * 4);
constexpr size_t OFF_WTKV = OFF_WTIN + (size_t)NPROJ * DM * 2;
constexpr size_t OFF_WTP = OFF_WTKV + (size_t)2048 * DM * 2;
constexpr size_t OFF_WTO = OFF_WTP + (size_t)DM * DM * 2;
constexpr size_t OFF_WTXQ = OFF_WTO + (size_t)DM * DM * 2;
constexpr size_t OFF_WTXO = OFF_WTXQ + (size_t)DM * DM * 2;
constexpr size_t OFF_WTPQ = OFF_WTXO + (size_t)DM * DM * 2;
constexpr size_t OFF_SKB = OFF_WTPQ + (size_t)2048 * DM * 2;
constexpr size_t OFF_UB = OFF_SKB + (size_t)8 * 2 * 128 * 128 * 2;
constexpr size_t OFF_VB = OFF_UB + (size_t)16384 * DM;
constexpr size_t OFF_PROJ = OFF_VB + (size_t)16384 * DM;
constexpr size_t OFF_LOGA = OFF_PROJ + (size_t)M_TOK * NPROJ * 2;
constexpr size_t OFF_KB = OFF_LOGA + (size_t)M_TOK * 256 * 4;
constexpr size_t OFF_VTB = OFF_KB + (size_t)2048 * DM * 2;
constexpr size_t OFF_X = OFF_VTB + (size_t)2048 * DM * 2;
constexpr size_t OFF_A2 = OFF_X + (size_t)M_TOK * DM * 4;
constexpr size_t OFF_SSP1 = OFF_A2 + (size_t)M_TOK * DM * 2;
constexpr size_t OFF_SSP2 = OFF_SSP1 + (size_t)16 * M_TOK * 4;
constexpr size_t OFF_BAR = OFF_SSP2 + (size_t)16 * M_TOK * 4;
constexpr size_t WS_END = OFF_BAR + 16384;
constexpr size_t OFF_H1B = OFF_PROJ;
constexpr size_t OFF_Q = OFF_H1B + (size_t)M_TOK * DM * 2;
constexpr size_t OFF_AO = OFF_Q + (size_t)M_TOK * DM * 2;
constexpr size_t OFF_H2B = OFF_AO + (size_t)M_TOK * DM * 2;
constexpr size_t OFF_PQ = OFF_PROJ;

struct Params { const float* in[28]; float* out; unsigned char* ws; };
#ifndef PHMASK
#define PHMASK 0xFFFF
#endif
#define PH(k) if constexpr ((PHMASK >> (k)) & 1)

typedef __bf16 bf16v2_t __attribute__((ext_vector_type(2)));
__device__ __forceinline__ unsigned cvt_pk_bf16(float lo, float hi) { const f32x2 v = {lo, hi}; return __builtin_bit_cast(unsigned, __builtin_convertvector(v, bf16v2_t)); }
__device__ __forceinline__ float bflo(unsigned u) { return __uint_as_float(u << 16); }
__device__ __forceinline__ float bfhi(unsigned u) { return __uint_as_float(u & 0xffff0000u); }
__device__ __forceinline__ float bf2f(bf16_t b) { return __uint_as_float(((unsigned)b) << 16); }
__device__ __forceinline__ float wave_sum(float v) {
#pragma unroll
    for (int o = 32; o > 0; o >>= 1) v += __shfl_xor(v, o);
    return v;
}
__device__ __forceinline__ float sigmoidf_(float v) { return __builtin_amdgcn_rcpf(1.0f + __expf(-v)); }

namespace pg8 {
constexpr int BM = 256, BK = 64, HALF = 128, HTB = HALF * BK * 2, STAGE_BYTES = 8 * HTB, NXCD = 8, WGM = 8;
__device__ __forceinline__ int lds_byte(int r, int c) { const int st = (r >> 4) * 2 + (c >> 5), rr = r & 15, cc = c & 31, ob = rr * 64 + cc * 2; return st * 1024 + (ob ^ (((ob >> 9) & 1) << 5)); }
__device__ __forceinline__ void stage_rc(int b, int& R, int& C) { const int st = b / 1024, sb = b % 1024, swz = sb ^ (((sb >> 9) & 1) << 5); R = (st >> 1) * 16 + swz / 64; C = (st & 1) * 32 + (swz % 64) / 2; }

struct Unit { int pm, pn, job; };
struct Sched {
    const bf16_t* A0; const bf16_t* B0; const bf16_t* A1; const bf16_t* B1;
    int nM0, nN0, n0, nM1, nN1, n1, G, c;
    __device__ __forceinline__ void init(const bf16_t* a0, const bf16_t* b0, int M0, int N0, const bf16_t* a1, const bf16_t* b1, int M1, int N1, int G_, int c_) {
        A0 = a0; B0 = b0; A1 = a1; B1 = b1; nM0 = M0 / BM; nN0 = N0 / BM; n0 = nM0 * nN0; nM1 = M1 / BM; nN1 = N1 / BM; n1 = nM1 * nN1; G = G_; c = c_; }
    __device__ __forceinline__ void map(int wgid, int nwg, int nM, int nN, Unit& u) const {
        { const int q = nwg / NXCD, r = nwg % NXCD, xcd = wgid % NXCD, off = wgid / NXCD; wgid = (xcd < r ? xcd * (q + 1) : r * (q + 1) + (xcd - r) * q) + off; }
        const int nig = WGM * nN, gid = wgid / nig, fm = gid * WGM, gsz = (nM - fm) < WGM ? (nM - fm) : WGM;
        u.pm = fm + ((wgid % nig) % gsz); u.pn = (wgid % nig) / gsz;
    }
    __device__ __forceinline__ bool next(int i, Unit& u) const {
        int L = i * G + c;
        if (L < n0) { map(L, n0, nM0, nN0, u); u.job = 0; return true; }
        L -= n0;
        if (L < n1) { map(L, n1, nM1, nN1, u); u.job = 1; return true; }
        return false;
    }
    __device__ __forceinline__ const char* aptr(const Unit& u, size_t tstep) const { return (const char*)(u.job ? A1 : A0) + (size_t)u.pm * tstep; }
    __device__ __forceinline__ const char* bptr(const Unit& u, size_t tstep) const { return (const char*)(u.job ? B1 : B0) + (size_t)u.pn * tstep; }
};

template <class Epi>
__device__ __forceinline__ void gemm_phase(LAS unsigned char* lds, const int K, const Sched& S, const Epi& E) {
    int tid_ = threadIdx.x; asm volatile("" : "+v"(tid_)); const int tid = tid_, wid = __builtin_amdgcn_readfirstlane(tid >> 6), lane = tid & 63, wr = wid >> 2, wc = wid & 3, fr = lane & 15, fq = lane >> 4;
    const int nt = K / BK;
    unsigned voffA[2], voffB[2];
#pragma unroll
    for (int i = 0; i < 2; ++i) { int R, C; stage_rc(tid * 16 + i * 8192, R, C); voffA[i] = (unsigned)(R * K + C) * 2u;
        { const int rho = R & 31, pn_ = rho >> 4, pi_ = rho & 15, Rb = (R & ~31) + 8 * (pi_ >> 2) + 4 * pn_ + (pi_ & 3); voffB[i] = (unsigned)(Rb * K + C) * 2u; } }
    const size_t kstep = (size_t)(BK * 2);
    const size_t hstep = (size_t)HALF * K * 2;
    const size_t tstep = 2 * hstep;
    const unsigned ldsw = (unsigned)wid * 1024u;
    const int aoff = lds_byte(wr * 64 + fr, fq * 8), boff = lds_byte(wc * 32 + fr, fq * 8);
#define PG8_SA(b, h) (((b) * 2 + (h)) * HTB)
#define PG8_SB(b, h) ((4 + (b) * 2 + (h)) * HTB)
#define PG8_STAGE(bufoff, gbase) do { _Pragma("unroll") for (int _i = 0; _i < 2; ++_i) \
        __builtin_amdgcn_global_load_lds((const unsigned*)((const char*)(gbase) + (((bufoff) >= 4 * HTB) ? voffB[_i] : voffA[_i])), (LAS unsigned*)(lds + (bufoff) + ldsw + _i * 8192), 16, 0, 0); } while (0)
#define PG8_LDA(dst, b, h) do { _Pragma("unroll") for (int m = 0; m < 4; ++m) _Pragma("unroll") for (int k = 0; k < 2; ++k) dst[m][k] = *(const LAS bf16x8*)(lds + PG8_SA(b, h) + aoff + m * 2048 + k * 1024); } while (0)
#define PG8_LDB(dst, b, h) do { _Pragma("unroll") for (int n = 0; n < 2; ++n) _Pragma("unroll") for (int k = 0; k < 2; ++k) dst[n][k] = *(const LAS bf16x8*)(lds + PG8_SB(b, h) + boff + n * 2048 + k * 1024); } while (0)
#define PG8_MMA(ai, bj, At, Bt) do { __builtin_amdgcn_s_setprio(1); _Pragma("unroll") for (int m = 0; m < 4; ++m) _Pragma("unroll") for (int n = 0; n < 2; ++n) _Pragma("unroll") for (int k = 0; k < 2; ++k) \
        acc[ai][bj][m][n] = __builtin_amdgcn_mfma_f32_16x16x32_bf16(Bt[n][k], At[m][k], acc[ai][bj][m][n], 0, 0, 0); __builtin_amdgcn_s_setprio(0); } while (0)
#define PG8_WAIT_V(n) asm volatile("s_waitcnt vmcnt(" #n ")" ::: "memory")
#define PG8_WAIT_L(n) asm volatile("s_waitcnt lgkmcnt(" #n ")" ::: "memory")
#define PG8_BAR __builtin_amdgcn_s_barrier()
#define PG8_SCHED __builtin_amdgcn_sched_barrier(0)
    Unit cur, nxt; int ui = 0;
    if (!S.next(0, cur)) return;
    f32x4 acc[2][2][4][2];
#pragma unroll
    for (int a = 0; a < 2; ++a)
#pragma unroll
        for (int b = 0; b < 2; ++b)
#pragma unroll
            for (int m = 0; m < 4; ++m)
#pragma unroll
                for (int n = 0; n < 2; ++n) acc[a][b][m][n] = (f32x4){0.f, 0.f, 0.f, 0.f};
    bf16x8 At[4][2], B0[2][2], B1[2][2];
    const char* cA = S.aptr(cur, tstep); const char* cB = S.bptr(cur, tstep);
    PG8_STAGE(PG8_SB(0, 0), cB); PG8_STAGE(PG8_SA(0, 0), cA); PG8_STAGE(PG8_SB(0, 1), cB + hstep); PG8_STAGE(PG8_SA(0, 1), cA + hstep);
    if (wr == 1) PG8_BAR;
    PG8_WAIT_V(4); PG8_BAR;
    PG8_STAGE(PG8_SB(1, 0), cB + kstep); PG8_STAGE(PG8_SA(1, 0), cA + kstep); PG8_STAGE(PG8_SB(1, 1), cB + hstep + kstep);
    PG8_WAIT_V(6); PG8_BAR;
    for (;;) {
        const bool has_next = S.next(ui + 1, nxt);
        const char* nA = has_next ? S.aptr(nxt, tstep) : cA; const char* nB = has_next ? S.bptr(nxt, tstep) : cB;
        for (int hf = 0; hf < (Epi::HAS_MID ? 2 : 1); ++hf) {
        const int t_lo = Epi::HAS_MID ? hf * (nt / 2) : 0, t_hi = Epi::HAS_MID ? (hf + 1) * (nt / 2) : nt;
        if constexpr (Epi::HAS_MID) { if (hf == 1) { E.mid(acc, cur, wr, wc, fr, fq); PG8_SCHED; } }
#pragma unroll 1
        for (int t = t_lo; t < t_hi; t += 2) {
            const bool last = (t == nt - 2);
            const char* a1 = cA + (size_t)(t + 1) * kstep;
            const char* a2 = last ? nA : cA + (size_t)(t + 2) * kstep; const char* b2 = last ? nB : cB + (size_t)(t + 2) * kstep;
            const char* a3 = a2 + kstep; const char* b3 = b2 + kstep;
            PG8_LDB(B0, 0, 0); PG8_SCHED; PG8_LDA(At, 0, 0); PG8_STAGE(PG8_SA(1, 1), a1 + hstep);
            PG8_WAIT_L(8); PG8_BAR; PG8_WAIT_L(0); PG8_MMA(0, 0, At, B0); PG8_BAR; PG8_SCHED;
            PG8_LDB(B1, 0, 1); PG8_STAGE(PG8_SB(0, 0), b2);
            PG8_BAR; PG8_WAIT_L(0); PG8_MMA(0, 1, At, B1); PG8_BAR;
            PG8_LDA(At, 0, 1); PG8_STAGE(PG8_SA(0, 0), a2);
            PG8_BAR; PG8_WAIT_L(0); PG8_MMA(1, 0, At, B0); PG8_BAR; PG8_SCHED;
            PG8_STAGE(PG8_SB(0, 1), b2 + hstep);
            PG8_WAIT_V(6); PG8_BAR; PG8_MMA(1, 1, At, B1); PG8_BAR;
            PG8_LDB(B0, 1, 0); PG8_SCHED; PG8_LDA(At, 1, 0); PG8_STAGE(PG8_SA(0, 1), a2 + hstep);
            PG8_WAIT_L(8); PG8_BAR; PG8_WAIT_L(0); PG8_MMA(0, 0, At, B0); PG8_BAR; PG8_SCHED;
            PG8_LDB(B1, 1, 1); PG8_STAGE(PG8_SB(1, 0), b3);
            PG8_BAR; PG8_WAIT_L(0); PG8_MMA(0, 1, At, B1); PG8_BAR;
            PG8_LDA(At, 1, 1); PG8_STAGE(PG8_SA(1, 0), a3);
            PG8_BAR; PG8_WAIT_L(0); PG8_MMA(1, 0, At, B0); PG8_BAR; PG8_SCHED;
            PG8_STAGE(PG8_SB(1, 1), b3 + hstep);
            PG8_WAIT_V(6); PG8_BAR; PG8_MMA(1, 1, At, B1); PG8_BAR;
        }
        }
        E(acc, cur, wr, wc, fr, fq);
        if (!has_next) break;
#pragma unroll
        for (int a = 0; a < 2; ++a)
#pragma unroll
            for (int b = 0; b < 2; ++b)
#pragma unroll
                for (int m = 0; m < 4; ++m)
#pragma unroll
                    for (int n = 0; n < 2; ++n) acc[a][b][m][n] = (f32x4){0.f, 0.f, 0.f, 0.f};
        cur = nxt; cA = nA; cB = nB; ++ui;
    }
    PG8_WAIT_V(0);
    if (wr == 0) PG8_BAR;
    PG8_BAR;
#undef PG8_SA
#undef PG8_SB
#undef PG8_STAGE
#undef PG8_LDA
#undef PG8_LDB
#undef PG8_MMA
#undef PG8_WAIT_V
#undef PG8_WAIT_L
#undef PG8_BAR
#undef PG8_SCHED
}
}

typedef f32x4 AccT[2][2][4][2];
#define EPI_LOOP_ROWS for (int ai = 0; ai < 2; ++ai) _Pragma("unroll") for (int m = 0; m < 4; ++m)
#define EPI_LOOP_COLS for (int bj = 0; bj < 2; ++bj) _Pragma("unroll") for (int n = 0; n < 2; ++n)

struct EpiProj {
    static constexpr bool HAS_MID = false;
    const float* ss0; const float* b_a; bf16_t* proj; float* loga; float* out; bf16_t* kb; bf16_t* vtb;
    __device__ __forceinline__ void operator()(const AccT& acc, const pg8::Unit& u, int wr, int wc, int fr, int fq) const {
        const int row0 = u.pm * 256 + wr * 64 + fr, col0 = u.pn * 256 + wc * 32 + 8 * fq;
        if (u.job == 0) {
            const int pn = u.pn;
            const int kind = (pn == 4) ? 3 : ((pn == 5 || pn == 6 || pn == 11 || pn == 12) ? 1 : (pn >= 13 ? 2 : 0));
            const float sc = (pn == 0 || pn == 8) ? 0.125f : 1.0f;
            float rsv[2][4];
#pragma unroll
            EPI_LOOP_ROWS rsv[ai][m] = ss0[row0 + ai * 128 + m * 16];
#pragma unroll
            EPI_LOOP_ROWS {
                const int row = row0 + ai * 128 + m * 16;
                const float rs = rsqrtf(rsv[ai][m] * (1.0f / 1024.0f) + EPS) * sc;
                u32x2 wp = (u32x2){0u, 0u};
#pragma unroll
                EPI_LOOP_COLS {
                    const int col = col0 + bj * 128 + n * 4;
                    f32x4 v = acc[ai][bj][m][n] * rs;
                    if (kind == 3) {
                        const f32x4 bb = *(const f32x4*)(b_a + (col - 1024));
                        f32x4 o;
#pragma unroll
                        for (int j = 0; j < 4; ++j) { const float z = v[j] + bb[j]; o[j] = (fminf(z, 0.f) - __logf(1.0f + __expf(-fabsf(z)))) * (1.0f / 16.0f); }
                        *(f32x4*)(loga + (size_t)row * 256 + (col - 1024)) = o;
                    } else {
                        if (kind == 1) {
#pragma unroll
                            for (int j = 0; j < 4; ++j) v[j] = v[j] * sigmoidf_(v[j]);
                        } else if (kind == 2) {
#pragma unroll
                            for (int j = 0; j < 4; ++j) v[j] = sigmoidf_(v[j]);
                        }
                        u32x2 w; w.x = cvt_pk_bf16(v[0], v[1]); w.y = cvt_pk_bf16(v[2], v[3]);
                        if (n == 0) wp = w; else { u32x4 W_; W_.x = wp.x; W_.y = wp.y; W_.z = w.x; W_.w = w.y; *(u32x4*)(proj + (size_t)row * NPROJ + col - 4) = W_; }
                    }
                }
            }
        } else {
            float rsv[2][4];
#pragma unroll
            EPI_LOOP_ROWS rsv[ai][m] = ss0[M_TOK + row0 + ai * 128 + m * 16];
#pragma unroll
            EPI_LOOP_ROWS {
                const int row = row0 + ai * 128 + m * 16;
                const float rs = rsqrtf(rsv[ai][m] * (1.0f / 1024.0f) + EPS);
#pragma unroll
                EPI_LOOP_COLS {
                    const int col = col0 + bj * 128 + n * 4;
                    const f32x4 v = acc[ai][bj][m][n] * rs;
                    if (col < 1024) {
                        *(f32x4*)(out + OUT_MK + (size_t)row * 1024 + col) = v;
                        u32x2 w; w.x = cvt_pk_bf16(v[0], v[1]); w.y = cvt_pk_bf16(v[2], v[3]);
                        *(u32x2*)(kb + (size_t)row * 1024 + col) = w;
                    } else {
                        const int c = col - 1024;
                        *(f32x4*)(out + OUT_MV + (size_t)row * 1024 + c) = v;
                        const int b = row >> 8, mem = row & 255;
                        const unsigned w0 = cvt_pk_bf16(v[0], v[1]), w1 = cvt_pk_bf16(v[2], v[3]);
                        bf16_t* vt = vtb + ((size_t)b * 1024 + c) * 256 + mem;
                        vt[0] = (bf16_t)(w0 & 0xffff); vt[256] = (bf16_t)(w0 >> 16); vt[512] = (bf16_t)(w1 & 0xffff); vt[768] = (bf16_t)(w1 >> 16);
                    }
                }
            }
        }
    }
};

struct EpiMerge {
    static constexpr bool HAS_MID = true;
    const bf16_t* proj; bf16_t* mrg;
    __device__ __forceinline__ void mid(AccT& acc, const pg8::Unit& u, int wr, int wc, int fr, int fq) const {
        const int row0 = u.pm * 256 + wr * 64 + fr, col0 = u.pn * 256 + wc * 32 + 8 * fq;
#pragma unroll
        for (int ai = 0; ai < 2; ++ai) {
            u32x2 a[4][2][2], b[4][2][2];
#pragma unroll
            for (int m = 0; m < 4; ++m) {
                unsigned roff = (unsigned)(row0 + ai * 128 + m * 16) * (unsigned)NPROJ + (unsigned)col0;
                asm volatile("" : "+v"(roff));
                const bf16_t* rp = proj + roff;
#pragma unroll
                for (int bj = 0; bj < 2; ++bj) { const u32x4 ta_ = *(const u32x4*)(rp + 3328 + bj * 128), tb_ = *(const u32x4*)(rp + 4352 + bj * 128);
                    a[m][bj][0] = (u32x2){ta_.x, ta_.y}; a[m][bj][1] = (u32x2){ta_.z, ta_.w}; b[m][bj][0] = (u32x2){tb_.x, tb_.y}; b[m][bj][1] = (u32x2){tb_.z, tb_.w}; }
            }
#pragma unroll
            for (int m = 0; m < 4; ++m) {
#pragma unroll
                EPI_LOOP_COLS {
                    const u32x2 av = a[m][bj][n], bv = b[m][bj][n];
                    f32x4 r;
                    r[0] = bflo(av.x) * __builtin_amdgcn_rcpf(bflo(bv.x)); r[1] = bfhi(av.x) * __builtin_amdgcn_rcpf(bfhi(bv.x));
                    r[2] = bflo(av.y) * __builtin_amdgcn_rcpf(bflo(bv.y)); r[3] = bfhi(av.y) * __builtin_amdgcn_rcpf(bfhi(bv.y));
                    acc[ai][bj][m][n] *= r;
                }
                asm volatile("" : "+v"(acc[ai][0][m][0]), "+v"(acc[ai][0][m][1]), "+v"(acc[ai][1][m][0]), "+v"(acc[ai][1][m][1]) :: "memory");
            }
        }
    }
    __device__ __forceinline__ void operator()(const AccT& acc, const pg8::Unit& u, int wr, int wc, int fr, int fq) const {
        const int row0 = u.pm * 256 + wr * 64 + fr, col0 = u.pn * 256 + wc * 32 + 8 * fq;
        u32x2 b[2][4][2][2];
#pragma unroll
        EPI_LOOP_ROWS {
            const bf16_t* rp = proj + (size_t)(row0 + ai * 128 + m * 16) * NPROJ + 4352 + col0;
#pragma unroll
            for (int bj = 0; bj < 2; ++bj) { const u32x4 t_ = *(const u32x4*)(rp + bj * 128); b[ai][m][bj][0] = (u32x2){t_.x, t_.y}; b[ai][m][bj][1] = (u32x2){t_.z, t_.w}; }
        }
#pragma unroll
        EPI_LOOP_ROWS {
            const int row = row0 + ai * 128 + m * 16;
            u32x2 wp = (u32x2){0u, 0u};
#pragma unroll
            EPI_LOOP_COLS {
                const int col = col0 + bj * 128 + n * 4;
                const u32x2 bv = b[ai][m][bj][n];
                const f32x4 v = acc[ai][bj][m][n];
                u32x2 w; w.x = cvt_pk_bf16(v[0] * bflo(bv.x), v[1] * bfhi(bv.x)); w.y = cvt_pk_bf16(v[2] * bflo(bv.y), v[3] * bfhi(bv.y));
                if (n == 0) wp = w; else { u32x4 W_; W_.x = wp.x; W_.y = wp.y; W_.z = w.x; W_.w = w.y; *(u32x4*)(mrg + (size_t)row * 1024 + col - 4) = W_; }
            }
        }
    }
};

struct EpiResid {
    static constexpr bool HAS_MID = false;
    const bf16_t* base; bf16_t* HB; float* SS;
    __device__ __forceinline__ void operator()(const AccT& acc, const pg8::Unit& u, int wr, int wc, int fr, int fq) const {
        const int row0 = u.pm * 256 + wr * 64 + fr, col0 = u.pn * 256 + wc * 32 + 8 * fq;
        u32x2 bv[2][4][2][2];
#pragma unroll
        EPI_LOOP_ROWS {
            const bf16_t* rp = base + (size_t)(row0 + ai * 128 + m * 16) * 1024 + col0;
#pragma unroll
            for (int bj = 0; bj < 2; ++bj) { const u32x4 t_ = *(const u32x4*)(rp + bj * 128); bv[ai][m][bj][0] = (u32x2){t_.x, t_.y}; bv[ai][m][bj][1] = (u32x2){t_.z, t_.w}; }
        }
#pragma unroll
        EPI_LOOP_ROWS {
            const int row = row0 + ai * 128 + m * 16;
            float s = 0.f; u32x2 wp = (u32x2){0u, 0u};
#pragma unroll
            EPI_LOOP_COLS {
                const int col = col0 + bj * 128 + n * 4;
                const u32x2 b = bv[ai][m][bj][n];
                f32x4 v = acc[ai][bj][m][n];
                v[0] += bflo(b.x); v[1] += bfhi(b.x); v[2] += bflo(b.y); v[3] += bfhi(b.y);
                s += (v[0] * v[0] + v[1] * v[1]) + (v[2] * v[2] + v[3] * v[3]);
                u32x2 w; w.x = cvt_pk_bf16(v[0], v[1]); w.y = cvt_pk_bf16(v[2], v[3]);
                if (n == 0) wp = w; else { u32x4 W_; W_.x = wp.x; W_.y = wp.y; W_.z = w.x; W_.w = w.y; *(u32x4*)(HB + (size_t)row * 1024 + col - 4) = W_; }
            }
            s += __shfl_xor(s, 16); s += __shfl_xor(s, 32);
            if (fq == 0) SS[(size_t)(u.pn * 4 + wc) * M_TOK + row] = s;
        }
    }
};

struct EpiScale {
    static constexpr bool HAS_MID = false;
    const float* SS; bf16_t* O; int ldo; float sc;
    __device__ __forceinline__ void operator()(const AccT& acc, const pg8::Unit& u, int wr, int wc, int fr, int fq) const {
        const int row0 = u.pm * 256 + wr * 64 + fr, col0 = u.pn * 256 + wc * 32 + 8 * fq;
        float part[2][4];
#pragma unroll
        EPI_LOOP_ROWS {
            const int row = row0 + ai * 128 + m * 16;
            float t = 0.f;
#pragma unroll
            for (int q = 0; q < 4; ++q) t += SS[(size_t)(fq * 4 + q) * M_TOK + row];
            part[ai][m] = t;
        }
#pragma unroll
        EPI_LOOP_ROWS {
            const int row = row0 + ai * 128 + m * 16;
            float ssum = part[ai][m];
            ssum += __shfl_xor(ssum, 16); ssum += __shfl_xor(ssum, 32);
            const float rs = rsqrtf(ssum * (1.0f / 1024.0f) + EPS) * sc;
            u32x2 wp = (u32x2){0u, 0u};
#pragma unroll
            EPI_LOOP_COLS {
                const int col = col0 + bj * 128 + n * 4;
                const f32x4 v = acc[ai][bj][m][n] * rs;
                u32x2 w; w.x = cvt_pk_bf16(v[0], v[1]); w.y = cvt_pk_bf16(v[2], v[3]);
                if (n == 0) wp = w; else { u32x4 W_; W_.x = wp.x; W_.y = wp.y; W_.z = w.x; W_.w = w.y; *(u32x4*)(O + (size_t)row * ldo + col - 4) = W_; }
            }
        }
    }
};

struct TJob { const float* src; int ld, c0, tn, K; bf16_t* dst; int Kd, kofs; const float* gain; };
__device__ __forceinline__ void tjob_get(const Params& p, int T, TJob& j, int& tile) {
    unsigned char* ws = p.ws;
    if (T < 256) { j = TJob{p.in[8], 5136, 0, 16, 1024, (bf16_t*)(ws + OFF_WTIN), 1024, 0, p.in[7]}; tile = T; return; }
    T -= 256;
    if (T < 1024) { j = TJob{p.in[8], 5136, 1040, 64, 1024, (bf16_t*)(ws + OFF_WTIN) + (size_t)1280 * 1024, 1024, 0, p.in[7]}; tile = T; return; }
    T -= 1024;
    if (T < 128) { j = TJob{p.in[13], 1024, 0, 16, 512, (bf16_t*)(ws + OFF_WTP), 1024, 0, nullptr}; tile = T; return; }
    T -= 128;
    if (T < 128) { j = TJob{p.in[14], 1024, 0, 16, 512, (bf16_t*)(ws + OFF_WTP), 1024, 512, nullptr}; tile = T; return; }
    T -= 128;
    if (T < 256) { j = TJob{p.in[15], 1024, 0, 16, 1024, (bf16_t*)(ws + OFF_WTO), 1024, 0, nullptr}; tile = T; return; }
    T -= 256;
    if (T < 256) { j = TJob{p.in[18], 1024, 0, 16, 1024, (bf16_t*)(ws + OFF_WTXQ), 1024, 0, p.in[16]}; tile = T; return; }
    T -= 256;
    if (T < 256) { j = TJob{p.in[19], 1024, 0, 16, 1024, (bf16_t*)(ws + OFF_WTKV), 1024, 0, p.in[17]}; tile = T; return; }
    T -= 256;
    if (T < 256) { j = TJob{p.in[20], 1024, 0, 16, 1024, (bf16_t*)(ws + OFF_WTKV) + (size_t)1024 * 1024, 1024, 0, p.in[17]}; tile = T; return; }
    T -= 256;
    if (T < 256) { j = TJob{p.in[21], 1024, 0, 16, 1024, (bf16_t*)(ws + OFF_WTXO), 1024, 0, nullptr}; tile = T; return; }
    T -= 256;
    j = TJob{p.in[23], 2048, 0, 32, 1024, (bf16_t*)(ws + OFF_WTPQ), 1024, 0, p.in[22]}; tile = T;
}
constexpr int N_TTILES = 256 + 1024 + 128 + 128 + 256 * 5 + 512;

__device__ void phase_prep(const Params& p, LAS unsigned char* lds) {
    int tid_ = threadIdx.x; asm volatile("" : "+v"(tid_)); const int tid = tid_, lane = tid & 63, wid = tid >> 6;
    const int gw = blockIdx.x * 8 + wid, nw = gridDim.x * 8;
    const size_t gt = (size_t)blockIdx.x * NTHR + tid, ngt = (size_t)gridDim.x * NTHR;
    unsigned char* ws = p.ws;
    {
        bf16_t* A0 = (bf16_t*)(ws + OFF_A0); float* ss0 = (float*)(ws + OFF_SS0);
        for (int r = gw; r < M_ALL; r += nw) {
            const float* src = r < M_PR ? p.in[0] + (size_t)r * 1024 : (r < M_TOK ? p.in[1] + (size_t)(r - M_PR) * 1024 : p.in[2] + (size_t)(r - M_TOK) * 1024);
            float s = 0.f;
#pragma unroll
            for (int i = 0; i < 4; ++i) {
                const f32x4 v = *(const f32x4*)(src + i * 256 + lane * 4);
                s += (v[0] * v[0] + v[1] * v[1]) + (v[2] * v[2] + v[3] * v[3]);
                u32x2 w; w.x = cvt_pk_bf16(v[0], v[1]); w.y = cvt_pk_bf16(v[2], v[3]);
                *(u32x2*)(A0 + (size_t)r * 1024 + i * 256 + lane * 4) = w;
            }
            s = wave_sum(s);
            if (lane == 0) ss0[r] = s;
        }
    }
    { float* z = (float*)(ws + OFF_SS1); for (size_t i = gt; i < (size_t)2 * M_TOK; i += ngt) z[i] = 0.f; }
    {
        const size_t n_sk = (size_t)8 * 2 * 128 * 128 / 8;
        for (size_t k = gt; k < n_sk; k += ngt) {
            const float* src = p.in[24]; bf16_t* dst = (bf16_t*)(ws + OFF_SKB);
            const f32x4 a = *(const f32x4*)(src + k * 8), b = *(const f32x4*)(src + k * 8 + 4);
            u32x4 w; w.x = cvt_pk_bf16(a[0], a[1]); w.y = cvt_pk_bf16(a[2], a[3]); w.z = cvt_pk_bf16(b[0], b[1]); w.w = cvt_pk_bf16(b[2], b[3]);
            *(u32x4*)(dst + k * 8) = w;
        }
        const size_t n_u = (size_t)16384 * 1024 / 16;
        for (size_t i = gt; i < 2 * n_u; i += ngt) {
            const bool isv = i >= n_u; const size_t k = isv ? i - n_u : i;
            const float* src = (isv ? p.in[26] : p.in[25]) + k * 16; unsigned char* dst = ws + (isv ? OFF_VB : OFF_UB) + k * 16;
            const float sc = isv ? 64.0f : 1024.0f;
            u32x4 w;
#pragma unroll
            for (int q = 0; q < 4; ++q) {
                f32x4 a = *(const f32x4*)(src + q * 4) * sc;
#pragma unroll
                for (int e = 0; e < 4; ++e) a[e] = fminf(fmaxf(a[e], -448.0f), 448.0f);
                int t = 0;
                t = __builtin_amdgcn_cvt_pk_fp8_f32(a[0], a[1], t, false);
                t = __builtin_amdgcn_cvt_pk_fp8_f32(a[2], a[3], t, true);
                w[q] = (unsigned)t;
            }
            *(u32x4*)dst = w;
        }
    }
    {
        const float* w_in = p.in[8]; const float* w_a2 = p.in[9]; const float* g = p.in[7];
        bf16_t* dst = (bf16_t*)(ws + OFF_WTIN) + (size_t)1024 * 1024;
        for (size_t i = gt; i < (size_t)256 * 128; i += ngt) {
            const int j = (int)(i >> 7), k0 = (int)(i & 127) * 8;
            float wa[16];
#pragma unroll
            for (int r = 0; r < 16; ++r) wa[r] = w_a2[r * 256 + j];
            float o[8];
#pragma unroll
            for (int e = 0; e < 8; ++e) {
                const float* wr_ = w_in + (size_t)(k0 + e) * 5136 + 1024;
                float s = 0.f;
#pragma unroll
                for (int r4 = 0; r4 < 4; ++r4) { const f32x4 v = *(const f32x4*)(wr_ + r4 * 4); s += v[0] * wa[r4 * 4] + v[1] * wa[r4 * 4 + 1] + v[2] * wa[r4 * 4 + 2] + v[3] * wa[r4 * 4 + 3]; }
                o[e] = s * g[k0 + e];
            }
            u32x4 w; w.x = cvt_pk_bf16(o[0], o[1]); w.y = cvt_pk_bf16(o[2], o[3]); w.z = cvt_pk_bf16(o[4], o[5]); w.w = cvt_pk_bf16(o[6], o[7]);
            *(u32x4*)(dst + (size_t)j * 1024 + k0) = w;
        }
    }
    {
        LAS float* tl = (LAS float*)lds;
        for (int T = blockIdx.x; T < N_TTILES; T += gridDim.x) {
            TJob j; int tile; tjob_get(p, T, j, tile);
            const int tk = tile / j.tn, tnn = tile % j.tn, k0 = tk * 64, n0 = tnn * 64;
            {
                const int kr = tid >> 4, nc = (tid & 15) * 4;
#pragma unroll
                for (int pp = 0; pp < 2; ++pp) {
                    const int k = k0 + kr + 32 * pp;
                    f32x4 v = *(const f32x4*)(j.src + (size_t)k * j.ld + j.c0 + n0 + nc);
                    if (j.gain) v *= j.gain[k];
                    LAS float* d = tl + (kr + 32 * pp) * 65 + nc;
                    d[0] = v[0]; d[1] = v[1]; d[2] = v[2]; d[3] = v[3];
                }
            }
            __syncthreads();
            {
                const int n = tid >> 3, kq = (tid & 7) * 8;
                float o[8];
#pragma unroll
                for (int e = 0; e < 8; ++e) o[e] = tl[(kq + e) * 65 + n];
                u32x4 w; w.x = cvt_pk_bf16(o[0], o[1]); w.y = cvt_pk_bf16(o[2], o[3]); w.z = cvt_pk_bf16(o[4], o[5]); w.w = cvt_pk_bf16(o[6], o[7]);
                *(u32x4*)(j.dst + (size_t)(n0 + n) * j.Kd + j.kofs + k0 + kq) = w;
            }
            __syncthreads();
        }
    }
}

#define MFMA16(a, b, c) __builtin_amdgcn_mfma_f32_16x16x32_bf16((a), (b), (c), 0, 0, 0)
__device__ __forceinline__ float scan64(float v, int lane) {
#pragma unroll
    for (int o = 1; o < 64; o <<= 1) { const float t = __shfl_up(v, o); if (lane >= o) v += t; }
    return v;
}
__device__ void phase_scan(const Params& p, LAS unsigned char* lds) {
    int tid_ = threadIdx.x; asm volatile("" : "+v"(tid_)); const int tid = tid_, lane = tid & 63, wid = tid >> 6, fr = lane & 15, fq = lane >> 4;
    const bf16_t* proj = (const bf16_t*)(p.ws + OFF_PROJ); const float* loga = (const float*)(p.ws + OFF_LOGA);
    float* omix = (float*)(p.ws + OFF_X);
    constexpr int P = 72;
    for (int u = blockIdx.x; u < 256; u += gridDim.x) {
        const int vs = u & 3, mx = (u >> 2) & 1, h = (u >> 3) & 3, b = u >> 5;
        const int qoff = (mx ? 1792 : 0) + h * 64, koff = (mx ? 2048 : 256) + h * 64, voff = (mx ? 2304 : 512) + h * 128 + vs * 32;
        const float lg = log1pf(-exp2f(-5.0f - (float)h));
        float inv[4];
#pragma unroll
        for (int e = 0; e < 4; ++e) inv[e] = exp2f(-(float)(4 * wid + e) * (13.287712379549449f / 32.0f));
        f32x4 sacc = (f32x4){0.f, 0.f, 0.f, 0.f};
        LAS bf16_t* QE = (LAS bf16_t*)lds; LAS bf16_t* KE = (LAS bf16_t*)(lds + 9216);
        LAS bf16_t* ATT = (LAS bf16_t*)(lds + 18432);
        LAS bf16_t* ST = (LAS bf16_t*)(lds + 27648);
        for (int i = tid; i < 32 * P; i += NTHR) ST[i] = 0;
        const int ct = wid >> 2, w4 = wid & 3;
        u32x2 rq0, rq1, rk0, rk1, rv; f32x4 rl0 = (f32x4){0.f, 0.f, 0.f, 0.f}, rl1 = rl0;
        u32x4 gq, gk, gv = (u32x4){0u, 0u, 0u, 0u}; f32x4 gl0 = (f32x4){0.f, 0.f, 0.f, 0.f}, gl1 = gl0;
#define SCAN_RAW(bi) (lds + 61440 + (bi) * 40960)
#define SCAN_STAGE_LOAD(ch) do { const size_t tb_ = (size_t)b * 2048 + (ch) * 64; \
            gq = *(const u32x4*)(proj + (tb_ + (tid >> 3)) * NPROJ + qoff + (tid & 7) * 8); gk = *(const u32x4*)(proj + (tb_ + (tid >> 3)) * NPROJ + koff + (tid & 7) * 8); \
            if (tid < 256) gv = *(const u32x4*)(proj + (tb_ + (tid >> 2)) * NPROJ + voff + (tid & 3) * 8); \
            if (!mx) { gl0 = *(const f32x4*)(loga + (tb_ + (tid >> 4)) * 256 + h * 64 + (tid & 15) * 4); gl1 = *(const f32x4*)(loga + (tb_ + 32 + (tid >> 4)) * 256 + h * 64 + (tid & 15) * 4); } } while (0)
#define SCAN_STAGE_WRITE(bi) do { LAS unsigned char* r_ = SCAN_RAW(bi); \
            *(LAS u32x4*)(r_ + (tid >> 3) * 144 + (tid & 7) * 16) = gq; *(LAS u32x4*)(r_ + 9216 + (tid >> 3) * 144 + (tid & 7) * 16) = gk; \
            if (tid < 256) *(LAS u32x4*)(r_ + 18432 + (tid >> 2) * 80 + (tid & 3) * 16) = gv; \
            if (!mx) { *(LAS f32x4*)(r_ + 23552 + (tid >> 4) * 272 + (tid & 15) * 16) = gl0; *(LAS f32x4*)(r_ + 23552 + (32 + (tid >> 4)) * 272 + (tid & 15) * 16) = gl1; } } while (0)
#define SCAN_READ_RAW(bi) do { const LAS unsigned char* r_ = SCAN_RAW(bi); \
            rq0 = *(const LAS u32x2*)(r_ + lane * 144 + 8 * wid); rq1 = *(const LAS u32x2*)(r_ + lane * 144 + 64 + 8 * wid); \
            rk0 = *(const LAS u32x2*)(r_ + 9216 + lane * 144 + 8 * wid); rk1 = *(const LAS u32x2*)(r_ + 9216 + lane * 144 + 64 + 8 * wid); \
            rv = *(const LAS u32x2*)(r_ + 18432 + lane * 80 + 8 * wid); \
            if (!mx) { rl0 = *(const LAS f32x4*)(r_ + 23552 + lane * 272 + 16 * wid); rl1 = *(const LAS f32x4*)(r_ + 23552 + lane * 272 + 128 + 16 * wid); } } while (0)
        SCAN_STAGE_LOAD(0); SCAN_STAGE_WRITE(0); SCAN_STAGE_LOAD(1);
        __syncthreads();
        for (int ch = 0; ch < 32; ++ch) {
            SCAN_READ_RAW(ch & 1);
            LAS unsigned char* buf = lds + 32256 + (ch & 1) * 14336;
            LAS bf16_t* KDT = (LAS bf16_t*)buf; LAS bf16_t* VT = (LAS bf16_t*)(buf + 9216); LAS float* DL = (LAS float*)(buf + 13824);
            {
                float qa[4] = {bflo(rq0.x), bfhi(rq0.x), bflo(rq0.y), bfhi(rq0.y)}, qb[4] = {bflo(rq1.x), bfhi(rq1.x), bflo(rq1.y), bfhi(rq1.y)};
                float ka[4] = {bflo(rk0.x), bfhi(rk0.x), bflo(rk0.y), bfhi(rk0.y)}, kb[4] = {bflo(rk1.x), bfhi(rk1.x), bflo(rk1.y), bfhi(rk1.y)};
                float ba[4], bb[4], la[4], lb[4];
                if (mx) {
                    const float pos = (float)(ch * 64 + lane);
#pragma unroll
                    for (int e = 0; e < 4; ++e) {
                        float sn, cs; sincosf(pos * inv[e], &sn, &cs);
                        const float q1 = qa[e], q2 = qb[e], k1 = ka[e], k2 = kb[e];
                        qa[e] = q1 * cs - q2 * sn; qb[e] = q1 * sn + q2 * cs; ka[e] = k1 * cs - k2 * sn; kb[e] = k1 * sn + k2 * cs;
                        ba[e] = bb[e] = (float)(lane + 1) * lg; la[e] = lb[e] = 64.0f * lg;
                    }
                } else {
#pragma unroll
                    for (int e = 0; e < 4; ++e) { ba[e] = scan64(rl0[e], lane); bb[e] = scan64(rl1[e], lane); la[e] = __shfl(ba[e], 63); lb[e] = __shfl(bb[e], 63); }
                }
                float qea[4], qeb[4], kea[4], keb[4];
#pragma unroll
                for (int e = 0; e < 4; ++e) {
                    qea[e] = qa[e] * __expf(ba[e]); qeb[e] = qb[e] * __expf(bb[e]);
                    kea[e] = ka[e] * __expf(-ba[e]); keb[e] = kb[e] * __expf(-bb[e]);
                    const float kda = ka[e] * __expf(la[e] - ba[e]), kdb = kb[e] * __expf(lb[e] - bb[e]);
                    KDT[(4 * wid + e) * P + lane] = (bf16_t)(cvt_pk_bf16(kda, 0.f) & 0xffff);
                    KDT[(32 + 4 * wid + e) * P + lane] = (bf16_t)(cvt_pk_bf16(kdb, 0.f) & 0xffff);
                    if (lane == 63) { DL[4 * wid + e] = __expf(la[e]); DL[32 + 4 * wid + e] = __expf(lb[e]); }
                }
                u32x2 w;
                w.x = cvt_pk_bf16(qea[0], qea[1]); w.y = cvt_pk_bf16(qea[2], qea[3]); *(LAS u32x2*)(QE + lane * P + 4 * wid) = w;
                w.x = cvt_pk_bf16(qeb[0], qeb[1]); w.y = cvt_pk_bf16(qeb[2], qeb[3]); *(LAS u32x2*)(QE + lane * P + 32 + 4 * wid) = w;
                w.x = cvt_pk_bf16(kea[0], kea[1]); w.y = cvt_pk_bf16(kea[2], kea[3]); *(LAS u32x2*)(KE + lane * P + 4 * wid) = w;
                w.x = cvt_pk_bf16(keb[0], keb[1]); w.y = cvt_pk_bf16(keb[2], keb[3]); *(LAS u32x2*)(KE + lane * P + 32 + 4 * wid) = w;
                VT[(4 * wid + 0) * P + lane] = (bf16_t)(rv.x & 0xffff); VT[(4 * wid + 1) * P + lane] = (bf16_t)(rv.x >> 16);
                VT[(4 * wid + 2) * P + lane] = (bf16_t)(rv.y & 0xffff); VT[(4 * wid + 3) * P + lane] = (bf16_t)(rv.y >> 16);
            }
            SCAN_STAGE_WRITE((ch + 1) & 1);
            { const int chn = (ch + 2 < 32) ? ch + 2 : 31; SCAN_STAGE_LOAD(chn); }
            __syncthreads();
            f32x4 oacc = (f32x4){0.f, 0.f, 0.f, 0.f};
            {
#pragma unroll
                for (int q = 0; q < 2; ++q) {
                    const int idx = wid * 2 + q, sb = idx >> 2, tb = idx & 3;
                    f32x4 a = (f32x4){0.f, 0.f, 0.f, 0.f};
                    if (sb <= tb) {
#pragma unroll
                        for (int ks = 0; ks < 2; ++ks) {
                            const bf16x8 A = *(const LAS bf16x8*)(KE + (sb * 16 + fr) * P + ks * 32 + fq * 8);
                            const bf16x8 B = *(const LAS bf16x8*)(QE + (tb * 16 + fr) * P + ks * 32 + fq * 8);
                            a = MFMA16(A, B, a);
                        }
                        const int tg = tb * 16 + fr, sg = sb * 16 + fq * 4;
#pragma unroll
                        for (int jj = 0; jj < 4; ++jj) if (sg + jj > tg) a[jj] = 0.f;
                    }
                    u32x2 w; w.x = cvt_pk_bf16(a[0], a[1]); w.y = cvt_pk_bf16(a[2], a[3]);
                    *(LAS u32x2*)(ATT + (tb * 16 + fr) * P + sb * 16 + fq * 4) = w;
                }
#pragma unroll
                for (int ks = 0; ks < 2; ++ks) {
#ifdef TEST_ST
                    const bf16x8 A = *(const LAS bf16x8*)(VT + (ct * 16 + fr) * P + ks * 32 + fq * 8);
#else
                    const bf16x8 A = *(const LAS bf16x8*)(ST + (ct * 16 + fr) * P + ks * 32 + fq * 8);
#endif
#ifdef TEST_ST
                    const bf16x8 B = *(const LAS bf16x8*)(KDT + (w4 * 16 + fr) * P + ks * 32 + fq * 8);
#else
                    const bf16x8 B = *(const LAS bf16x8*)(QE + (w4 * 16 + fr) * P + ks * 32 + fq * 8);
#endif
                    oacc = MFMA16(A, B, oacc);
                }
            }
            __syncthreads();
            {
                bf16x8 Av[2];
#pragma unroll
                for (int ks = 0; ks < 2; ++ks) Av[ks] = *(const LAS bf16x8*)(VT + (ct * 16 + fr) * P + ks * 32 + fq * 8);
#pragma unroll
                for (int ks = 0; ks < 2; ++ks) {
                    const bf16x8 B = *(const LAS bf16x8*)(ATT + (w4 * 16 + fr) * P + ks * 32 + fq * 8);
#ifndef NO_ATT
                    oacc = MFMA16(Av[ks], B, oacc);
#endif
                }
                const size_t tok = (size_t)b * 2048 + ch * 64 + w4 * 16 + fr;
                *(f32x4*)(omix + tok * 1024 + mx * 512 + h * 128 + vs * 32 + ct * 16 + fq * 4) = oacc;
                const float d = DL[w4 * 16 + fr];
                sacc *= d;
#pragma unroll
                for (int ks = 0; ks < 2; ++ks) {
                    const bf16x8 B = *(const LAS bf16x8*)(KDT + (w4 * 16 + fr) * P + ks * 32 + fq * 8);
                    sacc = MFMA16(Av[ks], B, sacc);
                }
                const unsigned w0 = cvt_pk_bf16(sacc[0], sacc[1]), w1 = cvt_pk_bf16(sacc[2], sacc[3]);
                LAS bf16_t* sp = ST + (ct * 16 + fq * 4) * P + w4 * 16 + fr;
                sp[0] = (bf16_t)(w0 & 0xffff); sp[P] = (bf16_t)(w0 >> 16); sp[2 * P] = (bf16_t)(w1 & 0xffff); sp[3 * P] = (bf16_t)(w1 >> 16);
            }
        }
        *(f32x4*)(p.out + (mx ? OUT_RETP : OUT_GLAP) + ((size_t)(b * 4 + h) * 64 + w4 * 16 + fr) * 128 + vs * 32 + ct * 16 + fq * 4) = sacc;
        __syncthreads();
#undef SCAN_RAW
#undef SCAN_STAGE_LOAD
#undef SCAN_STAGE_WRITE
#undef SCAN_READ_RAW
    }
    {
        LAS float* qv = (LAS float*)lds; LAS float* kv = qv + 256; LAS float* av = kv + 256; LAS float* red = av + 256;
        for (int su = blockIdx.x; su < 1024; su += gridDim.x) {
            const int mx = su & 1, h = (su >> 1) & 3, b = su >> 3;
            const int qoff = (mx ? 1792 : 0) + h * 64, koff = (mx ? 2048 : 256) + h * 64, voff = (mx ? 2304 : 512) + h * 128;
            if (tid < 256) {
                const int t = tid >> 6, k = tid & 63; const size_t tok = (size_t)M_PR + b * 4 + t; const bf16_t* base = proj + tok * NPROJ;
                float q, kk, a;
                if (mx) {
                    const int j = k & 31;
                    const float q1 = bf2f(base[qoff + j]), q2 = bf2f(base[qoff + 32 + j]), k1 = bf2f(base[koff + j]), k2 = bf2f(base[koff + 32 + j]);
                    const float ang = (float)(16384 + t) * exp2f(-(float)j * (13.287712379549449f / 32.0f));
                    float sn, cs; sincosf(ang, &sn, &cs);
                    if (k < 32) { q = q1 * cs - q2 * sn; kk = k1 * cs - k2 * sn; } else { q = q1 * sn + q2 * cs; kk = k1 * sn + k2 * cs; }
                    a = 1.0f - exp2f(-5.0f - (float)h);
                } else { q = bf2f(base[qoff + k]); kk = bf2f(base[koff + k]); a = __expf(loga[tok * 256 + h * 64 + k]); }
                qv[tid] = q; kv[tid] = kk; av[tid] = a;
            }
            __syncthreads();
            const int v = tid & 127, kg = tid >> 7;
            const float* sin_ = (mx ? p.in[4] : p.in[3]) + ((size_t)(b * 4 + h) * 64 + kg * 16) * 128 + v;
            float S[16];
#pragma unroll
            for (int i = 0; i < 16; ++i) S[i] = sin_[(size_t)i * 128];
#pragma unroll
            for (int t = 0; t < 4; ++t) {
                const float vt = bf2f(proj[((size_t)M_PR + b * 4 + t) * NPROJ + voff + v]);
                float part = 0.f;
#pragma unroll
                for (int i = 0; i < 16; ++i) { const int k = t * 64 + kg * 16 + i; S[i] = av[k] * S[i] + kv[k] * vt; part += qv[k] * S[i]; }
                red[(t * 4 + kg) * 128 + v] = part;
            }
            float* sout = p.out + (mx ? OUT_RETS : OUT_GLAS) + ((size_t)(b * 4 + h) * 64 + kg * 16) * 128 + v;
#pragma unroll
            for (int i = 0; i < 16; ++i) sout[(size_t)i * 128] = S[i];
            __syncthreads();
            {
                const int t = tid >> 7;
                const float o = (red[(t * 4 + 0) * 128 + v] + red[(t * 4 + 1) * 128 + v]) + (red[(t * 4 + 2) * 128 + v] + red[(t * 4 + 3) * 128 + v]);
                omix[((size_t)M_PR + b * 4 + t) * 1024 + mx * 512 + h * 128 + v] = o;
            }
            __syncthreads();
        }
    }
}

__device__ void phase_onorm(const Params& p) {
    int tid_ = threadIdx.x; asm volatile("" : "+v"(tid_)); const int tid = tid_, lane = tid & 63, wid = tid >> 6;
    const bf16_t* proj = (const bf16_t*)(p.ws + OFF_PROJ); const float* omix = (const float*)(p.ws + OFF_X); bf16_t* a2 = (bf16_t*)(p.ws + OFF_A2);
    for (int wt = blockIdx.x * 8 + wid; wt < M_TOK * 2; wt += gridDim.x * 8) {
        const int tok = wt >> 1, mx = wt & 1, c = lane * 8;
        const f32x4 o0 = *(const f32x4*)(omix + (size_t)tok * 1024 + mx * 512 + c), o1 = *(const f32x4*)(omix + (size_t)tok * 1024 + mx * 512 + c + 4);
        float ss = (o0[0] * o0[0] + o0[1] * o0[1]) + (o0[2] * o0[2] + o0[3] * o0[3]) + (o1[0] * o1[0] + o1[1] * o1[1]) + (o1[2] * o1[2] + o1[3] * o1[3]);
        ss += __shfl_xor(ss, 1); ss += __shfl_xor(ss, 2); ss += __shfl_xor(ss, 4); ss += __shfl_xor(ss, 8);
        const float r = rsqrtf(ss * (1.0f / 128.0f) + EPS);
        const float* g = (mx ? p.in[12] : p.in[11]) + c;
        const f32x4 g0 = *(const f32x4*)g, g1 = *(const f32x4*)(g + 4);
        const u32x4 gt = *(const u32x4*)(proj + (size_t)tok * NPROJ + (mx ? 2816 : 1280) + c);
        u32x4 w;
        w.x = cvt_pk_bf16(o0[0] * r * g0[0] * bflo(gt.x), o0[1] * r * g0[1] * bfhi(gt.x));
        w.y = cvt_pk_bf16(o0[2] * r * g0[2] * bflo(gt.y), o0[3] * r * g0[3] * bfhi(gt.y));
        w.z = cvt_pk_bf16(o1[0] * r * g1[0] * bflo(gt.z), o1[1] * r * g1[1] * bfhi(gt.z));
        w.w = cvt_pk_bf16(o1[2] * r * g1[2] * bflo(gt.w), o1[3] * r * g1[3] * bfhi(gt.w));
        *(u32x4*)(a2 + (size_t)tok * 1024 + mx * 512 + c) = w;
    }
}

__device__ void phase_attn(const Params& p, LAS unsigned char* lds) {
    int tid_ = threadIdx.x; asm volatile("" : "+v"(tid_)); const int tid = tid_, lane = tid & 63, wid = tid >> 6, fr = lane & 15, fq = lane >> 4;
    const bf16_t* Q = (const bf16_t*)(p.ws + OFF_Q); const bf16_t* KB = (const bf16_t*)(p.ws + OFF_KB); const bf16_t* VTB = (const bf16_t*)(p.ws + OFF_VTB);
    bf16_t* AO = (bf16_t*)(p.ws + OFF_AO);
    const bool sample_first = (blockIdx.x & 8) != 0;
#pragma unroll 1
    for (int part = 0; part < 2; ++part) {
    if ((part == 0) != sample_first) {
    constexpr int KP = 528;
    for (int du0 = blockIdx.x; du0 < 256; du0 += gridDim.x) {
        int du = du0;
        if (gridDim.x == 256) { const int xcd = du0 & 7, slot = du0 >> 3; du = (xcd * 4 + (slot >> 3)) * 8 + (slot & 7); }
        const int q8 = du & 7, h = (du >> 3) & 3, b = du >> 5;
        {
            const bf16_t* src = KB + (size_t)b * 256 * 1024 + h * 256 + (tid & 31) * 8;
#pragma unroll 2
            for (int ps = 0; ps < 16; ++ps) {
                const int r = ps * 16 + (tid >> 5);
                *(LAS u32x4*)(lds + r * KP + (tid & 31) * 16) = *(const u32x4*)(src + (size_t)r * 1024);
            }
        }
        __syncthreads();
        bf16x8 pf[2][8]; float rinv2[2];
#pragma unroll
        for (int sub = 0; sub < 2; ++sub) {
            const size_t row0 = (size_t)b * 2048 + q8 * 256 + sub * 128 + wid * 16;
            bf16x8 qf[8];
#pragma unroll
            for (int ks = 0; ks < 8; ++ks) qf[ks] = *(const bf16x8*)(Q + (row0 + fr) * 1024 + h * 256 + ks * 32 + fq * 8);
            float mxv = -3.0e38f;
#pragma unroll 2
            for (int mb = 0; mb < 16; ++mb) {
                f32x4 a = (f32x4){0.f, 0.f, 0.f, 0.f};
#pragma unroll
                for (int ks = 0; ks < 8; ++ks) a = MFMA16(*(const LAS bf16x8*)(lds + (mb * 16 + fr) * KP + ks * 64 + fq * 16), qf[ks], a);
                mxv = fmaxf(fmaxf(mxv, fmaxf(a[0], a[1])), fmaxf(a[2], a[3]));
                asm volatile("" ::: "memory");
            }
            mxv = fmaxf(mxv, __shfl_xor(mxv, 16)); mxv = fmaxf(mxv, __shfl_xor(mxv, 32));
            float sm = 0.f;
#pragma unroll
            for (int kk = 0; kk < 8; ++kk) {
                f32x4 a0 = (f32x4){0.f, 0.f, 0.f, 0.f}, a1 = a0;
#pragma unroll
                for (int ks = 0; ks < 8; ++ks) {
                    a0 = MFMA16(*(const LAS bf16x8*)(lds + ((2 * kk) * 16 + fr) * KP + ks * 64 + fq * 16), qf[ks], a0);
                    a1 = MFMA16(*(const LAS bf16x8*)(lds + ((2 * kk + 1) * 16 + fr) * KP + ks * 64 + fq * 16), qf[ks], a1);
                }
#pragma unroll
                for (int jj = 0; jj < 4; ++jj) { a0[jj] = __expf(a0[jj] - mxv); a1[jj] = __expf(a1[jj] - mxv); sm += a0[jj] + a1[jj]; }
                u32x4 w; w.x = cvt_pk_bf16(a0[0], a0[1]); w.y = cvt_pk_bf16(a0[2], a0[3]); w.z = cvt_pk_bf16(a1[0], a1[1]); w.w = cvt_pk_bf16(a1[2], a1[3]);
                pf[sub][kk] = __builtin_bit_cast(bf16x8, w);
                asm volatile("" ::: "memory");
            }
            sm += __shfl_xor(sm, 16); sm += __shfl_xor(sm, 32);
            rinv2[sub] = 1.0f / sm;
        }
        __syncthreads();
        {
            const bf16_t* src = VTB + ((size_t)b * 1024 + h * 256) * 256 + (tid & 31) * 8;
#pragma unroll 2
            for (int ps = 0; ps < 16; ++ps) {
                const int r = ps * 16 + (tid >> 5);
                *(LAS u32x4*)(lds + r * KP + (tid & 31) * 16) = *(const u32x4*)(src + (size_t)r * 256);
            }
        }
        __syncthreads();
        {
            const size_t rowA = (size_t)b * 2048 + q8 * 256 + wid * 16 + fr;
#pragma unroll 1
            for (int db = 0; db < 16; ++db) {
                f32x4 a0 = (f32x4){0.f, 0.f, 0.f, 0.f}, a1 = a0;
#pragma unroll
                for (int kk = 0; kk < 8; ++kk) {
                    const LAS unsigned char* vp = lds + (db * 16 + fr) * KP + (kk * 32 + fq * 4) * 2;
                    const u32x2 lo = *(const LAS u32x2*)vp, hi = *(const LAS u32x2*)(vp + 32);
                    u32x4 w; w.x = lo.x; w.y = lo.y; w.z = hi.x; w.w = hi.y;
                    const bf16x8 vf = __builtin_bit_cast(bf16x8, w);
                    a0 = MFMA16(vf, pf[0][kk], a0); a1 = MFMA16(vf, pf[1][kk], a1);
                }
                a0 *= rinv2[0]; a1 *= rinv2[1];
                u32x2 w0, w1; w0.x = cvt_pk_bf16(a0[0], a0[1]); w0.y = cvt_pk_bf16(a0[2], a0[3]); w1.x = cvt_pk_bf16(a1[0], a1[1]); w1.y = cvt_pk_bf16(a1[2], a1[3]);
                *(u32x2*)(AO + rowA * 1024 + h * 256 + db * 16 + fq * 4) = w0;
                *(u32x2*)(AO + (rowA + 128) * 1024 + h * 256 + db * 16 + fq * 4) = w1;
                asm volatile("" ::: "memory");
            }
        }
        __syncthreads();
    }
    } else {
    {
        LAS float* sc = (LAS float*)lds;
        LAS float* red = sc + 2048;
        const float* CK = p.in[5]; const float* CV = p.in[6];
        for (int u = blockIdx.x; u < 256; u += gridDim.x) {
            const int b = u >> 1, hp = u & 1;
            float qr[4][2][4];
#pragma unroll
            for (int t = 0; t < 4; ++t)
#pragma unroll
                for (int hh = 0; hh < 2; ++hh) {
                    const u32x2 w = *(const u32x2*)(Q + ((size_t)M_PR + b * 4 + t) * 1024 + (hp * 2 + hh) * 256 + lane * 4);
                    qr[t][hh][0] = bflo(w.x); qr[t][hh][1] = bfhi(w.x); qr[t][hh][2] = bflo(w.y); qr[t][hh][3] = bfhi(w.y);
                }
            for (int mi = 0; mi < 32; mi += 4) {
                f32x4 kr[4][2];
#pragma unroll
                for (int i = 0; i < 4; ++i)
#pragma unroll
                    for (int hh = 0; hh < 2; ++hh) kr[i][hh] = *(const f32x4*)(CK + (((size_t)b * 256 + wid * 32 + mi + i) * 4 + hp * 2 + hh) * 256 + lane * 4);
                float v32[32];
#pragma unroll
                for (int i = 0; i < 4; ++i)
#pragma unroll
                    for (int hh = 0; hh < 2; ++hh)
#pragma unroll
                        for (int t = 0; t < 4; ++t)
                            v32[(i * 2 + hh) * 4 + t] = kr[i][hh][0] * qr[t][hh][0] + kr[i][hh][1] * qr[t][hh][1] + kr[i][hh][2] * qr[t][hh][2] + kr[i][hh][3] * qr[t][hh][3];
                float w16[16], w8[8], w4[4], w2[2];
                { const bool up = (lane & 32) != 0;
#pragma unroll
                  for (int j = 0; j < 16; ++j) { const float keep = up ? v32[16 + j] : v32[j], send = up ? v32[j] : v32[16 + j]; w16[j] = keep + __shfl_xor(send, 32); } }
                { const bool up = (lane & 16) != 0;
#pragma unroll
                  for (int j = 0; j < 8; ++j) { const float keep = up ? w16[8 + j] : w16[j], send = up ? w16[j] : w16[8 + j]; w8[j] = keep + __shfl_xor(send, 16); } }
                { const bool up = (lane & 8) != 0;
#pragma unroll
                  for (int j = 0; j < 4; ++j) { const float keep = up ? w8[4 + j] : w8[j], send = up ? w8[j] : w8[4 + j]; w4[j] = keep + __shfl_xor(send, 8); } }
                { const bool up = (lane & 4) != 0;
#pragma unroll
                  for (int j = 0; j < 2; ++j) { const float keep = up ? w4[2 + j] : w4[j], send = up ? w4[j] : w4[2 + j]; w2[j] = keep + __shfl_xor(send, 4); } }
                float r1;
                { const bool up = (lane & 2) != 0; const float keep = up ? w2[1] : w2[0], send = up ? w2[0] : w2[1]; r1 = keep + __shfl_xor(send, 2); }
                r1 += __shfl_xor(r1, 1);
                if ((lane & 1) == 0) { const int e = (lane >> 1) & 31, i = e >> 3, hh = (e >> 2) & 1, t = e & 3; sc[(t * 2 + hh) * 256 + wid * 32 + mi + i] = r1; }
            }
            __syncthreads();
            {
                LAS float* r = sc + wid * 256;
                float v0 = r[lane], v1 = r[lane + 64], v2 = r[lane + 128], v3 = r[lane + 192];
                float m = fmaxf(fmaxf(v0, v1), fmaxf(v2, v3));
#pragma unroll
                for (int o = 32; o > 0; o >>= 1) m = fmaxf(m, __shfl_xor(m, o));
                v0 = __expf(v0 - m); v1 = __expf(v1 - m); v2 = __expf(v2 - m); v3 = __expf(v3 - m);
                const float s = wave_sum((v0 + v1) + (v2 + v3)), ri = 1.0f / s;
                r[lane] = v0 * ri; r[lane + 64] = v1 * ri; r[lane + 128] = v2 * ri; r[lane + 192] = v3 * ri;
            }
            __syncthreads();
            {
                f32x4 oa[4][2];
#pragma unroll
                for (int t = 0; t < 4; ++t)
#pragma unroll
                    for (int hh = 0; hh < 2; ++hh) oa[t][hh] = (f32x4){0.f, 0.f, 0.f, 0.f};
                for (int mi = 0; mi < 32; mi += 4) {
                    f32x4 vr[4][2];
#pragma unroll
                    for (int i = 0; i < 4; ++i)
#pragma unroll
                        for (int hh = 0; hh < 2; ++hh) vr[i][hh] = *(const f32x4*)(CV + (((size_t)b * 256 + wid * 32 + mi + i) * 4 + hp * 2 + hh) * 256 + lane * 4);
#pragma unroll
                    for (int i = 0; i < 4; ++i)
#pragma unroll
                        for (int hh = 0; hh < 2; ++hh)
#pragma unroll
                            for (int t = 0; t < 4; ++t) oa[t][hh] += vr[i][hh] * sc[(t * 2 + hh) * 256 + wid * 32 + mi + i];
                }
#pragma unroll
                for (int rnd = 0; rnd < 2; ++rnd) {
#pragma unroll
                    for (int t2 = 0; t2 < 2; ++t2)
#pragma unroll
                        for (int hh = 0; hh < 2; ++hh) *(LAS f32x4*)(red + ((wid * 2 + t2) * 2 + hh) * 256 + lane * 4) = oa[rnd * 2 + t2][hh];
                    __syncthreads();
#pragma unroll
                    for (int i = 0; i < 2; ++i) {
                        const int o = tid + i * 512, t2 = o >> 9, hh = (o >> 8) & 1, d = o & 255;
                        float sacc2 = 0.f;
#pragma unroll
                        for (int w = 0; w < 8; ++w) sacc2 += red[((w * 2 + t2) * 2 + hh) * 256 + d];
                        AO[((size_t)M_PR + b * 4 + rnd * 2 + t2) * 1024 + (hp * 2 + hh) * 256 + d] = (bf16_t)(cvt_pk_bf16(sacc2, 0.f) & 0xffff);
                    }
                    __syncthreads();
                }
            }
        }
    }
    }
    }
}

__device__ __forceinline__ void ins16(float (&T)[16], float x) {
#pragma unroll
    for (int i = 0; i < 16; ++i) { const float hi = fmaxf(T[i], x); x = fminf(T[i], x); T[i] = hi; }
}
__device__ __forceinline__ void sort16(float (&T)[16]) {
#pragma unroll
    for (int k = 2; k <= 16; k <<= 1)
#pragma unroll
        for (int j = k >> 1; j > 0; j >>= 1)
#pragma unroll
            for (int i = 0; i < 16; ++i) {
                const int l = i ^ j;
                if (l > i) {
                    const float hi = fmaxf(T[i], T[l]), lo = fminf(T[i], T[l]);
                    if ((i & k) == 0) { T[i] = hi; T[l] = lo; } else { T[i] = lo; T[l] = hi; }
                }
            }
}
__device__ __forceinline__ void merge16(float (&T)[16]) {
#pragma unroll
    for (int j = 8; j > 0; j >>= 1)
#pragma unroll
        for (int i = 0; i < 16; ++i) {
            const int l = i ^ j;
            if (l > i) { const float hi = fmaxf(T[i], T[l]), lo = fminf(T[i], T[l]); T[i] = hi; T[l] = lo; }
        }
}
__device__ __forceinline__ void topmerge16(float (&T)[16], const float (&G)[16]) {
#pragma unroll
    for (int i = 0; i < 16; ++i) T[i] = fmaxf(T[i], G[15 - i]);
    merge16(T);
}
__device__ __forceinline__ float pack_key(float v, unsigned code, unsigned mask) { return __uint_as_float((__float_as_uint(v) & ~mask) | code); }

__device__ __forceinline__ void peer_select(const bf16_t* PQ, const bf16_t* SKB, int tok0, int frc, int h, LAS int* sel_i, LAS float* sel_g, int fr, int fq) {
            float T1[16], T2[16];
#pragma unroll
            for (int half = 0; half < 2; ++half) {
                bf16x8 qf[4];
#pragma unroll
                for (int ks = 0; ks < 4; ++ks) qf[ks] = *(const bf16x8*)(PQ + (size_t)(tok0 + frc) * 2048 + h * 256 + half * 128 + ks * 32 + fq * 8);
                float T[16], Bk[16];
                {
                    unsigned so = (unsigned)(((h * 2 + half) * 128 + fr) * 128 + fq * 8);
                    asm volatile("" : "+v"(so));
                    const bf16_t* sp0 = SKB + so;
#pragma unroll
                    for (int kg = 0; kg < 2; ++kg) {
                        bf16x8 sf[4][4];
#pragma unroll
                        for (int kb = 0; kb < 4; ++kb)
#pragma unroll
                            for (int ks = 0; ks < 4; ++ks) sf[kb][ks] = *(const bf16x8*)(sp0 + (kg * 4 + kb) * 2048 + ks * 32);
#pragma unroll
                        for (int kb = 0; kb < 4; ++kb) {
                            f32x4 a = (f32x4){0.f, 0.f, 0.f, 0.f};
#pragma unroll
                            for (int ks = 0; ks < 4; ++ks) a = MFMA16(sf[kb][ks], qf[ks], a);
#pragma unroll
                            for (int jj = 0; jj < 4; ++jj) {
                                const float key = pack_key(a[jj], (unsigned)((kg * 4 + kb) * 16 + fq * 4 + jj), 127u);
                                if (kg == 0) T[kb * 4 + jj] = key; else Bk[kb * 4 + jj] = key;
                            }
                        }
                        asm volatile("" ::: "memory");
                    }
                }
                sort16(T); sort16(Bk); topmerge16(T, Bk);
#pragma unroll
                for (int o = 16; o <= 32; o <<= 1) {
                    float R[16];
#pragma unroll
                    for (int i = 0; i < 16; ++i) R[i] = __shfl_xor(T[i], o);
                    topmerge16(T, R);
                }
#pragma unroll
                for (int i = 0; i < 16; ++i) { if (half == 0) T1[i] = T[i]; else T2[i] = T[i]; }
            }
            float va[16], vb[16];
#pragma unroll
            for (int i = 0; i < 16; ++i) { va[i] = __uint_as_float(__float_as_uint(T1[i]) & ~127u); vb[i] = __uint_as_float(__float_as_uint(T2[i]) & ~127u); }
#define PEER_CAND(a_, b_) pack_key(va[a_] + vb[b_], (unsigned)((a_) * 16 + (b_)), 255u)
            float T3[16], X[16];
#pragma unroll
            for (int i = 0; i < 16; ++i) T3[i] = PEER_CAND(0, i);
#pragma unroll
            for (int i = 0; i < 8; ++i) { X[i] = PEER_CAND(1, i); X[8 + i] = PEER_CAND(15 - i, 0); }
            merge16(X); topmerge16(T3, X);
            X[0] = PEER_CAND(2, 0); X[1] = PEER_CAND(2, 1); X[2] = PEER_CAND(2, 2); X[3] = PEER_CAND(2, 3); X[4] = PEER_CAND(2, 4);
            X[5] = PEER_CAND(3, 0); X[6] = PEER_CAND(3, 1); X[7] = PEER_CAND(3, 2); X[8] = PEER_CAND(3, 3);
            X[9] = PEER_CAND(4, 0); X[10] = PEER_CAND(4, 1); X[11] = PEER_CAND(4, 2);
            X[12] = PEER_CAND(5, 0); X[13] = PEER_CAND(5, 1); X[14] = PEER_CAND(6, 0); X[15] = PEER_CAND(6, 1);
            sort16(X); topmerge16(T3, X);
            ins16(T3, PEER_CAND(7, 0)); ins16(T3, PEER_CAND(7, 1));
#undef PEER_CAND
            float e[16], es = 0.f;
            const float m0 = __uint_as_float(__float_as_uint(T3[0]) & ~255u);
#pragma unroll
            for (int i = 0; i < 16; ++i) { e[i] = __expf(__uint_as_float(__float_as_uint(T3[i]) & ~255u) - m0); es += e[i]; }
            const float ei = 1.0f / es;
#pragma unroll
            for (int jj = 0; jj < 4; ++jj) {
                float key = T3[0], ev = e[0];
#pragma unroll
                for (int r = 0; r < 16; ++r) { const bool s = (r == fq * 4 + jj); key = s ? T3[r] : key; ev = s ? e[r] : ev; }
                const unsigned code = __float_as_uint(key) & 255u, ca = code >> 4, cb = code & 15u;
                unsigned k1 = __float_as_uint(T1[0]), k2 = __float_as_uint(T2[0]);
#pragma unroll
                for (int r = 0; r < 16; ++r) { k1 = (ca == (unsigned)r) ? __float_as_uint(T1[r]) : k1; k2 = (cb == (unsigned)r) ? __float_as_uint(T2[r]) : k2; }
                const int idx = (int)((k1 & 127u) * 128u + (k2 & 127u));
                sel_i[fr * 128 + h * 16 + fq * 4 + jj] = idx;
                sel_g[fr * 128 + h * 16 + fq * 4 + jj] = ev * ei;
            }
        }

__device__ void phase_peer(const Params& p, LAS unsigned char* lds) {
    int tid_ = threadIdx.x; asm volatile("" : "+v"(tid_)); const int tid = tid_, lane = tid & 63, wid = tid >> 6, fr = lane & 15, fq = lane >> 4;
    const bf16_t* PQ = (const bf16_t*)(p.ws + OFF_PQ); const bf16_t* SKB = (const bf16_t*)(p.ws + OFF_SKB);
    const unsigned char* U8 = p.ws + OFF_UB; const unsigned char* V8 = p.ws + OFF_VB;
    const float* SS2 = (const float*)(p.ws + OFF_SSP2);
    const bf16_t* H2 = (const bf16_t*)(p.ws + OFF_H2B); float* Y = p.out;
    LAS int* sel_i = (LAS int*)lds;
    LAS float* sel_g = (LAS float*)(lds + 16384);
    LAS float* wv = (LAS float*)(lds + 32768);
    const int per_wg = (M_TOK + gridDim.x - 1) / gridDim.x, wg_lo = blockIdx.x * per_wg, wg_hi = (wg_lo + per_wg < M_TOK) ? wg_lo + per_wg : M_TOK;
    const int ntile = (wg_hi > wg_lo) ? (wg_hi - wg_lo + 15) / 16 : 0;
    if (ntile > 0) {
        const int nv0 = (wg_hi - wg_lo < 16) ? wg_hi - wg_lo : 16, frc0 = (fr < nv0) ? fr : nv0 - 1;
        peer_select(PQ, SKB, wg_lo, frc0, wid, sel_i, sel_g, fr, fq);
    }
    __syncthreads();
    for (int ti = 0; ti < ntile; ++ti) {
        const int tok0 = wg_lo + ti * 16;
        const int nvalid = (wg_hi - tok0 < 16) ? wg_hi - tok0 : 16;
        const LAS int* si_b = sel_i + (ti & 1) * 2048; const LAS float* sg_b = sel_g + (ti & 1) * 2048;
        if (wid >= 4) {
            if (ti + 1 < ntile) {
                const int tok1 = tok0 + 16, nv1 = (wg_hi - tok1 < 16) ? wg_hi - tok1 : 16, frc1 = (fr < nv1) ? fr : nv1 - 1;
#pragma unroll 1
                for (int hh = 0; hh < 2; ++hh) peer_select(PQ, SKB, tok1, frc1, (wid - 4) * 2 + hh, sel_i + ((ti + 1) & 1) * 2048, sel_g + ((ti + 1) & 1) * 2048, fr, fq);
            }
        } else {
    #pragma unroll 1
            for (int tt = 0; tt < 4; ++tt) {
                const int tl = tt * 4 + wid; const size_t tok = (size_t)tok0 + tl;
                if (tl >= nvalid) break;
                const float rs = rsqrtf(wave_sum(lane < 16 ? SS2[(size_t)lane * M_TOK + tok] : 0.f) * (1.0f / 1024.0f) + EPS);
                const bf16_t* hrow = H2 + tok * 1024; const float* gf = p.in[22];
                f32x2 x2[4][8];
    #pragma unroll
                for (int i = 0; i < 4; ++i) {
                    const u32x4 h0 = *(const u32x4*)(hrow + i * 256 + fr * 16), h1 = *(const u32x4*)(hrow + i * 256 + fr * 16 + 8);
    #pragma unroll
                    for (int q = 0; q < 4; ++q) {
                        const f32x4 ga = *(const f32x4*)(gf + i * 256 + fr * 16 + q * 4);
                        const unsigned w0 = (q < 2) ? h0[(q & 1) * 2] : h1[(q & 1) * 2], w1 = (q < 2) ? h0[(q & 1) * 2 + 1] : h1[(q & 1) * 2 + 1];
                        x2[i][q * 2] = (f32x2){bflo(w0) * rs * ga[0], bfhi(w0) * rs * ga[1]}; x2[i][q * 2 + 1] = (f32x2){bflo(w1) * rs * ga[2], bfhi(w1) * rs * ga[3]};
                    }
                }
                const LAS int* si = si_b + tl * 128; const LAS float* sg = sg_b + tl * 128; LAS float* wvw = wv + wid * 128;
                u32x4 bA[1][4], bB[1][4];
    #define PEER_LOADU(buf, g) do { _Pragma("unroll") for (int q_ = 0; q_ < 1; ++q_) { const int idx_ = si[((g) + q_) * 4 + fq]; \
                    const unsigned char* ur_ = U8 + (size_t)idx_ * 1024 + fr * 16; \
                    _Pragma("unroll") for (int i_ = 0; i_ < 4; ++i_) buf[q_][i_] = *(const u32x4*)(ur_ + i_ * 256); } } while (0)
    #define PEER_COMPU(buf, g) do { _Pragma("unroll") for (int q_ = 0; q_ < 1; ++q_) { f32x2 s2_ = (f32x2){0.f, 0.f}; \
                    _Pragma("unroll") for (int i_ = 0; i_ < 4; ++i_) _Pragma("unroll") for (int w_ = 0; w_ < 4; ++w_) { \
                        s2_ += x2[i_][w_ * 2] * __builtin_amdgcn_cvt_pk_f32_fp8((int)buf[q_][i_][w_], false); \
                        s2_ += x2[i_][w_ * 2 + 1] * __builtin_amdgcn_cvt_pk_f32_fp8((int)buf[q_][i_][w_], true); } \
                    float s_ = s2_.x + s2_.y; s_ += __shfl_xor(s_, 1); s_ += __shfl_xor(s_, 2); s_ += __shfl_xor(s_, 4); s_ += __shfl_xor(s_, 8); \
                    if (fr == 0) wvw[((g) + q_) * 4 + fq] = s_ * (1.0f / 1024.0f); } } while (0)
                PEER_LOADU(bA, 0);
    #pragma unroll 1
                for (int g = 0; g < 32; g += 2) {
                    PEER_LOADU(bB, g + 1);
                    PEER_COMPU(bA, g);
                    { const int gn = (g + 2 < 32) ? g + 2 : 31; PEER_LOADU(bA, gn); }
                    PEER_COMPU(bB, g + 1);
                }
                {
                    const float a0 = wvw[lane], a1 = wvw[lane + 64];
                    wvw[lane] = 0.5f * a0 * (1.0f + erff(a0 * 0.70710678118654752f)) * sg[lane] * (1.0f / 64.0f);
                    wvw[lane + 64] = 0.5f * a1 * (1.0f + erff(a1 * 0.70710678118654752f)) * sg[lane + 64] * (1.0f / 64.0f);
                }
                f32x2 acc2[8];
    #pragma unroll
                for (int e2 = 0; e2 < 8; ++e2) acc2[e2] = (f32x2){0.f, 0.f};
                u32x4 vA[8], vB[8];
    #define PEER_LOADV(buf, k0) do { _Pragma("unroll") for (int q_ = 0; q_ < 8; ++q_) buf[q_] = *(const u32x4*)(V8 + (size_t)si[(k0) + q_] * 1024 + lane * 16); } while (0)
    #define PEER_COMPV(buf, k0) do { _Pragma("unroll") for (int q_ = 0; q_ < 8; ++q_) { const float w_ = wvw[(k0) + q_]; \
                    _Pragma("unroll") for (int j_ = 0; j_ < 4; ++j_) { \
                        acc2[j_ * 2] += __builtin_amdgcn_cvt_pk_f32_fp8((int)buf[q_][j_], false) * w_; \
                        acc2[j_ * 2 + 1] += __builtin_amdgcn_cvt_pk_f32_fp8((int)buf[q_][j_], true) * w_; } } } while (0)
                PEER_LOADV(vA, 0);
    #pragma unroll 1
                for (int k0 = 0; k0 < 128; k0 += 16) {
                    PEER_LOADV(vB, k0 + 8);
                    PEER_COMPV(vA, k0);
                    { const int kn = (k0 + 16 < 128) ? k0 + 16 : 120; PEER_LOADV(vA, kn); }
                    PEER_COMPV(vB, k0 + 8);
                }
    #undef PEER_LOADU
    #undef PEER_COMPU
    #undef PEER_LOADV
    #undef PEER_COMPV
                float ss = 0.f; f32x4 hv[4];
                {
                    const u32x4 h0 = *(const u32x4*)(hrow + lane * 16), h1 = *(const u32x4*)(hrow + lane * 16 + 8);
    #pragma unroll
                    for (int q = 0; q < 4; ++q) {
                        const unsigned w0 = (q < 2) ? h0[(q & 1) * 2] : h1[(q & 1) * 2], w1 = (q < 2) ? h0[(q & 1) * 2 + 1] : h1[(q & 1) * 2 + 1];
                        hv[q][0] = bflo(w0) + acc2[q * 2].x; hv[q][1] = bfhi(w0) + acc2[q * 2].y; hv[q][2] = bflo(w1) + acc2[q * 2 + 1].x; hv[q][3] = bfhi(w1) + acc2[q * 2 + 1].y;
                        ss += (hv[q][0] * hv[q][0] + hv[q][1] * hv[q][1]) + (hv[q][2] * hv[q][2] + hv[q][3] * hv[q][3]);
                    }
                }
                ss = wave_sum(ss);
                const float rf = rsqrtf(ss * (1.0f / 1024.0f) + EPS);
                const float* nf = p.in[27];
    #pragma unroll
                for (int q = 0; q < 4; ++q) *(f32x4*)(Y + tok * 1024 + lane * 16 + q * 4) = hv[q] * rf * *(const f32x4*)(nf + lane * 16 + q * 4);
            }
        }
        __syncthreads();
    }
}

struct SmallArgs { const bf16_t* A; const bf16_t* Bt; int N; const bf16_t* proj; const bf16_t* base; bf16_t* O; int ldo; float* SSw; const float* SSr; float sc; };
template <int MODE>
__device__ __forceinline__ void small_gemm(const SmallArgs& a, LAS unsigned char* lds) {
    int tid_ = threadIdx.x; asm volatile("" : "+v"(tid_)); const int tid = tid_, lane = tid & 63, wid = tid >> 6, fr = lane & 15, fq = lane >> 4;
    const int ncb = a.N / 64;
    constexpr int SP = 1040;
    LAS unsigned char* LA = lds; LAS unsigned char* LB = lds + 32 * SP;
    LAS float* red = (LAS float*)(lds + 96 * SP);
    for (int tile = blockIdx.x; tile < 16 * ncb; tile += gridDim.x) {
        const int rb = tile / ncb, cb = tile % ncb;
        const int row = M_PR + rb * 32 + (wid >> 2) * 16 + fr;
        const int colb = cb * 64 + (wid & 3) * 16;
        const bf16_t* Ag = a.A + (size_t)(M_PR + rb * 32) * 1024 + (tid & 63) * 8;
        const bf16_t* Bg = a.Bt + (size_t)(cb * 64) * 1024 + (tid & 63) * 8;
        u32x4 ra[4], rbv[8];
#define SG_LOAD(kh_) do { _Pragma("unroll") for (int i_ = 0; i_ < 4; ++i_) ra[i_] = *(const u32x4*)(Ag + (size_t)((tid >> 6) + 8 * i_) * 1024 + (kh_) * 512); \
            _Pragma("unroll") for (int i_ = 0; i_ < 8; ++i_) rbv[i_] = *(const u32x4*)(Bg + (size_t)((tid >> 6) + 8 * i_) * 1024 + (kh_) * 512); } while (0)
        SG_LOAD(0);
        f32x4 acc = (f32x4){0.f, 0.f, 0.f, 0.f};
#pragma unroll
        for (int kh = 0; kh < 2; ++kh) {
#pragma unroll
            for (int i_ = 0; i_ < 4; ++i_) *(LAS u32x4*)(LA + ((tid >> 6) + 8 * i_) * SP + (tid & 63) * 16) = ra[i_];
#pragma unroll
            for (int i_ = 0; i_ < 8; ++i_) *(LAS u32x4*)(LB + ((tid >> 6) + 8 * i_) * SP + (tid & 63) * 16) = rbv[i_];
            __syncthreads();
            if (kh == 0) SG_LOAD(1);
            const LAS unsigned char* apl = LA + ((wid >> 2) * 16 + fr) * SP + fq * 16;
            const LAS unsigned char* bpl = LB + ((wid & 3) * 16 + fr) * SP + fq * 16;
#pragma unroll
            for (int ks = 0; ks < 16; ++ks) acc = MFMA16(*(const LAS bf16x8*)(bpl + ks * 64), *(const LAS bf16x8*)(apl + ks * 64), acc);
            if (MODE == 0 && kh == 0) {
                const u32x2 sa = *(const u32x2*)(a.proj + (size_t)row * NPROJ + 3328 + colb + fq * 4), sb = *(const u32x2*)(a.proj + (size_t)row * NPROJ + 4352 + colb + fq * 4);
                acc[0] *= bflo(sa.x) * __builtin_amdgcn_rcpf(bflo(sb.x)); acc[1] *= bfhi(sa.x) * __builtin_amdgcn_rcpf(bfhi(sb.x));
                acc[2] *= bflo(sa.y) * __builtin_amdgcn_rcpf(bflo(sb.y)); acc[3] *= bfhi(sa.y) * __builtin_amdgcn_rcpf(bfhi(sb.y));
            }
            __syncthreads();
        }
#undef SG_LOAD
        const int col = colb + fq * 4;
        if (MODE == 0) {
            const u32x2 sb = *(const u32x2*)(a.proj + (size_t)row * NPROJ + 4352 + col);
            u32x2 w; w.x = cvt_pk_bf16(acc[0] * bflo(sb.x), acc[1] * bfhi(sb.x)); w.y = cvt_pk_bf16(acc[2] * bflo(sb.y), acc[3] * bfhi(sb.y));
            *(u32x2*)(a.O + (size_t)row * a.ldo + col) = w;
        } else if (MODE == 1) {
            const u32x2 b = *(const u32x2*)(a.base + (size_t)row * 1024 + col);
            f32x4 v = acc; v[0] += bflo(b.x); v[1] += bfhi(b.x); v[2] += bflo(b.y); v[3] += bfhi(b.y);
            float sq = (v[0] * v[0] + v[1] * v[1]) + (v[2] * v[2] + v[3] * v[3]);
            u32x2 w; w.x = cvt_pk_bf16(v[0], v[1]); w.y = cvt_pk_bf16(v[2], v[3]);
            *(u32x2*)(a.O + (size_t)row * a.ldo + col) = w;
            sq += __shfl_xor(sq, 16); sq += __shfl_xor(sq, 32);
            if (fq == 0) red[((wid >> 2) * 16 + fr) * 4 + (wid & 3)] = sq;
            __syncthreads();
            if (tid < 32) a.SSw[(size_t)cb * M_TOK + M_PR + rb * 32 + tid] = (red[tid * 4] + red[tid * 4 + 1]) + (red[tid * 4 + 2] + red[tid * 4 + 3]);
            __syncthreads();
        } else {
            float t = 0.f;
#pragma unroll
            for (int q = 0; q < 4; ++q) t += a.SSr[(size_t)(fq * 4 + q) * M_TOK + row];
            t += __shfl_xor(t, 16); t += __shfl_xor(t, 32);
            const float rs = rsqrtf(t * (1.0f / 1024.0f) + EPS) * a.sc;
            u32x2 w; w.x = cvt_pk_bf16(acc[0] * rs, acc[1] * rs); w.y = cvt_pk_bf16(acc[2] * rs, acc[3] * rs);
            *(u32x2*)(a.O + (size_t)row * a.ldo + col) = w;
        }
    }
}

#define XB_TMO      128
#define XB_XCNT(j)  (256  + 64 * (j))
#define XB_XSUB(j)  (1280 + 64 * (j))
#define XB_XGEN(j)  (2304 + 64 * (j))
#define XB_TOP      3328
#define XB_TOPGEN   3392
#define XCD_BAR_WORDS 3456
#define XB_SPIN_CAP (1u << 18)

__device__ __forceinline__ unsigned xb_ld(unsigned* p)              { return __hip_atomic_load(p, __ATOMIC_RELAXED, __HIP_MEMORY_SCOPE_AGENT); }
__device__ __forceinline__ unsigned xb_add(unsigned* p, unsigned v) { return __hip_atomic_fetch_add(p, v, __ATOMIC_RELAXED, __HIP_MEMORY_SCOPE_AGENT); }
__device__ __forceinline__ unsigned xb_xcc_id() { return (unsigned)__builtin_amdgcn_s_getreg((3 << 11) | 20) & 0xFu; }
#define XB_SPIN(cond, bar) do { unsigned _sp = 0; while (cond) { __builtin_amdgcn_s_sleep(1); \
    if ((++_sp & 255u) == 0u) { if (xb_ld(&(bar)[XB_TMO])) break; if (_sp > XB_SPIN_CAP) { atomicAdd(&(bar)[XB_TMO], 1u); break; } } } } while (0)

struct XcdBarrier {
    unsigned* bar; unsigned x;
    volatile LAS unsigned* st;
};

__device__ __forceinline__ XcdBarrier xcd_barrier_post(unsigned* bar, volatile LAS unsigned* st) {
    XcdBarrier b; b.bar = bar; b.x = xb_xcc_id(); b.st = st;
    if (threadIdx.x == 0) (void)xb_add(&bar[XB_XCNT(b.x)], 1u);
    return b;
}
__device__ __forceinline__ void xcd_barrier_complete(unsigned* bar, unsigned x, unsigned& nloc, unsigned& nx) {
    const unsigned G = gridDim.x * gridDim.y * gridDim.z;
    unsigned sum, cnt, mine, sp = 0u;
    for (;;) {
        sum = 0u; cnt = 0u; mine = 0u;
#pragma unroll
        for (unsigned j = 0; j < 16; ++j) { const unsigned c = xb_ld(&bar[XB_XCNT(j)]); sum += c; cnt += (c > 0u) ? 1u : 0u; mine = (j == x) ? c : mine; }
        if (sum == G) break;
        __builtin_amdgcn_s_sleep(1);
        if ((++sp & 255u) == 0u) { if (xb_ld(&bar[XB_TMO])) break; if (sp > XB_SPIN_CAP) { atomicAdd(&bar[XB_TMO], 1u); break; } }
    }
    nloc = mine > 0u ? mine : 1u; nx = cnt > 0u ? cnt : 1u;
}

__device__ __forceinline__ void xcd_barrier(const XcdBarrier& b) {
    asm volatile("s_waitcnt vmcnt(0)" ::: "memory");
    __syncthreads();
    if (threadIdx.x == 0) {
        unsigned* bar = b.bar;
        __builtin_amdgcn_s_waitcnt(0);
        unsigned nloc = b.st[0], nx = b.st[1];
        if (nloc == 0u) { xcd_barrier_complete(bar, b.x, nloc, nx); b.st[0] = nloc; b.st[1] = nx; }
        const unsigned old = xb_add(&bar[XB_XSUB(b.x)], 1u);
        const unsigned gen = old / nloc;
        if (old + 1u == (gen + 1u) * nloc) {
            __builtin_amdgcn_fence(__ATOMIC_RELEASE, "agent");
            asm volatile("s_waitcnt vmcnt(0)" ::: "memory");
            const unsigned og = xb_add(&bar[XB_TOP], 1u);
            const unsigned tg = og / nx;
            if (og + 1u == (tg + 1u) * nx) xb_add(&bar[XB_TOPGEN], 1u);
            else XB_SPIN(xb_ld(&bar[XB_TOPGEN]) == tg, bar);
            __builtin_amdgcn_fence(__ATOMIC_ACQUIRE, "agent");
            xb_add(&bar[XB_XGEN(b.x)], 1u);
            asm volatile("s_waitcnt vmcnt(0)" ::: "memory");
        } else {
            XB_SPIN(xb_ld(&bar[XB_XGEN(b.x)]) == gen, bar);
            __builtin_amdgcn_fence(__ATOMIC_ACQUIRE, "agent");
            asm volatile("s_waitcnt vmcnt(0)" ::: "memory");
        }
    }
    __syncthreads();
}


__device__ __forceinline__ void my_grid_sync(unsigned* bar, unsigned target) {
    asm volatile("s_waitcnt vmcnt(0) lgkmcnt(0)" ::: "memory");
    __syncthreads();
    if (threadIdx.x == 0) {
        __builtin_amdgcn_fence(__ATOMIC_RELEASE, "agent");
        asm volatile("s_waitcnt vmcnt(0)" ::: "memory");
        __hip_atomic_fetch_add(bar, 1u, __ATOMIC_RELAXED, __HIP_MEMORY_SCOPE_AGENT);
        while (__hip_atomic_load(bar, __ATOMIC_RELAXED, __HIP_MEMORY_SCOPE_AGENT) < target) __builtin_amdgcn_s_sleep(2);
    }
    __syncthreads();
    asm volatile("buffer_inv sc1\n\ts_waitcnt vmcnt(0)" ::: "memory");
}
__global__ void __launch_bounds__(NTHR) mk_fwd(Params p) {
    extern __shared__ __attribute__((aligned(16))) unsigned char lds_raw[];
    LAS unsigned char* lds = (LAS unsigned char*)lds_raw;
    cg::grid_group grid = cg::this_grid();
    if (threadIdx.x < 4) ((LAS unsigned*)(lds + LDS_BYTES - 16))[threadIdx.x] = 0u;
    __syncthreads();
    const XcdBarrier xb = xcd_barrier_post((unsigned*)(p.ws + OFF_BAR), (volatile LAS unsigned*)(lds + LDS_BYTES - 16));
#define GRID_SYNC() xcd_barrier(xb)
    unsigned char* ws = p.ws;
    const int G = gridDim.x, c = blockIdx.x;
    const bf16_t* A0 = (const bf16_t*)(ws + OFF_A0);

    if (p.ws == nullptr) grid.sync();
    PH(0) phase_prep(p, lds);
    GRID_SYNC();
    PH(1) {
        pg8::Sched S; S.init(A0, (const bf16_t*)(ws + OFF_WTIN), M_TOK, NPROJ, A0 + (size_t)M_TOK * 1024, (const bf16_t*)(ws + OFF_WTKV), 2048, 2048, G, c);
        EpiProj E{(const float*)(ws + OFF_SS0), p.in[10], (bf16_t*)(ws + OFF_PROJ), (float*)(ws + OFF_LOGA), p.out, (bf16_t*)(ws + OFF_KB), (bf16_t*)(ws + OFF_VTB)};
        pg8::gemm_phase(lds, 1024, S, E);
    }
    GRID_SYNC();
    PH(2) phase_scan(p, lds);
    GRID_SYNC();
    PH(3) phase_onorm(p);
    GRID_SYNC();
    PH(4) {
        pg8::Sched S; S.init((const bf16_t*)(ws + OFF_A2), (const bf16_t*)(ws + OFF_WTP), M_PR, 1024, nullptr, nullptr, 0, 0, G, c);
        EpiMerge E{(const bf16_t*)(ws + OFF_PROJ), (bf16_t*)(ws + OFF_X)};
        pg8::gemm_phase(lds, 1024, S, E);
        SmallArgs sa{(const bf16_t*)(ws + OFF_A2), (const bf16_t*)(ws + OFF_WTP), 1024, (const bf16_t*)(ws + OFF_PROJ), nullptr, (bf16_t*)(ws + OFF_X), 1024, nullptr, nullptr, 1.f};
        small_gemm<0>(sa, lds);
    }
    GRID_SYNC();
    PH(5) {
        pg8::Sched S; S.init((const bf16_t*)(ws + OFF_X), (const bf16_t*)(ws + OFF_WTO), M_PR, 1024, nullptr, nullptr, 0, 0, G, c);
        EpiResid E{A0, (bf16_t*)(ws + OFF_H1B), (float*)(ws + OFF_SSP1)};
        pg8::gemm_phase(lds, 1024, S, E);
        SmallArgs sa{(const bf16_t*)(ws + OFF_X), (const bf16_t*)(ws + OFF_WTO), 1024, nullptr, A0, (bf16_t*)(ws + OFF_H1B), 1024, (float*)(ws + OFF_SSP1), nullptr, 1.f};
        small_gemm<1>(sa, lds);
    }
    GRID_SYNC();
    PH(6) {
        pg8::Sched S; S.init((const bf16_t*)(ws + OFF_H1B), (const bf16_t*)(ws + OFF_WTXQ), M_PR, 1024, nullptr, nullptr, 0, 0, G, c);
        EpiScale E{(const float*)(ws + OFF_SSP1), (bf16_t*)(ws + OFF_Q), 1024, 0.0625f};
        pg8::gemm_phase(lds, 1024, S, E);
        SmallArgs sa{(const bf16_t*)(ws + OFF_H1B), (const bf16_t*)(ws + OFF_WTXQ), 1024, nullptr, nullptr, (bf16_t*)(ws + OFF_Q), 1024, nullptr, (const float*)(ws + OFF_SSP1), 0.0625f};
        small_gemm<2>(sa, lds);
    }
    GRID_SYNC();
    PH(7) phase_attn(p, lds);
    GRID_SYNC();
    PH(8) {
        pg8::Sched S; S.init((const bf16_t*)(ws + OFF_AO), (const bf16_t*)(ws + OFF_WTXO), M_PR, 1024, nullptr, nullptr, 0, 0, G, c);
        EpiResid E{(const bf16_t*)(ws + OFF_H1B), (bf16_t*)(ws + OFF_H2B), (float*)(ws + OFF_SSP2)};
        pg8::gemm_phase(lds, 1024, S, E);
        SmallArgs sa{(const bf16_t*)(ws + OFF_AO), (const bf16_t*)(ws + OFF_WTXO), 1024, nullptr, (const bf16_t*)(ws + OFF_H1B), (bf16_t*)(ws + OFF_H2B), 1024, (float*)(ws + OFF_SSP2), nullptr, 1.f};
        small_gemm<1>(sa, lds);
    }
    GRID_SYNC();
    PH(9) {
        pg8::Sched S; S.init((const bf16_t*)(ws + OFF_H2B), (const bf16_t*)(ws + OFF_WTPQ), M_PR, 2048, nullptr, nullptr, 0, 0, G, c);
        EpiScale E{(const float*)(ws + OFF_SSP2), (bf16_t*)(ws + OFF_PQ), 2048, 1.0f};
        pg8::gemm_phase(lds, 1024, S, E);
        SmallArgs sa{(const bf16_t*)(ws + OFF_H2B), (const bf16_t*)(ws + OFF_WTPQ), 2048, nullptr, nullptr, (bf16_t*)(ws + OFF_PQ), 2048, nullptr, (const float*)(ws + OFF_SSP2), 1.0f};
        small_gemm<2>(sa, lds);
    }
    GRID_SYNC();
    PH(10) phase_peer(p, lds);
#ifdef DUMP
    GRID_SYNC();
    {
        const size_t gt = (size_t)blockIdx.x * NTHR + threadIdx.x, ngt = (size_t)gridDim.x * NTHR;
        const bf16_t* srcb = (const bf16_t*)(ws + (DUMP == 1 ? OFF_A2 : (DUMP == 2 ? OFF_X : OFF_H1B)));
        const float* srcf = (const float*)(ws + OFF_X);
        if (DUMP == 4) { const bf16_t* pj = (const bf16_t*)(ws + OFF_PROJ); for (size_t i = gt; i < (size_t)M_TOK * 1024; i += ngt) p.out[i] = bf2f(pj[(i >> 10) * NPROJ + (i & 1023)]); }
        else if (DUMP == 5) { const bf16_t* pj = (const bf16_t*)(ws + OFF_PROJ); for (size_t i = gt; i < (size_t)M_TOK * 1024; i += ngt) p.out[i] = bf2f(pj[(i >> 10) * NPROJ + 1792 + (i & 1023)]); }
        else for (size_t i = gt; i < (size_t)M_PR * 1024; i += ngt) p.out[i] = (DUMP == 3) ? srcf[i] : bf2f(srcb[i]);
    }
#endif
}

extern "C" void kernel_launch(void* const* d_in, const int* in_sizes, int n_in, void* d_out, int out_size, void* d_ws, size_t ws_size, hipStream_t stream) {
    static int grid_blocks = 0;
    if (!grid_blocks) {
        int dev = 0, cus = 0, per_cu = 0;
        (void)hipGetDevice(&dev);
        (void)hipDeviceGetAttribute(&cus, hipDeviceAttributeMultiprocessorCount, dev);
        (void)hipFuncSetAttribute((const void*)mk_fwd, hipFuncAttributeMaxDynamicSharedMemorySize, LDS_BYTES);
        (void)hipOccupancyMaxActiveBlocksPerMultiprocessor(&per_cu, (const void*)mk_fwd, NTHR, LDS_BYTES);
        if (per_cu < 1) per_cu = 1;
        grid_blocks = cus * per_cu;
        if (ws_size < WS_END) fprintf(stderr, "kernel_launch: workspace too small (%zu < %zu)\n", ws_size, (size_t)WS_END);
    }
    Params p{};
    for (int i = 0; i < 28; ++i) p.in[i] = (const float*)d_in[i];
    p.out = (float*)d_out; p.ws = (unsigned char*)d_ws;
    (void)hipMemsetAsync((unsigned char*)d_ws + OFF_BAR, 0, 16384, stream);
    void* args[] = {&p};
    hipError_t e = hipLaunchCooperativeKernel((const void*)mk_fwd, dim3(grid_blocks), dim3(NTHR), args, LDS_BYTES, stream);
    if (e != hipSuccess) fprintf(stderr, "cooperative launch failed: %s (grid %d)\n", hipGetErrorString(e), grid_blocks);
}
```

```cpp
#include <hip/hip_runtime.h>
#include <hip/hip_cooperative_groups.h>
#include <cstdio>
namespace cg = cooperative_groups;

#define LAS __attribute__((address_space(3)))
typedef unsigned short bf16_t;
typedef short bf16x8 __attribute__((ext_vector_type(8)));
typedef float f32x4 __attribute__((ext_vector_type(4)));
typedef float f32x2 __attribute__((ext_vector_type(2)));
typedef unsigned u32x4 __attribute__((ext_vector_type(4)));
typedef unsigned u32x2 __attribute__((ext_vector_type(2)));

constexpr int NTHR = 512;
constexpr int M_TOK = 16896, M_PR = 16384, M_ALL = 18944, DM = 1024, NPROJ = 5376;
constexpr float EPS = 1e-6f;
constexpr int LDS_BYTES = 147456;

constexpr size_t OUT_Y = 0, OUT_GLAP = 17301504, OUT_RETP = 17563648, OUT_MK = 17825792, OUT_MV = 19922944, OUT_GLAS = 22020096, OUT_RETS = 26214400;

constexpr size_t al256(size_t x) { return (x + 255) & ~(size_t)255; }
constexpr size_t OFF_A0 = 0;
constexpr size_t OFF_SS0 = al256(OFF_A0 + (size_t)M_ALL * DM * 2);
constexpr size_t OFF_SS1 = al256(OFF_SS0 + (size_t)M_ALL * 4);
constexpr size_t OFF_SS2 = OFF_SS1 + (size_t)M_TOK * 4;
constexpr size_t OFF_WTIN = al256(OFF_SS2 + (size_t)M_TOK * 4);
constexpr size_t OFF_WTKV = OFF_WTIN + (size_t)NPROJ * DM * 2;
constexpr size_t OFF_WTP = OFF_WTKV + (size_t)2048 * DM * 2;
constexpr size_t OFF_WTO = OFF_WTP + (size_t)DM * DM * 2;
constexpr size_t OFF_WTXQ = OFF_WTO + (size_t)DM * DM * 2;
constexpr size_t OFF_WTXO = OFF_WTXQ + (size_t)DM * DM * 2;
constexpr size_t OFF_WTPQ = OFF_WTXO + (size_t)DM * DM * 2;
constexpr size_t OFF_SKB = OFF_WTPQ + (size_t)2048 * DM * 2;
constexpr size_t OFF_UB = OFF_SKB + (size_t)8 * 2 * 128 * 128 * 2;
constexpr size_t OFF_VB = OFF_UB + (size_t)16384 * DM;
constexpr size_t OFF_PROJ = OFF_VB + (size_t)16384 * DM;
constexpr size_t OFF_LOGA = OFF_PROJ + (size_t)M_TOK * NPROJ * 2;
constexpr size_t OFF_KB = OFF_LOGA + (size_t)M_TOK * 256 * 4;
constexpr size_t OFF_VTB = OFF_KB + (size_t)2048 * DM * 2;
constexpr size_t OFF_X = OFF_VTB + (size_t)2048 * DM * 2;
constexpr size_t OFF_A2 = OFF_X + (size_t)M_TOK * DM * 4;
constexpr size_t OFF_SSP1 = OFF_A2 + (size_t)M_TOK * DM * 2;
constexpr size_t OFF_SSP2 = OFF_SSP1 + (size_t)16 * M_TOK * 4;
constexpr size_t OFF_BAR = OFF_SSP2 + (size_t)16 * M_TOK * 4;
constexpr size_t WS_END = OFF_BAR + 16384;
constexpr size_t OFF_H1B = OFF_PROJ;
constexpr size_t OFF_Q = OFF_H1B + (size_t)M_TOK * DM * 2;
constexpr size_t OFF_AO = OFF_Q + (size_t)M_TOK * DM * 2;
constexpr size_t OFF_H2B = OFF_AO + (size_t)M_TOK * DM * 2;
constexpr size_t OFF_PQ = OFF_PROJ;

struct Params { const float* in[28]; float* out; unsigned char* ws; };
#ifndef PHMASK
#define PHMASK 0xFFFF
#endif
#define PH(k) if constexpr ((PHMASK >> (k)) & 1)

typedef __bf16 bf16v2_t __attribute__((ext_vector_type(2)));
__device__ __forceinline__ unsigned cvt_pk_bf16(float lo, float hi) { const f32x2 v = {lo, hi}; return __builtin_bit_cast(unsigned, __builtin_convertvector(v, bf16v2_t)); }
__device__ __forceinline__ float bflo(unsigned u) { return __uint_as_float(u << 16); }
__device__ __forceinline__ float bfhi(unsigned u) { return __uint_as_float(u & 0xffff0000u); }
__device__ __forceinline__ float bf2f(bf16_t b) { return __uint_as_float(((unsigned)b) << 16); }
__device__ __forceinline__ float wave_sum(float v) {
#pragma unroll
    for (int o = 32; o > 0; o >>= 1) v += __shfl_xor(v, o);
    return v;
}
__device__ __forceinline__ float sigmoidf_(float v) { return __builtin_amdgcn_rcpf(1.0f + __expf(-v)); }

namespace pg8 {
constexpr int BM = 256, BK = 64, HALF = 128, HTB = HALF * BK * 2, STAGE_BYTES = 8 * HTB, NXCD = 8, WGM = 8;
__device__ __forceinline__ int lds_byte(int r, int c) { const int st = (r >> 4) * 2 + (c >> 5), rr = r & 15, cc = c & 31, ob = rr * 64 + cc * 2; return st * 1024 + (ob ^ (((ob >> 9) & 1) << 5)); }
__device__ __forceinline__ void stage_rc(int b, int& R, int& C) { const int st = b / 1024, sb = b % 1024, swz = sb ^ (((sb >> 9) & 1) << 5); R = (st >> 1) * 16 + swz / 64; C = (st & 1) * 32 + (swz % 64) / 2; }

struct Unit { int pm, pn, job; };
struct Sched {
    const bf16_t* A0; const bf16_t* B0; const bf16_t* A1; const bf16_t* B1;
    int nM0, nN0, n0, nM1, nN1, n1, G, c;
    __device__ __forceinline__ void init(const bf16_t* a0, const bf16_t* b0, int M0, int N0, const bf16_t* a1, const bf16_t* b1, int M1, int N1, int G_, int c_) {
        A0 = a0; B0 = b0; A1 = a1; B1 = b1; nM0 = M0 / BM; nN0 = N0 / BM; n0 = nM0 * nN0; nM1 = M1 / BM; nN1 = N1 / BM; n1 = nM1 * nN1; G = G_; c = c_; }
    __device__ __forceinline__ void map(int wgid, int nwg, int nM, int nN, Unit& u) const {
        { const int q = nwg / NXCD, r = nwg % NXCD, xcd = wgid % NXCD, off = wgid / NXCD; wgid = (xcd < r ? xcd * (q + 1) : r * (q + 1) + (xcd - r) * q) + off; }
        const int nig = WGM * nN, gid = wgid / nig, fm = gid * WGM, gsz = (nM - fm) < WGM ? (nM - fm) : WGM;
        u.pm = fm + ((wgid % nig) % gsz); u.pn = (wgid % nig) / gsz;
    }
    __device__ __forceinline__ bool next(int i, Unit& u) const {
        int L = i * G + c;
        if (L < n0) { map(L, n0, nM0, nN0, u); u.job = 0; return true; }
        L -= n0;
        if (L < n1) { map(L, n1, nM1, nN1, u); u.job = 1; return true; }
        return false;
    }
    __device__ __forceinline__ const char* aptr(const Unit& u, size_t tstep) const { return (const char*)(u.job ? A1 : A0) + (size_t)u.pm * tstep; }
    __device__ __forceinline__ const char* bptr(const Unit& u, size_t tstep) const { return (const char*)(u.job ? B1 : B0) + (size_t)u.pn * tstep; }
};

template <class Epi>
__device__ __forceinline__ void gemm_phase(LAS unsigned char* lds, const int K, const Sched& S, const Epi& E) {
    int tid_ = threadIdx.x; asm volatile("" : "+v"(tid_)); const int tid = tid_, wid = __builtin_amdgcn_readfirstlane(tid >> 6), lane = tid & 63, wr = wid >> 2, wc = wid & 3, fr = lane & 15, fq = lane >> 4;
    const int nt = K / BK;
    unsigned voffA[2], voffB[2];
#pragma unroll
    for (int i = 0; i < 2; ++i) { int R, C; stage_rc(tid * 16 + i * 8192, R, C); voffA[i] = (unsigned)(R * K + C) * 2u;
        { const int rho = R & 31, pn_ = rho >> 4, pi_ = rho & 15, Rb = (R & ~31) + 8 * (pi_ >> 2) + 4 * pn_ + (pi_ & 3); voffB[i] = (unsigned)(Rb * K + C) * 2u; } }
    const size_t kstep = (size_t)(BK * 2);
    const size_t hstep = (size_t)HALF * K * 2;
    const size_t tstep = 2 * hstep;
    const unsigned ldsw = (unsigned)wid * 1024u;
    const int aoff = lds_byte(wr * 64 + fr, fq * 8), boff = lds_byte(wc * 32 + fr, fq * 8);
#define PG8_SA(b, h) (((b) * 2 + (h)) * HTB)
#define PG8_SB(b, h) ((4 + (b) * 2 + (h)) * HTB)
#define PG8_STAGE(bufoff, gbase) do { _Pragma("unroll") for (int _i = 0; _i < 2; ++_i) \
        __builtin_amdgcn_global_load_lds((const unsigned*)((const char*)(gbase) + (((bufoff) >= 4 * HTB) ? voffB[_i] : voffA[_i])), (LAS unsigned*)(lds + (bufoff) + ldsw + _i * 8192), 16, 0, 0); } while (0)
#define PG8_LDA(dst, b, h) do { _Pragma("unroll") for (int m = 0; m < 4; ++m) _Pragma("unroll") for (int k = 0; k < 2; ++k) dst[m][k] = *(const LAS bf16x8*)(lds + PG8_SA(b, h) + aoff + m * 2048 + k * 1024); } while (0)
#define PG8_LDB(dst, b, h) do { _Pragma("unroll") for (int n = 0; n < 2; ++n) _Pragma("unroll") for (int k = 0; k < 2; ++k) dst[n][k] = *(const LAS bf16x8*)(lds + PG8_SB(b, h) + boff + n * 2048 + k * 1024); } while (0)
#define PG8_MMA(ai, bj, At, Bt) do { __builtin_amdgcn_s_setprio(1); _Pragma("unroll") for (int m = 0; m < 4; ++m) _Pragma("unroll") for (int n = 0; n < 2; ++n) _Pragma("unroll") for (int k = 0; k < 2; ++k) \
        acc[ai][bj][m][n] = __builtin_amdgcn_mfma_f32_16x16x32_bf16(Bt[n][k], At[m][k], acc[ai][bj][m][n], 0, 0, 0); __builtin_amdgcn_s_setprio(0); } while (0)
#define PG8_WAIT_V(n) asm volatile("s_waitcnt vmcnt(" #n ")" ::: "memory")
#define PG8_WAIT_L(n) asm volatile("s_waitcnt lgkmcnt(" #n ")" ::: "memory")
#define PG8_BAR __builtin_amdgcn_s_barrier()
#define PG8_SCHED __builtin_amdgcn_sched_barrier(0)
    Unit cur, nxt; int ui = 0;
    if (!S.next(0, cur)) return;
    f32x4 acc[2][2][4][2];
#pragma unroll
    for (int a = 0; a < 2; ++a)
#pragma unroll
        for (int b = 0; b < 2; ++b)
#pragma unroll
            for (int m = 0; m < 4; ++m)
#pragma unroll
                for (int n = 0; n < 2; ++n) acc[a][b][m][n] = (f32x4){0.f, 0.f, 0.f, 0.f};
    bf16x8 At[4][2], B0[2][2], B1[2][2];
    const char* cA = S.aptr(cur, tstep); const char* cB = S.bptr(cur, tstep);
    PG8_STAGE(PG8_SB(0, 0), cB); PG8_STAGE(PG8_SA(0, 0), cA); PG8_STAGE(PG8_SB(0, 1), cB + hstep); PG8_STAGE(PG8_SA(0, 1), cA + hstep);
    if (wr == 1) PG8_BAR;
    PG8_WAIT_V(4); PG8_BAR;
    PG8_STAGE(PG8_SB(1, 0), cB + kstep); PG8_STAGE(PG8_SA(1, 0), cA + kstep); PG8_STAGE(PG8_SB(1, 1), cB + hstep + kstep);
    PG8_WAIT_V(6); PG8_BAR;
    for (;;) {
        const bool has_next = S.next(ui + 1, nxt);
        const char* nA = has_next ? S.aptr(nxt, tstep) : cA; const char* nB = has_next ? S.bptr(nxt, tstep) : cB;
        for (int hf = 0; hf < (Epi::HAS_MID ? 2 : 1); ++hf) {
        const int t_lo = Epi::HAS_MID ? hf * (nt / 2) : 0, t_hi = Epi::HAS_MID ? (hf + 1) * (nt / 2) : nt;
        if constexpr (Epi::HAS_MID) { if (hf == 1) { E.mid(acc, cur, wr, wc, fr, fq); PG8_SCHED; } }
#pragma unroll 1
        for (int t = t_lo; t < t_hi; t += 2) {
            const bool last = (t == nt - 2);
            const char* a1 = cA + (size_t)(t + 1) * kstep;
            const char* a2 = last ? nA : cA + (size_t)(t + 2) * kstep; const char* b2 = last ? nB : cB + (size_t)(t + 2) * kstep;
            const char* a3 = a2 + kstep; const char* b3 = b2 + kstep;
            PG8_LDB(B0, 0, 0); PG8_SCHED; PG8_LDA(At, 0, 0); PG8_STAGE(PG8_SA(1, 1), a1 + hstep);
            PG8_WAIT_L(8); PG8_BAR; PG8_WAIT_L(0); PG8_MMA(0, 0, At, B0); PG8_BAR; PG8_SCHED;
            PG8_LDB(B1, 0, 1); PG8_STAGE(PG8_SB(0, 0), b2);
            PG8_BAR; PG8_WAIT_L(0); PG8_MMA(0, 1, At, B1); PG8_BAR;
            PG8_LDA(At, 0, 1); PG8_STAGE(PG8_SA(0, 0), a2);
            PG8_BAR; PG8_WAIT_L(0); PG8_MMA(1, 0, At, B0); PG8_BAR; PG8_SCHED;
            PG8_STAGE(PG8_SB(0, 1), b2 + hstep);
            PG8_WAIT_V(6); PG8_BAR; PG8_MMA(1, 1, At, B1); PG8_BAR;
            PG8_LDB(B0, 1, 0); PG8_SCHED; PG8_LDA(At, 1, 0); PG8_STAGE(PG8_SA(0, 1), a2 + hstep);
            PG8_WAIT_L(8); PG8_BAR; PG8_WAIT_L(0); PG8_MMA(0, 0, At, B0); PG8_BAR; PG8_SCHED;
            PG8_LDB(B1, 1, 1); PG8_STAGE(PG8_SB(1, 0), b3);
            PG8_BAR; PG8_WAIT_L(0); PG8_MMA(0, 1, At, B1); PG8_BAR;
            PG8_LDA(At, 1, 1); PG8_STAGE(PG8_SA(1, 0), a3);
            PG8_BAR; PG8_WAIT_L(0); PG8_MMA(1, 0, At, B0); PG8_BAR; PG8_SCHED;
            PG8_STAGE(PG8_SB(1, 1), b3 + hstep);
            PG8_WAIT_V(6); PG8_BAR; PG8_MMA(1, 1, At, B1); PG8_BAR;
        }
        }
        E(acc, cur, wr, wc, fr, fq);
        if (!has_next) break;
#pragma unroll
        for (int a = 0; a < 2; ++a)
#pragma unroll
            for (int b = 0; b < 2; ++b)
#pragma unroll
                for (int m = 0; m < 4; ++m)
#pragma unroll
                    for (int n = 0; n < 2; ++n) acc[a][b][m][n] = (f32x4){0.f, 0.f, 0.f, 0.f};
        cur = nxt; cA = nA; cB = nB; ++ui;
    }
    PG8_WAIT_V(0);
    if (wr == 0) PG8_BAR;
    PG8_BAR;
#undef PG8_SA
#undef PG8_SB
#undef PG8_STAGE
#undef PG8_LDA
#undef PG8_LDB
#undef PG8_MMA
#undef PG8_WAIT_V
#undef PG8_WAIT_L
#undef PG8_BAR
#undef PG8_SCHED
}
}

typedef f32x4 AccT[2][2][4][2];
#define EPI_LOOP_ROWS for (int ai = 0; ai < 2; ++ai) _Pragma("unroll") for (int m = 0; m < 4; ++m)
#define EPI_LOOP_COLS for (int bj = 0; bj < 2; ++bj) _Pragma("unroll") for (int n = 0; n < 2; ++n)

struct EpiProj {
    static constexpr bool HAS_MID = false;
    const float* ss0; const float* b_a; bf16_t* proj; float* loga; float* out; bf16_t* kb; bf16_t* vtb;
    __device__ __forceinline__ void operator()(const AccT& acc, const pg8::Unit& u, int wr, int wc, int fr, int fq) const {
        const int row0 = u.pm * 256 + wr * 64 + fr, col0 = u.pn * 256 + wc * 32 + 8 * fq;
        if (u.job == 0) {
            const int pn = u.pn;
            const int kind = (pn == 4) ? 3 : ((pn == 5 || pn == 6 || pn == 11 || pn == 12) ? 1 : (pn >= 13 ? 2 : 0));
            const float sc = (pn == 0 || pn == 8) ? 0.125f : 1.0f;
            float rsv[2][4];
#pragma unroll
            EPI_LOOP_ROWS rsv[ai][m] = ss0[row0 + ai * 128 + m * 16];
#pragma unroll
            EPI_LOOP_ROWS {
                const int row = row0 + ai * 128 + m * 16;
                const float rs = rsqrtf(rsv[ai][m] * (1.0f / 1024.0f) + EPS) * sc;
                u32x2 wp = (u32x2){0u, 0u};
#pragma unroll
                EPI_LOOP_COLS {
                    const int col = col0 + bj * 128 + n * 4;
                    f32x4 v = acc[ai][bj][m][n] * rs;
                    if (kind == 3) {
                        const f32x4 bb = *(const f32x4*)(b_a + (col - 1024));
                        f32x4 o;
#pragma unroll
                        for (int j = 0; j < 4; ++j) { const float z = v[j] + bb[j]; o[j] = (fminf(z, 0.f) - __logf(1.0f + __expf(-fabsf(z)))) * (1.0f / 16.0f); }
                        *(f32x4*)(loga + (size_t)row * 256 + (col - 1024)) = o;
                    } else {
                        if (kind == 1) {
#pragma unroll
                            for (int j = 0; j < 4; ++j) v[j] = v[j] * sigmoidf_(v[j]);
                        } else if (kind == 2) {
#pragma unroll
                            for (int j = 0; j < 4; ++j) v[j] = sigmoidf_(v[j]);
                        }
                        u32x2 w; w.x = cvt_pk_bf16(v[0], v[1]); w.y = cvt_pk_bf16(v[2], v[3]);
                        if (n == 0) wp = w; else { u32x4 W_; W_.x = wp.x; W_.y = wp.y; W_.z = w.x; W_.w = w.y; *(u32x4*)(proj + (size_t)row * NPROJ + col - 4) = W_; }
                    }
                }
            }
        } else {
            float rsv[2][4];
#pragma unroll
            EPI_LOOP_ROWS rsv[ai][m] = ss0[M_TOK + row0 + ai * 128 + m * 16];
#pragma unroll
            EPI_LOOP_ROWS {
                const int row = row0 + ai * 128 + m * 16;
                const float rs = rsqrtf(rsv[ai][m] * (1.0f / 1024.0f) + EPS);
#pragma unroll
                EPI_LOOP_COLS {
                    const int col = col0 + bj * 128 + n * 4;
                    const f32x4 v = acc[ai][bj][m][n] * rs;
                    if (col < 1024) {
                        *(f32x4*)(out + OUT_MK + (size_t)row * 1024 + col) = v;
                        u32x2 w; w.x = cvt_pk_bf16(v[0], v[1]); w.y = cvt_pk_bf16(v[2], v[3]);
                        *(u32x2*)(kb + (size_t)row * 1024 + col) = w;
                    } else {
                        const int c = col - 1024;
                        *(f32x4*)(out + OUT_MV + (size_t)row * 1024 + c) = v;
                        const int b = row >> 8, mem = row & 255;
                        const unsigned w0 = cvt_pk_bf16(v[0], v[1]), w1 = cvt_pk_bf16(v[2], v[3]);
                        bf16_t* vt = vtb + ((size_t)b * 1024 + c) * 256 + mem;
                        vt[0] = (bf16_t)(w0 & 0xffff); vt[256] = (bf16_t)(w0 >> 16); vt[512] = (bf16_t)(w1 & 0xffff); vt[768] = (bf16_t)(w1 >> 16);
                    }
                }
            }
        }
    }
};

struct EpiMerge {
    static constexpr bool HAS_MID = true;
    const bf16_t* proj; bf16_t* mrg;
    __device__ __forceinline__ void mid(AccT& acc, const pg8::Unit& u, int wr, int wc, int fr, int fq) const {
        const int row0 = u.pm * 256 + wr * 64 + fr, col0 = u.pn * 256 + wc * 32 + 8 * fq;
#pragma unroll
        for (int ai = 0; ai < 2; ++ai) {
            u32x2 a[4][2][2], b[4][2][2];
#pragma unroll
            for (int m = 0; m < 4; ++m) {
                unsigned roff = (unsigned)(row0 + ai * 128 + m * 16) * (unsigned)NPROJ + (unsigned)col0;
                asm volatile("" : "+v"(roff));
                const bf16_t* rp = proj + roff;
#pragma unroll
                for (int bj = 0; bj < 2; ++bj) { const u32x4 ta_ = *(const u32x4*)(rp + 3328 + bj * 128), tb_ = *(const u32x4*)(rp + 4352 + bj * 128);
                    a[m][bj][0] = (u32x2){ta_.x, ta_.y}; a[m][bj][1] = (u32x2){ta_.z, ta_.w}; b[m][bj][0] = (u32x2){tb_.x, tb_.y}; b[m][bj][1] = (u32x2){tb_.z, tb_.w}; }
            }
#pragma unroll
            for (int m = 0; m < 4; ++m) {
#pragma unroll
                EPI_LOOP_COLS {
                    const u32x2 av = a[m][bj][n], bv = b[m][bj][n];
                    f32x4 r;
                    r[0] = bflo(av.x) * __builtin_amdgcn_rcpf(bflo(bv.x)); r[1] = bfhi(av.x) * __builtin_amdgcn_rcpf(bfhi(bv.x));
                    r[2] = bflo(av.y) * __builtin_amdgcn_rcpf(bflo(bv.y)); r[3] = bfhi(av.y) * __builtin_amdgcn_rcpf(bfhi(bv.y));
                    acc[ai][bj][m][n] *= r;
                }
                asm volatile("" : "+v"(acc[ai][0][m][0]), "+v"(acc[ai][0][m][1]), "+v"(acc[ai][1][m][0]), "+v"(acc[ai][1][m][1]) :: "memory");
            }
        }
    }
    __device__ __forceinline__ void operator()(const AccT& acc, const pg8::Unit& u, int wr, int wc, int fr, int fq) const {
        const int row0 = u.pm * 256 + wr * 64 + fr, col0 = u.pn * 256 + wc * 32 + 8 * fq;
        u32x2 b[2][4][2][2];
#pragma unroll
        EPI_LOOP_ROWS {
            const bf16_t* rp = proj + (size_t)(row0 + ai * 128 + m * 16) * NPROJ + 4352 + col0;
#pragma unroll
            for (int bj = 0; bj < 2; ++bj) { const u32x4 t_ = *(const u32x4*)(rp + bj * 128); b[ai][m][bj][0] = (u32x2){t_.x, t_.y}; b[ai][m][bj][1] = (u32x2){t_.z, t_.w}; }
        }
#pragma unroll
        EPI_LOOP_ROWS {
            const int row = row0 + ai * 128 + m * 16;
            u32x2 wp = (u32x2){0u, 0u};
#pragma unroll
            EPI_LOOP_COLS {
                const int col = col0 + bj * 128 + n * 4;
                const u32x2 bv = b[ai][m][bj][n];
                const f32x4 v = acc[ai][bj][m][n];
                u32x2 w; w.x = cvt_pk_bf16(v[0] * bflo(bv.x), v[1] * bfhi(bv.x)); w.y = cvt_pk_bf16(v[2] * bflo(bv.y), v[3] * bfhi(bv.y));
                if (n == 0) wp = w; else { u32x4 W_; W_.x = wp.x; W_.y = wp.y; W_.z = w.x; W_.w = w.y; *(u32x4*)(mrg + (size_t)row * 1024 + col - 4) = W_; }
            }
        }
    }
};

struct EpiResid {
    static constexpr bool HAS_MID = false;
    const bf16_t* base; bf16_t* HB; float* SS;
    __device__ __forceinline__ void operator()(const AccT& acc, const pg8::Unit& u, int wr, int wc, int fr, int fq) const {
        const int row0 = u.pm * 256 + wr * 64 + fr, col0 = u.pn * 256 + wc * 32 + 8 * fq;
        u32x2 bv[2][4][2][2];
#pragma unroll
        EPI_LOOP_ROWS {
            const bf16_t* rp = base + (size_t)(row0 + ai * 128 + m * 16) * 1024 + col0;
#pragma unroll
            for (int bj = 0; bj < 2; ++bj) { const u32x4 t_ = *(const u32x4*)(rp + bj * 128); bv[ai][m][bj][0] = (u32x2){t_.x, t_.y}; bv[ai][m][bj][1] = (u32x2){t_.z, t_.w}; }
        }
#pragma unroll
        EPI_LOOP_ROWS {
            const int row = row0 + ai * 128 + m * 16;
            float s = 0.f; u32x2 wp = (u32x2){0u, 0u};
#pragma unroll
            EPI_LOOP_COLS {
                const int col = col0 + bj * 128 + n * 4;
                const u32x2 b = bv[ai][m][bj][n];
                f32x4 v = acc[ai][bj][m][n];
                v[0] += bflo(b.x); v[1] += bfhi(b.x); v[2] += bflo(b.y); v[3] += bfhi(b.y);
                s += (v[0] * v[0] + v[1] * v[1]) + (v[2] * v[2] + v[3] * v[3]);
                u32x2 w; w.x = cvt_pk_bf16(v[0], v[1]); w.y = cvt_pk_bf16(v[2], v[3]);
                if (n == 0) wp = w; else { u32x4 W_; W_.x = wp.x; W_.y = wp.y; W_.z = w.x; W_.w = w.y; *(u32x4*)(HB + (size_t)row * 1024 + col - 4) = W_; }
            }
            s += __shfl_xor(s, 16); s += __shfl_xor(s, 32);
            if (fq == 0) SS[(size_t)(u.pn * 4 + wc) * M_TOK + row] = s;
        }
    }
};

struct EpiScale {
    static constexpr bool HAS_MID = false;
    const float* SS; bf16_t* O; int ldo; float sc;
    __device__ __forceinline__ void operator()(const AccT& acc, const pg8::Unit& u, int wr, int wc, int fr, int fq) const {
        const int row0 = u.pm * 256 + wr * 64 + fr, col0 = u.pn * 256 + wc * 32 + 8 * fq;
        float part[2][4];
#pragma unroll
        EPI_LOOP_ROWS {
            const int row = row0 + ai * 128 + m * 16;
            float t = 0.f;
#pragma unroll
            for (int q = 0; q < 4; ++q) t += SS[(size_t)(fq * 4 + q) * M_TOK + row];
            part[ai][m] = t;
        }
#pragma unroll
        EPI_LOOP_ROWS {
            const int row = row0 + ai * 128 + m * 16;
            float ssum = part[ai][m];
            ssum += __shfl_xor(ssum, 16); ssum += __shfl_xor(ssum, 32);
            const float rs = rsqrtf(ssum * (1.0f / 1024.0f) + EPS) * sc;
            u32x2 wp = (u32x2){0u, 0u};
#pragma unroll
            EPI_LOOP_COLS {
                const int col = col0 + bj * 128 + n * 4;
                const f32x4 v = acc[ai][bj][m][n] * rs;
                u32x2 w; w.x = cvt_pk_bf16(v[0], v[1]); w.y = cvt_pk_bf16(v[2], v[3]);
                if (n == 0) wp = w; else { u32x4 W_; W_.x = wp.x; W_.y = wp.y; W_.z = w.x; W_.w = w.y; *(u32x4*)(O + (size_t)row * ldo + col - 4) = W_; }
            }
        }
    }
};

struct TJob { const float* src; int ld, c0, tn, K; bf16_t* dst; int Kd, kofs; const float* gain; };
__device__ __forceinline__ void tjob_get(const Params& p, int T, TJob& j, int& tile) {
    unsigned char* ws = p.ws;
    if (T < 256) { j = TJob{p.in[8], 5136, 0, 16, 1024, (bf16_t*)(ws + OFF_WTIN), 1024, 0, p.in[7]}; tile = T; return; }
    T -= 256;
    if (T < 1024) { j = TJob{p.in[8], 5136, 1040, 64, 1024, (bf16_t*)(ws + OFF_WTIN) + (size_t)1280 * 1024, 1024, 0, p.in[7]}; tile = T; return; }
    T -= 1024;
    if (T < 128) { j = TJob{p.in[13], 1024, 0, 16, 512, (bf16_t*)(ws + OFF_WTP), 1024, 0, nullptr}; tile = T; return; }
    T -= 128;
    if (T < 128) { j = TJob{p.in[14], 1024, 0, 16, 512, (bf16_t*)(ws + OFF_WTP), 1024, 512, nullptr}; tile = T; return; }
    T -= 128;
    if (T < 256) { j = TJob{p.in[15], 1024, 0, 16, 1024, (bf16_t*)(ws + OFF_WTO), 1024, 0, nullptr}; tile = T; return; }
    T -= 256;
    if (T < 256) { j = TJob{p.in[18], 1024, 0, 16, 1024, (bf16_t*)(ws + OFF_WTXQ), 1024, 0, p.in[16]}; tile = T; return; }
    T -= 256;
    if (T < 256) { j = TJob{p.in[19], 1024, 0, 16, 1024, (bf16_t*)(ws + OFF_WTKV), 1024, 0, p.in[17]}; tile = T; return; }
    T -= 256;
    if (T < 256) { j = TJob{p.in[20], 1024, 0, 16, 1024, (bf16_t*)(ws + OFF_WTKV) + (size_t)1024 * 1024, 1024, 0, p.in[17]}; tile = T; return; }
    T -= 256;
    if (T < 256) { j = TJob{p.in[21], 1024, 0, 16, 1024, (bf16_t*)(ws + OFF_WTXO), 1024, 0, nullptr}; tile = T; return; }
    T -= 256;
    j = TJob{p.in[23], 2048, 0, 32, 1024, (bf16_t*)(ws + OFF_WTPQ), 1024, 0, p.in[22]}; tile = T;
}
constexpr int N_TTILES = 256 + 1024 + 128 + 128 + 256 * 5 + 512;

__device__ void phase_prep(const Params& p, LAS unsigned char* lds) {
    int tid_ = threadIdx.x; asm volatile("" : "+v"(tid_)); const int tid = tid_, lane = tid & 63, wid = tid >> 6;
    const int gw = blockIdx.x * 8 + wid, nw = gridDim.x * 8;
    const size_t gt = (size_t)blockIdx.x * NTHR + tid, ngt = (size_t)gridDim.x * NTHR;
    unsigned char* ws = p.ws;
    {
        bf16_t* A0 = (bf16_t*)(ws + OFF_A0); float* ss0 = (float*)(ws + OFF_SS0);
        for (int r = gw; r < M_ALL; r += nw) {
            const float* src = r < M_PR ? p.in[0] + (size_t)r * 1024 : (r < M_TOK ? p.in[1] + (size_t)(r - M_PR) * 1024 : p.in[2] + (size_t)(r - M_TOK) * 1024);
            float s = 0.f;
#pragma unroll
            for (int i = 0; i < 4; ++i) {
                const f32x4 v = *(const f32x4*)(src + i * 256 + lane * 4);
                s += (v[0] * v[0] + v[1] * v[1]) + (v[2] * v[2] + v[3] * v[3]);
                u32x2 w; w.x = cvt_pk_bf16(v[0], v[1]); w.y = cvt_pk_bf16(v[2], v[3]);
                *(u32x2*)(A0 + (size_t)r * 1024 + i * 256 + lane * 4) = w;
            }
            s = wave_sum(s);
            if (lane == 0) ss0[r] = s;
        }
    }
    { float* z = (float*)(ws + OFF_SS1); for (size_t i = gt; i < (size_t)2 * M_TOK; i += ngt) z[i] = 0.f; }
    {
        const size_t n_sk = (size_t)8 * 2 * 128 * 128 / 8;
        for (size_t k = gt; k < n_sk; k += ngt) {
            const float* src = p.in[24]; bf16_t* dst = (bf16_t*)(ws + OFF_SKB);
            const f32x4 a = *(const f32x4*)(src + k * 8), b = *(const f32x4*)(src + k * 8 + 4);
            u32x4 w; w.x = cvt_pk_bf16(a[0], a[1]); w.y = cvt_pk_bf16(a[2], a[3]); w.z = cvt_pk_bf16(b[0], b[1]); w.w = cvt_pk_bf16(b[2], b[3]);
            *(u32x4*)(dst + k * 8) = w;
        }
        const size_t n_u = (size_t)16384 * 1024 / 16;
        for (size_t i = gt; i < 2 * n_u; i += ngt) {
            const bool isv = i >= n_u; const size_t k = isv ? i - n_u : i;
            const float* src = (isv ? p.in[26] : p.in[25]) + k * 16; unsigned char* dst = ws + (isv ? OFF_VB : OFF_UB) + k * 16;
            const float sc = isv ? 64.0f : 1024.0f;
            u32x4 w;
#pragma unroll
            for (int q = 0; q < 4; ++q) {
                f32x4 a = *(const f32x4*)(src + q * 4) * sc;
#pragma unroll
                for (int e = 0; e < 4; ++e) a[e] = fminf(fmaxf(a[e], -448.0f), 448.0f);
                int t = 0;
                t = __builtin_amdgcn_cvt_pk_fp8_f32(a[0], a[1], t, false);
                t = __builtin_amdgcn_cvt_pk_fp8_f32(a[2], a[3], t, true);
                w[q] = (unsigned)t;
            }
            *(u32x4*)dst = w;
        }
    }
    {
        const float* w_in = p.in[8]; const float* w_a2 = p.in[9]; const float* g = p.in[7];
        bf16_t* dst = (bf16_t*)(ws + OFF_WTIN) + (size_t)1024 * 1024;
        for (size_t i = gt; i < (size_t)256 * 128; i += ngt) {
            const int j = (int)(i >> 7), k0 = (int)(i & 127) * 8;
            float wa[16];
#pragma unroll
            for (int r = 0; r < 16; ++r) wa[r] = w_a2[r * 256 + j];
            float o[8];
#pragma unroll
            for (int e = 0; e < 8; ++e) {
                const float* wr_ = w_in + (size_t)(k0 + e) * 5136 + 1024;
                float s = 0.f;
#pragma unroll
                for (int r4 = 0; r4 < 4; ++r4) { const f32x4 v = *(const f32x4*)(wr_ + r4 * 4); s += v[0] * wa[r4 * 4] + v[1] * wa[r4 * 4 + 1] + v[2] * wa[r4 * 4 + 2] + v[3] * wa[r4 * 4 + 3]; }
                o[e] = s * g[k0 + e];
            }
            u32x4 w; w.x = cvt_pk_bf16(o[0], o[1]); w.y = cvt_pk_bf16(o[2], o[3]); w.z = cvt_pk_bf16(o[4], o[5]); w.w = cvt_pk_bf16(o[6], o[7]);
            *(u32x4*)(dst + (size_t)j * 1024 + k0) = w;
        }
    }
    {
        LAS float* tl = (LAS float*)lds;
        for (int T = blockIdx.x; T < N_TTILES; T += gridDim.x) {
            TJob j; int tile; tjob_get(p, T, j, tile);
            const int tk = tile / j.tn, tnn = tile % j.tn, k0 = tk * 64, n0 = tnn * 64;
            {
                const int kr = tid >> 4, nc = (tid & 15) * 4;
#pragma unroll
                for (int pp = 0; pp < 2; ++pp) {
                    const int k = k0 + kr + 32 * pp;
                    f32x4 v = *(const f32x4*)(j.src + (size_t)k * j.ld + j.c0 + n0 + nc);
                    if (j.gain) v *= j.gain[k];
                    LAS float* d = tl + (kr + 32 * pp) * 65 + nc;
                    d[0] = v[0]; d[1] = v[1]; d[2] = v[2]; d[3] = v[3];
                }
            }
            __syncthreads();
            {
                const int n = tid >> 3, kq = (tid & 7) * 8;
                float o[8];
#pragma unroll
                for (int e = 0; e < 8; ++e) o[e] = tl[(kq + e) * 65 + n];
                u32x4 w; w.x = cvt_pk_bf16(o[0], o[1]); w.y = cvt_pk_bf16(o[2], o[3]); w.z = cvt_pk_bf16(o[4], o[5]); w.w = cvt_pk_bf16(o[6], o[7]);
                *(u32x4*)(j.dst + (size_t)(n0 + n) * j.Kd + j.kofs + k0 + kq) = w;
            }
            __syncthreads();
        }
    }
}

#define MFMA16(a, b, c) __builtin_amdgcn_mfma_f32_16x16x32_bf16((a), (b), (c), 0, 0, 0)
__device__ __forceinline__ float scan64(float v, int lane) {
#pragma unroll
    for (int o = 1; o < 64; o <<= 1) { const float t = __shfl_up(v, o); if (lane >= o) v += t; }
    return v;
}
__device__ void phase_scan(const Params& p, LAS unsigned char* lds) {
    int tid_ = threadIdx.x; asm volatile("" : "+v"(tid_)); const int tid = tid_, lane = tid & 63, wid = tid >> 6, fr = lane & 15, fq = lane >> 4;
    const bf16_t* proj = (const bf16_t*)(p.ws + OFF_PROJ); const float* loga = (const float*)(p.ws + OFF_LOGA);
    float* omix = (float*)(p.ws + OFF_X);
    constexpr int P = 72;
    for (int u = blockIdx.x; u < 256; u += gridDim.x) {
        const int vs = u & 3, mx = (u >> 2) & 1, h = (u >> 3) & 3, b = u >> 5;
        const int qoff = (mx ? 1792 : 0) + h * 64, koff = (mx ? 2048 : 256) + h * 64, voff = (mx ? 2304 : 512) + h * 128 + vs * 32;
        const float lg = log1pf(-exp2f(-5.0f - (float)h));
        float inv[4];
#pragma unroll
        for (int e = 0; e < 4; ++e) inv[e] = exp2f(-(float)(4 * wid + e) * (13.287712379549449f / 32.0f));
        f32x4 sacc = (f32x4){0.f, 0.f, 0.f, 0.f};
        LAS bf16_t* QE = (LAS bf16_t*)lds; LAS bf16_t* KE = (LAS bf16_t*)(lds + 9216);
        LAS bf16_t* ATT = (LAS bf16_t*)(lds + 18432);
        LAS bf16_t* ST = (LAS bf16_t*)(lds + 27648);
        for (int i = tid; i < 32 * P; i += NTHR) ST[i] = 0;
        const int ct = wid >> 2, w4 = wid & 3;
        u32x2 rq0, rq1, rk0, rk1, rv; f32x4 rl0 = (f32x4){0.f, 0.f, 0.f, 0.f}, rl1 = rl0;
        u32x4 gq, gk, gv = (u32x4){0u, 0u, 0u, 0u}; f32x4 gl0 = (f32x4){0.f, 0.f, 0.f, 0.f}, gl1 = gl0;
#define SCAN_RAW(bi) (lds + 61440 + (bi) * 40960)
#define SCAN_STAGE_LOAD(ch) do { const size_t tb_ = (size_t)b * 2048 + (ch) * 64; \
            gq = *(const u32x4*)(proj + (tb_ + (tid >> 3)) * NPROJ + qoff + (tid & 7) * 8); gk = *(const u32x4*)(proj + (tb_ + (tid >> 3)) * NPROJ + koff + (tid & 7) * 8); \
            if (tid < 256) gv = *(const u32x4*)(proj + (tb_ + (tid >> 2)) * NPROJ + voff + (tid & 3) * 8); \
            if (!mx) { gl0 = *(const f32x4*)(loga + (tb_ + (tid >> 4)) * 256 + h * 64 + (tid & 15) * 4); gl1 = *(const f32x4*)(loga + (tb_ + 32 + (tid >> 4)) * 256 + h * 64 + (tid & 15) * 4); } } while (0)
#define SCAN_STAGE_WRITE(bi) do { LAS unsigned char* r_ = SCAN_RAW(bi); \
            *(LAS u32x4*)(r_ + (tid >> 3) * 144 + (tid & 7) * 16) = gq; *(LAS u32x4*)(r_ + 9216 + (tid >> 3) * 144 + (tid & 7) * 16) = gk; \
            if (tid < 256) *(LAS u32x4*)(r_ + 18432 + (tid >> 2) * 80 + (tid & 3) * 16) = gv; \
            if (!mx) { *(LAS f32x4*)(r_ + 23552 + (tid >> 4) * 272 + (tid & 15) * 16) = gl0; *(LAS f32x4*)(r_ + 23552 + (32 + (tid >> 4)) * 272 + (tid & 15) * 16) = gl1; } } while (0)
#define SCAN_READ_RAW(bi) do { const LAS unsigned char* r_ = SCAN_RAW(bi); \
            rq0 = *(const LAS u32x2*)(r_ + lane * 144 + 8 * wid); rq1 = *(const LAS u32x2*)(r_ + lane * 144 + 64 + 8 * wid); \
            rk0 = *(const LAS u32x2*)(r_ + 9216 + lane * 144 + 8 * wid); rk1 = *(const LAS u32x2*)(r_ + 9216 + lane * 144 + 64 + 8 * wid); \
            rv = *(const LAS u32x2*)(r_ + 18432 + lane * 80 + 8 * wid); \
            if (!mx) { rl0 = *(const LAS f32x4*)(r_ + 23552 + lane * 272 + 16 * wid); rl1 = *(const LAS f32x4*)(r_ + 23552 + lane * 272 + 128 + 16 * wid); } } while (0)
        SCAN_STAGE_LOAD(0); SCAN_STAGE_WRITE(0); SCAN_STAGE_LOAD(1);
        __syncthreads();
        for (int ch = 0; ch < 32; ++ch) {
            SCAN_READ_RAW(ch & 1);
            LAS unsigned char* buf = lds + 32256 + (ch & 1) * 14336;
            LAS bf16_t* KDT = (LAS bf16_t*)buf; LAS bf16_t* VT = (LAS bf16_t*)(buf + 9216); LAS float* DL = (LAS float*)(buf + 13824);
            {
                float qa[4] = {bflo(rq0.x), bfhi(rq0.x), bflo(rq0.y), bfhi(rq0.y)}, qb[4] = {bflo(rq1.x), bfhi(rq1.x), bflo(rq1.y), bfhi(rq1.y)};
                float ka[4] = {bflo(rk0.x), bfhi(rk0.x), bflo(rk0.y), bfhi(rk0.y)}, kb[4] = {bflo(rk1.x), bfhi(rk1.x), bflo(rk1.y), bfhi(rk1.y)};
                float ba[4], bb[4], la[4], lb[4];
                if (mx) {
                    const float pos = (float)(ch * 64 + lane);
#pragma unroll
                    for (int e = 0; e < 4; ++e) {
                        float sn, cs; sincosf(pos * inv[e], &sn, &cs);
                        const float q1 = qa[e], q2 = qb[e], k1 = ka[e], k2 = kb[e];
                        qa[e] = q1 * cs - q2 * sn; qb[e] = q1 * sn + q2 * cs; ka[e] = k1 * cs - k2 * sn; kb[e] = k1 * sn + k2 * cs;
                        ba[e] = bb[e] = (float)(lane + 1) * lg; la[e] = lb[e] = 64.0f * lg;
                    }
                } else {
#pragma unroll
                    for (int e = 0; e < 4; ++e) { ba[e] = scan64(rl0[e], lane); bb[e] = scan64(rl1[e], lane); la[e] = __shfl(ba[e], 63); lb[e] = __shfl(bb[e], 63); }
                }
                float qea[4], qeb[4], kea[4], keb[4];
#pragma unroll
                for (int e = 0; e < 4; ++e) {
                    qea[e] = qa[e] * __expf(ba[e]); qeb[e] = qb[e] * __expf(bb[e]);
                    kea[e] = ka[e] * __expf(-ba[e]); keb[e] = kb[e] * __expf(-bb[e]);
                    const float kda = ka[e] * __expf(la[e] - ba[e]), kdb = kb[e] * __expf(lb[e] - bb[e]);
                    KDT[(4 * wid + e) * P + lane] = (bf16_t)(cvt_pk_bf16(kda, 0.f) & 0xffff);
                    KDT[(32 + 4 * wid + e) * P + lane] = (bf16_t)(cvt_pk_bf16(kdb, 0.f) & 0xffff);
                    if (lane == 63) { DL[4 * wid + e] = __expf(la[e]); DL[32 + 4 * wid + e] = __expf(lb[e]); }
                }
                u32x2 w;
                w.x = cvt_pk_bf16(qea[0], qea[1]); w.y = cvt_pk_bf16(qea[2], qea[3]); *(LAS u32x2*)(QE + lane * P + 4 * wid) = w;
                w.x = cvt_pk_bf16(qeb[0], qeb[1]); w.y = cvt_pk_bf16(qeb[2], qeb[3]); *(LAS u32x2*)(QE + lane * P + 32 + 4 * wid) = w;
                w.x = cvt_pk_bf16(kea[0], kea[1]); w.y = cvt_pk_bf16(kea[2], kea[3]); *(LAS u32x2*)(KE + lane * P + 4 * wid) = w;
                w.x = cvt_pk_bf16(keb[0], keb[1]); w.y = cvt_pk_bf16(keb[2], keb[3]); *(LAS u32x2*)(KE + lane * P + 32 + 4 * wid) = w;
                VT[(4 * wid + 0) * P + lane] = (bf16_t)(rv.x & 0xffff); VT[(4 * wid + 1) * P + lane] = (bf16_t)(rv.x >> 16);
                VT[(4 * wid + 2) * P + lane] = (bf16_t)(rv.y & 0xffff); VT[(4 * wid + 3) * P + lane] = (bf16_t)(rv.y >> 16);
            }
            SCAN_STAGE_WRITE((ch + 1) & 1);
            { const int chn = (ch + 2 < 32) ? ch + 2 : 31; SCAN_STAGE_LOAD(chn); }
            __syncthreads();
            f32x4 oacc = (f32x4){0.f, 0.f, 0.f, 0.f};
            {
#pragma unroll
                for (int q = 0; q < 2; ++q) {
                    const int idx = wid * 2 + q, sb = idx >> 2, tb = idx & 3;
                    f32x4 a = (f32x4){0.f, 0.f, 0.f, 0.f};
                    if (sb <= tb) {
#pragma unroll
                        for (int ks = 0; ks < 2; ++ks) {
                            const bf16x8 A = *(const LAS bf16x8*)(KE + (sb * 16 + fr) * P + ks * 32 + fq * 8);
                            const bf16x8 B = *(const LAS bf16x8*)(QE + (tb * 16 + fr) * P + ks * 32 + fq * 8);
                            a = MFMA16(A, B, a);
                        }
                        const int tg = tb * 16 + fr, sg = sb * 16 + fq * 4;
#pragma unroll
                        for (int jj = 0; jj < 4; ++jj) if (sg + jj > tg) a[jj] = 0.f;
                    }
                    u32x2 w; w.x = cvt_pk_bf16(a[0], a[1]); w.y = cvt_pk_bf16(a[2], a[3]);
                    *(LAS u32x2*)(ATT + (tb * 16 + fr) * P + sb * 16 + fq * 4) = w;
                }
#pragma unroll
                for (int ks = 0; ks < 2; ++ks) {
#ifdef TEST_ST
                    const bf16x8 A = *(const LAS bf16x8*)(VT + (ct * 16 + fr) * P + ks * 32 + fq * 8);
#else
                    const bf16x8 A = *(const LAS bf16x8*)(ST + (ct * 16 + fr) * P + ks * 32 + fq * 8);
#endif
#ifdef TEST_ST
                    const bf16x8 B = *(const LAS bf16x8*)(KDT + (w4 * 16 + fr) * P + ks * 32 + fq * 8);
#else
                    const bf16x8 B = *(const LAS bf16x8*)(QE + (w4 * 16 + fr) * P + ks * 32 + fq * 8);
#endif
                    oacc = MFMA16(A, B, oacc);
                }
            }
            __syncthreads();
            {
                bf16x8 Av[2];
#pragma unroll
                for (int ks = 0; ks < 2; ++ks) Av[ks] = *(const LAS bf16x8*)(VT + (ct * 16 + fr) * P + ks * 32 + fq * 8);
#pragma unroll
                for (int ks = 0; ks < 2; ++ks) {
                    const bf16x8 B = *(const LAS bf16x8*)(ATT + (w4 * 16 + fr) * P + ks * 32 + fq * 8);
#ifndef NO_ATT
                    oacc = MFMA16(Av[ks], B, oacc);
#endif
                }
                const size_t tok = (size_t)b * 2048 + ch * 64 + w4 * 16 + fr;
                *(f32x4*)(omix + tok * 1024 + mx * 512 + h * 128 + vs * 32 + ct * 16 + fq * 4) = oacc;
                const float d = DL[w4 * 16 + fr];
                sacc *= d;
#pragma unroll
                for (int ks = 0; ks < 2; ++ks) {
                    const bf16x8 B = *(const LAS bf16x8*)(KDT + (w4 * 16 + fr) * P + ks * 32 + fq * 8);
                    sacc = MFMA16(Av[ks], B, sacc);
                }
                const unsigned w0 = cvt_pk_bf16(sacc[0], sacc[1]), w1 = cvt_pk_bf16(sacc[2], sacc[3]);
                LAS bf16_t* sp = ST + (ct * 16 + fq * 4) * P + w4 * 16 + fr;
                sp[0] = (bf16_t)(w0 & 0xffff); sp[P] = (bf16_t)(w0 >> 16); sp[2 * P] = (bf16_t)(w1 & 0xffff); sp[3 * P] = (bf16_t)(w1 >> 16);
            }
        }
        *(f32x4*)(p.out + (mx ? OUT_RETP : OUT_GLAP) + ((size_t)(b * 4 + h) * 64 + w4 * 16 + fr) * 128 + vs * 32 + ct * 16 + fq * 4) = sacc;
        __syncthreads();
#undef SCAN_RAW
#undef SCAN_STAGE_LOAD
#undef SCAN_STAGE_WRITE
#undef SCAN_READ_RAW
    }
    {
        LAS float* qv = (LAS float*)lds; LAS float* kv = qv + 256; LAS float* av = kv + 256; LAS float* red = av + 256;
        for (int su = blockIdx.x; su < 1024; su += gridDim.x) {
            const int mx = su & 1, h = (su >> 1) & 3, b = su >> 3;
            const int qoff = (mx ? 1792 : 0) + h * 64, koff = (mx ? 2048 : 256) + h * 64, voff = (mx ? 2304 : 512) + h * 128;
            if (tid < 256) {
                const int t = tid >> 6, k = tid & 63; const size_t tok = (size_t)M_PR + b * 4 + t; const bf16_t* base = proj + tok * NPROJ;
                float q, kk, a;
                if (mx) {
                    const int j = k & 31;
                    const float q1 = bf2f(base[qoff + j]), q2 = bf2f(base[qoff + 32 + j]), k1 = bf2f(base[koff + j]), k2 = bf2f(base[koff + 32 + j]);
                    const float ang = (float)(16384 + t) * exp2f(-(float)j * (13.287712379549449f / 32.0f));
                    float sn, cs; sincosf(ang, &sn, &cs);
                    if (k < 32) { q = q1 * cs - q2 * sn; kk = k1 * cs - k2 * sn; } else { q = q1 * sn + q2 * cs; kk = k1 * sn + k2 * cs; }
                    a = 1.0f - exp2f(-5.0f - (float)h);
                } else { q = bf2f(base[qoff + k]); kk = bf2f(base[koff + k]); a = __expf(loga[tok * 256 + h * 64 + k]); }
                qv[tid] = q; kv[tid] = kk; av[tid] = a;
            }
            __syncthreads();
            const int v = tid & 127, kg = tid >> 7;
            const float* sin_ = (mx ? p.in[4] : p.in[3]) + ((size_t)(b * 4 + h) * 64 + kg * 16) * 128 + v;
            float S[16];
#pragma unroll
            for (int i = 0; i < 16; ++i) S[i] = sin_[(size_t)i * 128];
#pragma unroll
            for (int t = 0; t < 4; ++t) {
                const float vt = bf2f(proj[((size_t)M_PR + b * 4 + t) * NPROJ + voff + v]);
                float part = 0.f;
#pragma unroll
                for (int i = 0; i < 16; ++i) { const int k = t * 64 + kg * 16 + i; S[i] = av[k] * S[i] + kv[k] * vt; part += qv[k] * S[i]; }
                red[(t * 4 + kg) * 128 + v] = part;
            }
            float* sout = p.out + (mx ? OUT_RETS : OUT_GLAS) + ((size_t)(b * 4 + h) * 64 + kg * 16) * 128 + v;
#pragma unroll
            for (int i = 0; i < 16; ++i) sout[(size_t)i * 128] = S[i];
            __syncthreads();
            {
                const int t = tid >> 7;
                const float o = (red[(t * 4 + 0) * 128 + v] + red[(t * 4 + 1) * 128 + v]) + (red[(t * 4 + 2) * 128 + v] + red[(t * 4 + 3) * 128 + v]);
                omix[((size_t)M_PR + b * 4 + t) * 1024 + mx * 512 + h * 128 + v] = o;
            }
            __syncthreads();
        }
    }
}

__device__ void phase_onorm(const Params& p) {
    int tid_ = threadIdx.x; asm volatile("" : "+v"(tid_)); const int tid = tid_, lane = tid & 63, wid = tid >> 6;
    const bf16_t* proj = (const bf16_t*)(p.ws + OFF_PROJ); const float* omix = (const float*)(p.ws + OFF_X); bf16_t* a2 = (bf16_t*)(p.ws + OFF_A2);
    for (int wt = blockIdx.x * 8 + wid; wt < M_TOK * 2; wt += gridDim.x * 8) {
        const int tok = wt >> 1, mx = wt & 1, c = lane * 8;
        const f32x4 o0 = *(const f32x4*)(omix + (size_t)tok * 1024 + mx * 512 + c), o1 = *(const f32x4*)(omix + (size_t)tok * 1024 + mx * 512 + c + 4);
        float ss = (o0[0] * o0[0] + o0[1] * o0[1]) + (o0[2] * o0[2] + o0[3] * o0[3]) + (o1[0] * o1[0] + o1[1] * o1[1]) + (o1[2] * o1[2] + o1[3] * o1[3]);
        ss += __shfl_xor(ss, 1); ss += __shfl_xor(ss, 2); ss += __shfl_xor(ss, 4); ss += __shfl_xor(ss, 8);
        const float r = rsqrtf(ss * (1.0f / 128.0f) + EPS);
        const float* g = (mx ? p.in[12] : p.in[11]) + c;
        const f32x4 g0 = *(const f32x4*)g, g1 = *(const f32x4*)(g + 4);
        const u32x4 gt = *(const u32x4*)(proj + (size_t)tok * NPROJ + (mx ? 2816 : 1280) + c);
        u32x4 w;
        w.x = cvt_pk_bf16(o0[0] * r * g0[0] * bflo(gt.x), o0[1] * r * g0[1] * bfhi(gt.x));
        w.y = cvt_pk_bf16(o0[2] * r * g0[2] * bflo(gt.y), o0[3] * r * g0[3] * bfhi(gt.y));
        w.z = cvt_pk_bf16(o1[0] * r * g1[0] * bflo(gt.z), o1[1] * r * g1[1] * bfhi(gt.z));
        w.w = cvt_pk_bf16(o1[2] * r * g1[2] * bflo(gt.w), o1[3] * r * g1[3] * bfhi(gt.w));
        *(u32x4*)(a2 + (size_t)tok * 1024 + mx * 512 + c) = w;
    }
}

__device__ void phase_attn(const Params& p, LAS unsigned char* lds) {
    int tid_ = threadIdx.x; asm volatile("" : "+v"(tid_)); const int tid = tid_, lane = tid & 63, wid = tid >> 6, fr = lane & 15, fq = lane >> 4;
    const bf16_t* Q = (const bf16_t*)(p.ws + OFF_Q); const bf16_t* KB = (const bf16_t*)(p.ws + OFF_KB); const bf16_t* VTB = (const bf16_t*)(p.ws + OFF_VTB);
    bf16_t* AO = (bf16_t*)(p.ws + OFF_AO);
    const bool sample_first = (blockIdx.x & 8) != 0;
#pragma unroll 1
    for (int part = 0; part < 2; ++part) {
    if ((part == 0) != sample_first) {
    constexpr int KP = 528;
    for (int du0 = blockIdx.x; du0 < 256; du0 += gridDim.x) {
        int du = du0;
        if (gridDim.x == 256) { const int xcd = du0 & 7, slot = du0 >> 3; du = (xcd * 4 + (slot >> 3)) * 8 + (slot & 7); }
        const int q8 = du & 7, h = (du >> 3) & 3, b = du >> 5;
        {
            const bf16_t* src = KB + (size_t)b * 256 * 1024 + h * 256 + (tid & 31) * 8;
#pragma unroll 2
            for (int ps = 0; ps < 16; ++ps) {
                const int r = ps * 16 + (tid >> 5);
                *(LAS u32x4*)(lds + r * KP + (tid & 31) * 16) = *(const u32x4*)(src + (size_t)r * 1024);
            }
        }
        __syncthreads();
        bf16x8 pf[2][8]; float rinv2[2];
#pragma unroll
        for (int sub = 0; sub < 2; ++sub) {
            const size_t row0 = (size_t)b * 2048 + q8 * 256 + sub * 128 + wid * 16;
            bf16x8 qf[8];
#pragma unroll
            for (int ks = 0; ks < 8; ++ks) qf[ks] = *(const bf16x8*)(Q + (row0 + fr) * 1024 + h * 256 + ks * 32 + fq * 8);
            float mxv = -3.0e38f;
#pragma unroll 2
            for (int mb = 0; mb < 16; ++mb) {
                f32x4 a = (f32x4){0.f, 0.f, 0.f, 0.f};
#pragma unroll
                for (int ks = 0; ks < 8; ++ks) a = MFMA16(*(const LAS bf16x8*)(lds + (mb * 16 + fr) * KP + ks * 64 + fq * 16), qf[ks], a);
                mxv = fmaxf(fmaxf(mxv, fmaxf(a[0], a[1])), fmaxf(a[2], a[3]));
                asm volatile("" ::: "memory");
            }
            mxv = fmaxf(mxv, __shfl_xor(mxv, 16)); mxv = fmaxf(mxv, __shfl_xor(mxv, 32));
            float sm = 0.f;
#pragma unroll
            for (int kk = 0; kk < 8; ++kk) {
                f32x4 a0 = (f32x4){0.f, 0.f, 0.f, 0.f}, a1 = a0;
#pragma unroll
                for (int ks = 0; ks < 8; ++ks) {
                    a0 = MFMA16(*(const LAS bf16x8*)(lds + ((2 * kk) * 16 + fr) * KP + ks * 64 + fq * 16), qf[ks], a0);
                    a1 = MFMA16(*(const LAS bf16x8*)(lds + ((2 * kk + 1) * 16 + fr) * KP + ks * 64 + fq * 16), qf[ks], a1);
                }
#pragma unroll
                for (int jj = 0; jj < 4; ++jj) { a0[jj] = __expf(a0[jj] - mxv); a1[jj] = __expf(a1[jj] - mxv); sm += a0[jj] + a1[jj]; }
                u32x4 w; w.x = cvt_pk_bf16(a0[0], a0[1]); w.y = cvt_pk_bf16(a0[2], a0[3]); w.z = cvt_pk_bf16(a1[0], a1[1]); w.w = cvt_pk_bf16(a1[2], a1[3]);
                pf[sub][kk] = __builtin_bit_cast(bf16x8, w);
                asm volatile("" ::: "memory");
            }
            sm += __shfl_xor(sm, 16); sm += __shfl_xor(sm, 32);
            rinv2[sub] = 1.0f / sm;
        }
        __syncthreads();
        {
            const bf16_t* src = VTB + ((size_t)b * 1024 + h * 256) * 256 + (tid & 31) * 8;
#pragma unroll 2
            for (int ps = 0; ps < 16; ++ps) {
                const int r = ps * 16 + (tid >> 5);
                *(LAS u32x4*)(lds + r * KP + (tid & 31) * 16) = *(const u32x4*)(src + (size_t)r * 256);
            }
        }
        __syncthreads();
        {
            const size_t rowA = (size_t)b * 2048 + q8 * 256 + wid * 16 + fr;
#pragma unroll 1
            for (int db = 0; db < 16; ++db) {
                f32x4 a0 = (f32x4){0.f, 0.f, 0.f, 0.f}, a1 = a0;
#pragma unroll
                for (int kk = 0; kk < 8; ++kk) {
                    const LAS unsigned char* vp = lds + (db * 16 + fr) * KP + (kk * 32 + fq * 4) * 2;
                    const u32x2 lo = *(const LAS u32x2*)vp, hi = *(const LAS u32x2*)(vp + 32);
                    u32x4 w; w.x = lo.x; w.y = lo.y; w.z = hi.x; w.w = hi.y;
                    const bf16x8 vf = __builtin_bit_cast(bf16x8, w);
                    a0 = MFMA16(vf, pf[0][kk], a0); a1 = MFMA16(vf, pf[1][kk], a1);
                }
                a0 *= rinv2[0]; a1 *= rinv2[1];
                u32x2 w0, w1; w0.x = cvt_pk_bf16(a0[0], a0[1]); w0.y = cvt_pk_bf16(a0[2], a0[3]); w1.x = cvt_pk_bf16(a1[0], a1[1]); w1.y = cvt_pk_bf16(a1[2], a1[3]);
                *(u32x2*)(AO + rowA * 1024 + h * 256 + db * 16 + fq * 4) = w0;
                *(u32x2*)(AO + (rowA + 128) * 1024 + h * 256 + db * 16 + fq * 4) = w1;
                asm volatile("" ::: "memory");
            }
        }
        __syncthreads();
    }
    } else {
    {
        LAS float* sc = (LAS float*)lds;
        LAS float* red = sc + 2048;
        const float* CK = p.in[5]; const float* CV = p.in[6];
        for (int u = blockIdx.x; u < 256; u += gridDim.x) {
            const int b = u >> 1, hp = u & 1;
            float qr[4][2][4];
#pragma unroll
            for (int t = 0; t < 4; ++t)
#pragma unroll
                for (int hh = 0; hh < 2; ++hh) {
                    const u32x2 w = *(const u32x2*)(Q + ((size_t)M_PR + b * 4 + t) * 1024 + (hp * 2 + hh) * 256 + lane * 4);
                    qr[t][hh][0] = bflo(w.x); qr[t][hh][1] = bfhi(w.x); qr[t][hh][2] = bflo(w.y); qr[t][hh][3] = bfhi(w.y);
                }
            for (int mi = 0; mi < 32; mi += 4) {
                f32x4 kr[4][2];
#pragma unroll
                for (int i = 0; i < 4; ++i)
#pragma unroll
                    for (int hh = 0; hh < 2; ++hh) kr[i][hh] = *(const f32x4*)(CK + (((size_t)b * 256 + wid * 32 + mi + i) * 4 + hp * 2 + hh) * 256 + lane * 4);
                float v32[32];
#pragma unroll
                for (int i = 0; i < 4; ++i)
#pragma unroll
                    for (int hh = 0; hh < 2; ++hh)
#pragma unroll
                        for (int t = 0; t < 4; ++t)
                            v32[(i * 2 + hh) * 4 + t] = kr[i][hh][0] * qr[t][hh][0] + kr[i][hh][1] * qr[t][hh][1] + kr[i][hh][2] * qr[t][hh][2] + kr[i][hh][3] * qr[t][hh][3];
                float w16[16], w8[8], w4[4], w2[2];
                { const bool up = (lane & 32) != 0;
#pragma unroll
                  for (int j = 0; j < 16; ++j) { const float keep = up ? v32[16 + j] : v32[j], send = up ? v32[j] : v32[16 + j]; w16[j] = keep + __shfl_xor(send, 32); } }
                { const bool up = (lane & 16) != 0;
#pragma unroll
                  for (int j = 0; j < 8; ++j) { const float keep = up ? w16[8 + j] : w16[j], send = up ? w16[j] : w16[8 + j]; w8[j] = keep + __shfl_xor(send, 16); } }
                { const bool up = (lane & 8) != 0;
#pragma unroll
                  for (int j = 0; j < 4; ++j) { const float keep = up ? w8[4 + j] : w8[j], send = up ? w8[j] : w8[4 + j]; w4[j] = keep + __shfl_xor(send, 8); } }
                { const bool up = (lane & 4) != 0;
#pragma unroll
                  for (int j = 0; j < 2; ++j) { const float keep = up ? w4[2 + j] : w4[j], send = up ? w4[j] : w4[2 + j]; w2[j] = keep + __shfl_xor(send, 4); } }
                float r1;
                { const bool up = (lane & 2) != 0; const float keep = up ? w2[1] : w2[0], send = up ? w2[0] : w2[1]; r1 = keep + __shfl_xor(send, 2); }
                r1 += __shfl_xor(r1, 1);
                if ((lane & 1) == 0) { const int e = (lane >> 1) & 31, i = e >> 3, hh = (e >> 2) & 1, t = e & 3; sc[(t * 2 + hh) * 256 + wid * 32 + mi + i] = r1; }
            }
            __syncthreads();
            {
                LAS float* r = sc + wid * 256;
                float v0 = r[lane], v1 = r[lane + 64], v2 = r[lane + 128], v3 = r[lane + 192];
                float m = fmaxf(fmaxf(v0, v1), fmaxf(v2, v3));
#pragma unroll
                for (int o = 32; o > 0; o >>= 1) m = fmaxf(m, __shfl_xor(m, o));
                v0 = __expf(v0 - m); v1 = __expf(v1 - m); v2 = __expf(v2 - m); v3 = __expf(v3 - m);
                const float s = wave_sum((v0 + v1) + (v2 + v3)), ri = 1.0f / s;
                r[lane] = v0 * ri; r[lane + 64] = v1 * ri; r[lane + 128] = v2 * ri; r[lane + 192] = v3 * ri;
            }
            __syncthreads();
            {
                f32x4 oa[4][2];
#pragma unroll
                for (int t = 0; t < 4; ++t)
#pragma unroll
                    for (int hh = 0; hh < 2; ++hh) oa[t][hh] = (f32x4){0.f, 0.f, 0.f, 0.f};
                for (int mi = 0; mi < 32; mi += 4) {
                    f32x4 vr[4][2];
#pragma unroll
                    for (int i = 0; i < 4; ++i)
#pragma unroll
                        for (int hh = 0; hh < 2; ++hh) vr[i][hh] = *(const f32x4*)(CV + (((size_t)b * 256 + wid * 32 + mi + i) * 4 + hp * 2 + hh) * 256 + lane * 4);
#pragma unroll
                    for (int i = 0; i < 4; ++i)
#pragma unroll
                        for (int hh = 0; hh < 2; ++hh)
#pragma unroll
                            for (int t = 0; t < 4; ++t) oa[t][hh] += vr[i][hh] * sc[(t * 2 + hh) * 256 + wid * 32 + mi + i];
                }
#pragma unroll
                for (int rnd = 0; rnd < 2; ++rnd) {
#pragma unroll
                    for (int t2 = 0; t2 < 2; ++t2)
#pragma unroll
                        for (int hh = 0; hh < 2; ++hh) *(LAS f32x4*)(red + ((wid * 2 + t2) * 2 + hh) * 256 + lane * 4) = oa[rnd * 2 + t2][hh];
                    __syncthreads();
#pragma unroll
                    for (int i = 0; i < 2; ++i) {
                        const int o = tid + i * 512, t2 = o >> 9, hh = (o >> 8) & 1, d = o & 255;
                        float sacc2 = 0.f;
#pragma unroll
                        for (int w = 0; w < 8; ++w) sacc2 += red[((w * 2 + t2) * 2 + hh) * 256 + d];
                        AO[((size_t)M_PR + b * 4 + rnd * 2 + t2) * 1024 + (hp * 2 + hh) * 256 + d] = (bf16_t)(cvt_pk_bf16(sacc2, 0.f) & 0xffff);
                    }
                    __syncthreads();
                }
            }
        }
    }
    }
    }
}

__device__ __forceinline__ void ins16(float (&T)[16], float x) {
#pragma unroll
    for (int i = 0; i < 16; ++i) { const float hi = fmaxf(T[i], x); x = fminf(T[i], x); T[i] = hi; }
}
__device__ __forceinline__ void sort16(float (&T)[16]) {
#pragma unroll
    for (int k = 2; k <= 16; k <<= 1)
#pragma unroll
        for (int j = k >> 1; j > 0; j >>= 1)
#pragma unroll
            for (int i = 0; i < 16; ++i) {
                const int l = i ^ j;
                if (l > i) {
                    const float hi = fmaxf(T[i], T[l]), lo = fminf(T[i], T[l]);
                    if ((i & k) == 0) { T[i] = hi; T[l] = lo; } else { T[i] = lo; T[l] = hi; }
                }
            }
}
__device__ __forceinline__ void merge16(float (&T)[16]) {
#pragma unroll
    for (int j = 8; j > 0; j >>= 1)
#pragma unroll
        for (int i = 0; i < 16; ++i) {
            const int l = i ^ j;
            if (l > i) { const float hi = fmaxf(T[i], T[l]), lo = fminf(T[i], T[l]); T[i] = hi; T[l] = lo; }
        }
}
__device__ __forceinline__ void topmerge16(float (&T)[16], const float (&G)[16]) {
#pragma unroll
    for (int i = 0; i < 16; ++i) T[i] = fmaxf(T[i], G[15 - i]);
    merge16(T);
}
__device__ __forceinline__ float pack_key(float v, unsigned code, unsigned mask) { return __uint_as_float((__float_as_uint(v) & ~mask) | code); }

__device__ __forceinline__ void peer_select(const bf16_t* PQ, const bf16_t* SKB, int tok0, int frc, int h, LAS int* sel_i, LAS float* sel_g, int fr, int fq) {
            float T1[16], T2[16];
#pragma unroll
            for (int half = 0; half < 2; ++half) {
                bf16x8 qf[4];
#pragma unroll
                for (int ks = 0; ks < 4; ++ks) qf[ks] = *(const bf16x8*)(PQ + (size_t)(tok0 + frc) * 2048 + h * 256 + half * 128 + ks * 32 + fq * 8);
                float T[16], Bk[16];
                {
                    unsigned so = (unsigned)(((h * 2 + half) * 128 + fr) * 128 + fq * 8);
                    asm volatile("" : "+v"(so));
                    const bf16_t* sp0 = SKB + so;
#pragma unroll
                    for (int kg = 0; kg < 2; ++kg) {
                        bf16x8 sf[4][4];
#pragma unroll
                        for (int kb = 0; kb < 4; ++kb)
#pragma unroll
                            for (int ks = 0; ks < 4; ++ks) sf[kb][ks] = *(const bf16x8*)(sp0 + (kg * 4 + kb) * 2048 + ks * 32);
#pragma unroll
                        for (int kb = 0; kb < 4; ++kb) {
                            f32x4 a = (f32x4){0.f, 0.f, 0.f, 0.f};
#pragma unroll
                            for (int ks = 0; ks < 4; ++ks) a = MFMA16(sf[kb][ks], qf[ks], a);
#pragma unroll
                            for (int jj = 0; jj < 4; ++jj) {
                                const float key = pack_key(a[jj], (unsigned)((kg * 4 + kb) * 16 + fq * 4 + jj), 127u);
                                if (kg == 0) T[kb * 4 + jj] = key; else Bk[kb * 4 + jj] = key;
                            }
                        }
                        asm volatile("" ::: "memory");
                    }
                }
                sort16(T); sort16(Bk); topmerge16(T, Bk);
#pragma unroll
                for (int o = 16; o <= 32; o <<= 1) {
                    float R[16];
#pragma unroll
                    for (int i = 0; i < 16; ++i) R[i] = __shfl_xor(T[i], o);
                    topmerge16(T, R);
                }
#pragma unroll
                for (int i = 0; i < 16; ++i) { if (half == 0) T1[i] = T[i]; else T2[i] = T[i]; }
            }
            float va[16], vb[16];
#pragma unroll
            for (int i = 0; i < 16; ++i) { va[i] = __uint_as_float(__float_as_uint(T1[i]) & ~127u); vb[i] = __uint_as_float(__float_as_uint(T2[i]) & ~127u); }
#define PEER_CAND(a_, b_) pack_key(va[a_] + vb[b_], (unsigned)((a_) * 16 + (b_)), 255u)
            float T3[16], X[16];
#pragma unroll
            for (int i = 0; i < 16; ++i) T3[i] = PEER_CAND(0, i);
#pragma unroll
            for (int i = 0; i < 8; ++i) { X[i] = PEER_CAND(1, i); X[8 + i] = PEER_CAND(15 - i, 0); }
            merge16(X); topmerge16(T3, X);
            X[0] = PEER_CAND(2, 0); X[1] = PEER_CAND(2, 1); X[2] = PEER_CAND(2, 2); X[3] = PEER_CAND(2, 3); X[4] = PEER_CAND(2, 4);
            X[5] = PEER_CAND(3, 0); X[6] = PEER_CAND(3, 1); X[7] = PEER_CAND(3, 2); X[8] = PEER_CAND(3, 3);
            X[9] = PEER_CAND(4, 0); X[10] = PEER_CAND(4, 1); X[11] = PEER_CAND(4, 2);
            X[12] = PEER_CAND(5, 0); X[13] = PEER_CAND(5, 1); X[14] = PEER_CAND(6, 0); X[15] = PEER_CAND(6, 1);
            sort16(X); topmerge16(T3, X);
            ins16(T3, PEER_CAND(7, 0)); ins16(T3, PEER_CAND(7, 1));
#undef PEER_CAND
            float e[16], es = 0.f;
            const float m0 = __uint_as_float(__float_as_uint(T3[0]) & ~255u);
#pragma unroll
            for (int i = 0; i < 16; ++i) { e[i] = __expf(__uint_as_float(__float_as_uint(T3[i]) & ~255u) - m0); es += e[i]; }
            const float ei = 1.0f / es;
#pragma unroll
            for (int jj = 0; jj < 4; ++jj) {
                float key = T3[0], ev = e[0];
#pragma unroll
                for (int r = 0; r < 16; ++r) { const bool s = (r == fq * 4 + jj); key = s ? T3[r] : key; ev = s ? e[r] : ev; }
                const unsigned code = __float_as_uint(key) & 255u, ca = code >> 4, cb = code & 15u;
                unsigned k1 = __float_as_uint(T1[0]), k2 = __float_as_uint(T2[0]);
#pragma unroll
                for (int r = 0; r < 16; ++r) { k1 = (ca == (unsigned)r) ? __float_as_uint(T1[r]) : k1; k2 = (cb == (unsigned)r) ? __float_as_uint(T2[r]) : k2; }
                const int idx = (int)((k1 & 127u) * 128u + (k2 & 127u));
                sel_i[fr * 128 + h * 16 + fq * 4 + jj] = idx;
                sel_g[fr * 128 + h * 16 + fq * 4 + jj] = ev * ei;
            }
        }

__device__ void phase_peer(const Params& p, LAS unsigned char* lds) {
    int tid_ = threadIdx.x; asm volatile("" : "+v"(tid_)); const int tid = tid_, lane = tid & 63, wid = tid >> 6, fr = lane & 15, fq = lane >> 4;
    const bf16_t* PQ = (const bf16_t*)(p.ws + OFF_PQ); const bf16_t* SKB = (const bf16_t*)(p.ws + OFF_SKB);
    const unsigned char* U8 = p.ws + OFF_UB; const unsigned char* V8 = p.ws + OFF_VB;
    const float* SS2 = (const float*)(p.ws + OFF_SSP2);
    const bf16_t* H2 = (const bf16_t*)(p.ws + OFF_H2B); float* Y = p.out;
    LAS int* sel_i = (LAS int*)lds;
    LAS float* sel_g = (LAS float*)(lds + 16384);
    LAS float* wv = (LAS float*)(lds + 32768);
    const int per_wg = (M_TOK + gridDim.x - 1) / gridDim.x, wg_lo = blockIdx.x * per_wg, wg_hi = (wg_lo + per_wg < M_TOK) ? wg_lo + per_wg : M_TOK;
    const int ntile = (wg_hi > wg_lo) ? (wg_hi - wg_lo + 15) / 16 : 0;
    if (ntile > 0) {
        const int nv0 = (wg_hi - wg_lo < 16) ? wg_hi - wg_lo : 16, frc0 = (fr < nv0) ? fr : nv0 - 1;
        peer_select(PQ, SKB, wg_lo, frc0, wid, sel_i, sel_g, fr, fq);
    }
    __syncthreads();
    for (int ti = 0; ti < ntile; ++ti) {
        const int tok0 = wg_lo + ti * 16;
        const int nvalid = (wg_hi - tok0 < 16) ? wg_hi - tok0 : 16;
        const LAS int* si_b = sel_i + (ti & 1) * 2048; const LAS float* sg_b = sel_g + (ti & 1) * 2048;
        if (wid >= 4) {
            if (ti + 1 < ntile) {
                const int tok1 = tok0 + 16, nv1 = (wg_hi - tok1 < 16) ? wg_hi - tok1 : 16, frc1 = (fr < nv1) ? fr : nv1 - 1;
#pragma unroll 1
                for (int hh = 0; hh < 2; ++hh) peer_select(PQ, SKB, tok1, frc1, (wid - 4) * 2 + hh, sel_i + ((ti + 1) & 1) * 2048, sel_g + ((ti + 1) & 1) * 2048, fr, fq);
            }
        } else {
    #pragma unroll 1
            for (int tt = 0; tt < 4; ++tt) {
                const int tl = tt * 4 + wid; const size_t tok = (size_t)tok0 + tl;
                if (tl >= nvalid) break;
                const float rs = rsqrtf(wave_sum(lane < 16 ? SS2[(size_t)lane * M_TOK + tok] : 0.f) * (1.0f / 1024.0f) + EPS);
                const bf16_t* hrow = H2 + tok * 1024; const float* gf = p.in[22];
                f32x2 x2[4][8];
    #pragma unroll
                for (int i = 0; i < 4; ++i) {
                    const u32x4 h0 = *(const u32x4*)(hrow + i * 256 + fr * 16), h1 = *(const u32x4*)(hrow + i * 256 + fr * 16 + 8);
    #pragma unroll
                    for (int q = 0; q < 4; ++q) {
                        const f32x4 ga = *(const f32x4*)(gf + i * 256 + fr * 16 + q * 4);
                        const unsigned w0 = (q < 2) ? h0[(q & 1) * 2] : h1[(q & 1) * 2], w1 = (q < 2) ? h0[(q & 1) * 2 + 1] : h1[(q & 1) * 2 + 1];
                        x2[i][q * 2] = (f32x2){bflo(w0) * rs * ga[0], bfhi(w0) * rs * ga[1]}; x2[i][q * 2 + 1] = (f32x2){bflo(w1) * rs * ga[2], bfhi(w1) * rs * ga[3]};
                    }
                }
                const LAS int* si = si_b + tl * 128; const LAS float* sg = sg_b + tl * 128; LAS float* wvw = wv + wid * 128;
                LAS float* upart = (LAS float*)(lds + 36864) + wid * 2048;
                u32x4 bA[1][4], bB[1][4];
    #define PEER_LOADU(buf, g) do { _Pragma("unroll") for (int q_ = 0; q_ < 1; ++q_) { const int idx_ = si[((g) + q_) * 4 + fq]; \
                    const unsigned char* ur_ = U8 + (size_t)idx_ * 1024 + fr * 16; \
                    _Pragma("unroll") for (int i_ = 0; i_ < 4; ++i_) buf[q_][i_] = *(const u32x4*)(ur_ + i_ * 256); } } while (0)
    #define PEER_COMPU(buf, g) do { _Pragma("unroll") for (int q_ = 0; q_ < 1; ++q_) { f32x2 s2_ = (f32x2){0.f, 0.f}; \
                    _Pragma("unroll") for (int i_ = 0; i_ < 4; ++i_) _Pragma("unroll") for (int w_ = 0; w_ < 4; ++w_) { \
                        s2_ += x2[i_][w_ * 2] * __builtin_amdgcn_cvt_pk_f32_fp8((int)buf[q_][i_][w_], false); \
                        s2_ += x2[i_][w_ * 2 + 1] * __builtin_amdgcn_cvt_pk_f32_fp8((int)buf[q_][i_][w_], true); } \
                    upart[(((g) + q_) * 4 + fq) * 16 + fr] = s2_.x + s2_.y; } } while (0)
                PEER_LOADU(bA, 0);
    #pragma unroll 1
                for (int g = 0; g < 32; g += 2) {
                    PEER_LOADU(bB, g + 1);
                    PEER_COMPU(bA, g);
                    { const int gn = (g + 2 < 32) ? g + 2 : 31; PEER_LOADU(bA, gn); }
                    PEER_COMPU(bB, g + 1);
                }
                {
                    float a0 = 0.f, a1 = 0.f;
                    for (int q = 0; q < 4; ++q) { const f32x4 p0 = *(const LAS f32x4*)(upart + lane * 16 + q * 4), p1 = *(const LAS f32x4*)(upart + (lane + 64) * 16 + q * 4);
                        a0 += (p0[0] + p0[1]) + (p0[2] + p0[3]); a1 += (p1[0] + p1[1]) + (p1[2] + p1[3]); }
                    a0 *= (1.0f / 1024.0f); a1 *= (1.0f / 1024.0f);
                    wvw[lane] = 0.5f * a0 * (1.0f + erff(a0 * 0.70710678118654752f)) * sg[lane] * (1.0f / 64.0f);
                    wvw[lane + 64] = 0.5f * a1 * (1.0f + erff(a1 * 0.70710678118654752f)) * sg[lane + 64] * (1.0f / 64.0f);
                }
                f32x2 acc2[8];
    #pragma unroll
                for (int e2 = 0; e2 < 8; ++e2) acc2[e2] = (f32x2){0.f, 0.f};
                u32x4 vA[8], vB[8];
    #define PEER_LOADV(buf, k0) do { _Pragma("unroll") for (int q_ = 0; q_ < 8; ++q_) buf[q_] = *(const u32x4*)(V8 + (size_t)si[(k0) + q_] * 1024 + lane * 16); } while (0)
    #define PEER_COMPV(buf, k0) do { _Pragma("unroll") for (int q_ = 0; q_ < 8; ++q_) { const float w_ = wvw[(k0) + q_]; \
                    _Pragma("unroll") for (int j_ = 0; j_ < 4; ++j_) { \
                        acc2[j_ * 2] += __builtin_amdgcn_cvt_pk_f32_fp8((int)buf[q_][j_], false) * w_; \
                        acc2[j_ * 2 + 1] += __builtin_amdgcn_cvt_pk_f32_fp8((int)buf[q_][j_], true) * w_; } } } while (0)
                PEER_LOADV(vA, 0);
    #pragma unroll 1
                for (int k0 = 0; k0 < 128; k0 += 16) {
                    PEER_LOADV(vB, k0 + 8);
                    PEER_COMPV(vA, k0);
                    { const int kn = (k0 + 16 < 128) ? k0 + 16 : 120; PEER_LOADV(vA, kn); }
                    PEER_COMPV(vB, k0 + 8);
                }
    #undef PEER_LOADU
    #undef PEER_COMPU
    #undef PEER_LOADV
    #undef PEER_COMPV
                float ss = 0.f; f32x4 hv[4];
                {
                    const u32x4 h0 = *(const u32x4*)(hrow + lane * 16), h1 = *(const u32x4*)(hrow + lane * 16 + 8);
    #pragma unroll
                    for (int q = 0; q < 4; ++q) {
                        const unsigned w0 = (q < 2) ? h0[(q & 1) * 2] : h1[(q & 1) * 2], w1 = (q < 2) ? h0[(q & 1) * 2 + 1] : h1[(q & 1) * 2 + 1];
                        hv[q][0] = bflo(w0) + acc2[q * 2].x; hv[q][1] = bfhi(w0) + acc2[q * 2].y; hv[q][2] = bflo(w1) + acc2[q * 2 + 1].x; hv[q][3] = bfhi(w1) + acc2[q * 2 + 1].y;
                        ss += (hv[q][0] * hv[q][0] + hv[q][1] * hv[q][1]) + (hv[q][2] * hv[q][2] + hv[q][3] * hv[q][3]);
                    }
                }
                ss = wave_sum(ss);
                const float rf = rsqrtf(ss * (1.0f / 1024.0f) + EPS);
                const float* nf = p.in[27];
    #pragma unroll
                for (int q = 0; q < 4; ++q) *(f32x4*)(Y + tok * 1024 + lane * 16 + q * 4) = hv[q] * rf * *(const f32x4*)(nf + lane * 16 + q * 4);
            }
        }
        __syncthreads();
    }
}

struct SmallArgs { const bf16_t* A; const bf16_t* Bt; int N; const bf16_t* proj; const bf16_t* base; bf16_t* O; int ldo; float* SSw; const float* SSr; float sc; };
template <int MODE>
__device__ __forceinline__ void small_gemm(const SmallArgs& a, LAS unsigned char* lds) {
    int tid_ = threadIdx.x; asm volatile("" : "+v"(tid_)); const int tid = tid_, lane = tid & 63, wid = tid >> 6, fr = lane & 15, fq = lane >> 4;
    const int ncb = a.N / 64;
    constexpr int SP = 1040;
    LAS unsigned char* LA = lds; LAS unsigned char* LB = lds + 32 * SP;
    LAS float* red = (LAS float*)(lds + 96 * SP);
    for (int tile = blockIdx.x; tile < 16 * ncb; tile += gridDim.x) {
        const int rb = tile / ncb, cb = tile % ncb;
        const int row = M_PR + rb * 32 + (wid >> 2) * 16 + fr;
        const int colb = cb * 64 + (wid & 3) * 16;
        const bf16_t* Ag = a.A + (size_t)(M_PR + rb * 32) * 1024 + (tid & 63) * 8;
        const bf16_t* Bg = a.Bt + (size_t)(cb * 64) * 1024 + (tid & 63) * 8;
        u32x4 ra[4], rbv[8];
#define SG_LOAD(kh_) do { _Pragma("unroll") for (int i_ = 0; i_ < 4; ++i_) ra[i_] = *(const u32x4*)(Ag + (size_t)((tid >> 6) + 8 * i_) * 1024 + (kh_) * 512); \
            _Pragma("unroll") for (int i_ = 0; i_ < 8; ++i_) rbv[i_] = *(const u32x4*)(Bg + (size_t)((tid >> 6) + 8 * i_) * 1024 + (kh_) * 512); } while (0)
        SG_LOAD(0);
        f32x4 acc = (f32x4){0.f, 0.f, 0.f, 0.f};
#pragma unroll
        for (int kh = 0; kh < 2; ++kh) {
#pragma unroll
            for (int i_ = 0; i_ < 4; ++i_) *(LAS u32x4*)(LA + ((tid >> 6) + 8 * i_) * SP + (tid & 63) * 16) = ra[i_];
#pragma unroll
            for (int i_ = 0; i_ < 8; ++i_) *(LAS u32x4*)(LB + ((tid >> 6) + 8 * i_) * SP + (tid & 63) * 16) = rbv[i_];
            __syncthreads();
            if (kh == 0) SG_LOAD(1);
            const LAS unsigned char* apl = LA + ((wid >> 2) * 16 + fr) * SP + fq * 16;
            const LAS unsigned char* bpl = LB + ((wid & 3) * 16 + fr) * SP + fq * 16;
#pragma unroll
            for (int ks = 0; ks < 16; ++ks) acc = MFMA16(*(const LAS bf16x8*)(bpl + ks * 64), *(const LAS bf16x8*)(apl + ks * 64), acc);
            if (MODE == 0 && kh == 0) {
                const u32x2 sa = *(const u32x2*)(a.proj + (size_t)row * NPROJ + 3328 + colb + fq * 4), sb = *(const u32x2*)(a.proj + (size_t)row * NPROJ + 4352 + colb + fq * 4);
                acc[0] *= bflo(sa.x) * __builtin_amdgcn_rcpf(bflo(sb.x)); acc[1] *= bfhi(sa.x) * __builtin_amdgcn_rcpf(bfhi(sb.x));
                acc[2] *= bflo(sa.y) * __builtin_amdgcn_rcpf(bflo(sb.y)); acc[3] *= bfhi(sa.y) * __builtin_amdgcn_rcpf(bfhi(sb.y));
            }
            __syncthreads();
        }
#undef SG_LOAD
        const int col = colb + fq * 4;
        if (MODE == 0) {
            const u32x2 sb = *(const u32x2*)(a.proj + (size_t)row * NPROJ + 4352 + col);
            u32x2 w; w.x = cvt_pk_bf16(acc[0] * bflo(sb.x), acc[1] * bfhi(sb.x)); w.y = cvt_pk_bf16(acc[2] * bflo(sb.y), acc[3] * bfhi(sb.y));
            *(u32x2*)(a.O + (size_t)row * a.ldo + col) = w;
        } else if (MODE == 1) {
            const u32x2 b = *(const u32x2*)(a.base + (size_t)row * 1024 + col);
            f32x4 v = acc; v[0] += bflo(b.x); v[1] += bfhi(b.x); v[2] += bflo(b.y); v[3] += bfhi(b.y);
            float sq = (v[0] * v[0] + v[1] * v[1]) + (v[2] * v[2] + v[3] * v[3]);
            u32x2 w; w.x = cvt_pk_bf16(v[0], v[1]); w.y = cvt_pk_bf16(v[2], v[3]);
            *(u32x2*)(a.O + (size_t)row * a.ldo + col) = w;
            sq += __shfl_xor(sq, 16); sq += __shfl_xor(sq, 32);
            if (fq == 0) red[((wid >> 2) * 16 + fr) * 4 + (wid & 3)] = sq;
            __syncthreads();
            if (tid < 32) a.SSw[(size_t)cb * M_TOK + M_PR + rb * 32 + tid] = (red[tid * 4] + red[tid * 4 + 1]) + (red[tid * 4 + 2] + red[tid * 4 + 3]);
            __syncthreads();
        } else {
            float t = 0.f;
#pragma unroll
            for (int q = 0; q < 4; ++q) t += a.SSr[(size_t)(fq * 4 + q) * M_TOK + row];
            t += __shfl_xor(t, 16); t += __shfl_xor(t, 32);
            const float rs = rsqrtf(t * (1.0f / 1024.0f) + EPS) * a.sc;
            u32x2 w; w.x = cvt_pk_bf16(acc[0] * rs, acc[1] * rs); w.y = cvt_pk_bf16(acc[2] * rs, acc[3] * rs);
            *(u32x2*)(a.O + (size_t)row * a.ldo + col) = w;
        }
    }
}

#define XB_TMO      128
#define XB_XCNT(j)  (256  + 64 * (j))
#define XB_XSUB(j)  (1280 + 64 * (j))
#define XB_XGEN(j)  (2304 + 64 * (j))
#define XB_TOP      3328
#define XB_TOPGEN   3392
#define XCD_BAR_WORDS 3456
#define XB_SPIN_CAP (1u << 18)

__device__ __forceinline__ unsigned xb_ld(unsigned* p)              { return __hip_atomic_load(p, __ATOMIC_RELAXED, __HIP_MEMORY_SCOPE_AGENT); }
__device__ __forceinline__ unsigned xb_add(unsigned* p, unsigned v) { return __hip_atomic_fetch_add(p, v, __ATOMIC_RELAXED, __HIP_MEMORY_SCOPE_AGENT); }
__device__ __forceinline__ unsigned xb_xcc_id() { return (unsigned)__builtin_amdgcn_s_getreg((3 << 11) | 20) & 0xFu; }
#define XB_SPIN(cond, bar) do { unsigned _sp = 0; while (cond) { __builtin_amdgcn_s_sleep(1); \
    if ((++_sp & 255u) == 0u) { if (xb_ld(&(bar)[XB_TMO])) break; if (_sp > XB_SPIN_CAP) { atomicAdd(&(bar)[XB_TMO], 1u); break; } } } } while (0)

struct XcdBarrier {
    unsigned* bar; unsigned x;
    volatile LAS unsigned* st;
};

__device__ __forceinline__ XcdBarrier xcd_barrier_post(unsigned* bar, volatile LAS unsigned* st) {
    XcdBarrier b; b.bar = bar; b.x = xb_xcc_id(); b.st = st;
    if (threadIdx.x == 0) (void)xb_add(&bar[XB_XCNT(b.x)], 1u);
    return b;
}
__device__ __forceinline__ void xcd_barrier_complete(unsigned* bar, unsigned x, unsigned& nloc, unsigned& nx) {
    const unsigned G = gridDim.x * gridDim.y * gridDim.z;
    unsigned sum, cnt, mine, sp = 0u;
    for (;;) {
        sum = 0u; cnt = 0u; mine = 0u;
#pragma unroll
        for (unsigned j = 0; j < 16; ++j) { const unsigned c = xb_ld(&bar[XB_XCNT(j)]); sum += c; cnt += (c > 0u) ? 1u : 0u; mine = (j == x) ? c : mine; }
        if (sum == G) break;
        __builtin_amdgcn_s_sleep(1);
        if ((++sp & 255u) == 0u) { if (xb_ld(&bar[XB_TMO])) break; if (sp > XB_SPIN_CAP) { atomicAdd(&bar[XB_TMO], 1u); break; } }
    }
    nloc = mine > 0u ? mine : 1u; nx = cnt > 0u ? cnt : 1u;
}

__device__ __forceinline__ void xcd_barrier(const XcdBarrier& b) {
    asm volatile("s_waitcnt vmcnt(0)" ::: "memory");
    __syncthreads();
    if (threadIdx.x == 0) {
        unsigned* bar = b.bar;
        __builtin_amdgcn_s_waitcnt(0);
        unsigned nloc = b.st[0], nx = b.st[1];
        if (nloc == 0u) { xcd_barrier_complete(bar, b.x, nloc, nx); b.st[0] = nloc; b.st[1] = nx; }
        const unsigned old = xb_add(&bar[XB_XSUB(b.x)], 1u);
        const unsigned gen = old / nloc;
        if (old + 1u == (gen + 1u) * nloc) {
            __builtin_amdgcn_fence(__ATOMIC_RELEASE, "agent");
            asm volatile("s_waitcnt vmcnt(0)" ::: "memory");
            const unsigned og = xb_add(&bar[XB_TOP], 1u);
            const unsigned tg = og / nx;
            if (og + 1u == (tg + 1u) * nx) xb_add(&bar[XB_TOPGEN], 1u);
            else XB_SPIN(xb_ld(&bar[XB_TOPGEN]) == tg, bar);
            __builtin_amdgcn_fence(__ATOMIC_ACQUIRE, "agent");
            xb_add(&bar[XB_XGEN(b.x)], 1u);
            asm volatile("s_waitcnt vmcnt(0)" ::: "memory");
        } else {
            XB_SPIN(xb_ld(&bar[XB_XGEN(b.x)]) == gen, bar);
            __builtin_amdgcn_fence(__ATOMIC_ACQUIRE, "agent");
            asm volatile("s_waitcnt vmcnt(0)" ::: "memory");
        }
    }
    __syncthreads();
}


__device__ __forceinline__ void my_grid_sync(unsigned* bar, unsigned target) {
    asm volatile("s_waitcnt vmcnt(0) lgkmcnt(0)" ::: "memory");
    __syncthreads();
    if (threadIdx.x == 0) {
        __builtin_amdgcn_fence(__ATOMIC_RELEASE, "agent");
        asm volatile("s_waitcnt vmcnt(0)" ::: "memory");
        __hip_atomic_fetch_add(bar, 1u, __ATOMIC_RELAXED, __HIP_MEMORY_SCOPE_AGENT);
        while (__hip_atomic_load(bar, __ATOMIC_RELAXED, __HIP_MEMORY_SCOPE_AGENT) < target) __builtin_amdgcn_s_sleep(2);
    }
    __syncthreads();
    asm volatile("buffer_inv sc1\n\ts_waitcnt vmcnt(0)" ::: "memory");
}
__global__ void __launch_bounds__(NTHR) mk_fwd(Params p) {
    extern __shared__ __attribute__((aligned(16))) unsigned char lds_raw[];
    LAS unsigned char* lds = (LAS unsigned char*)lds_raw;
    cg::grid_group grid = cg::this_grid();
    if (threadIdx.x < 4) ((LAS unsigned*)(lds + LDS_BYTES - 16))[threadIdx.x] = 0u;
    __syncthreads();
    const XcdBarrier xb = xcd_barrier_post((unsigned*)(p.ws + OFF_BAR), (volatile LAS unsigned*)(lds + LDS_BYTES - 16));
#define GRID_SYNC() xcd_barrier(xb)
    unsigned char* ws = p.ws;
    const int G = gridDim.x, c = blockIdx.x;
    const bf16_t* A0 = (const bf16_t*)(ws + OFF_A0);

    if (p.ws == nullptr) grid.sync();
    PH(0) phase_prep(p, lds);
    GRID_SYNC();
    PH(1) {
        pg8::Sched S; S.init(A0, (const bf16_t*)(ws + OFF_WTIN), M_TOK, NPROJ, A0 + (size_t)M_TOK * 1024, (const bf16_t*)(ws + OFF_WTKV), 2048, 2048, G, c);
        EpiProj E{(const float*)(ws + OFF_SS0), p.in[10], (bf16_t*)(ws + OFF_PROJ), (float*)(ws + OFF_LOGA), p.out, (bf16_t*)(ws + OFF_KB), (bf16_t*)(ws + OFF_VTB)};
        pg8::gemm_phase(lds, 1024, S, E);
    }
    GRID_SYNC();
    PH(2) phase_scan(p, lds);
    GRID_SYNC();
    PH(3) phase_onorm(p);
    GRID_SYNC();
    PH(4) {
        pg8::Sched S; S.init((const bf16_t*)(ws + OFF_A2), (const bf16_t*)(ws + OFF_WTP), M_PR, 1024, nullptr, nullptr, 0, 0, G, c);
        EpiMerge E{(const bf16_t*)(ws + OFF_PROJ), (bf16_t*)(ws + OFF_X)};
        pg8::gemm_phase(lds, 1024, S, E);
        SmallArgs sa{(const bf16_t*)(ws + OFF_A2), (const bf16_t*)(ws + OFF_WTP), 1024, (const bf16_t*)(ws + OFF_PROJ), nullptr, (bf16_t*)(ws + OFF_X), 1024, nullptr, nullptr, 1.f};
        small_gemm<0>(sa, lds);
    }
    GRID_SYNC();
    PH(5) {
        pg8::Sched S; S.init((const bf16_t*)(ws + OFF_X), (const bf16_t*)(ws + OFF_WTO), M_PR, 1024, nullptr, nullptr, 0, 0, G, c);
        EpiResid E{A0, (bf16_t*)(ws + OFF_H1B), (float*)(ws + OFF_SSP1)};
        pg8::gemm_phase(lds, 1024, S, E);
        SmallArgs sa{(const bf16_t*)(ws + OFF_X), (const bf16_t*)(ws + OFF_WTO), 1024, nullptr, A0, (bf16_t*)(ws + OFF_H1B), 1024, (float*)(ws + OFF_SSP1), nullptr, 1.f};
        small_gemm<1>(sa, lds);
    }
    GRID_SYNC();
    PH(6) {
        pg8::Sched S; S.init((const bf16_t*)(ws + OFF_H1B), (const bf16_t*)(ws + OFF_WTXQ), M_PR, 1024, nullptr, nullptr, 0, 0, G, c);
        EpiScale E{(const float*)(ws + OFF_SSP1), (bf16_t*)(ws + OFF_Q), 1024, 0.0625f};
        pg8::gemm_phase(lds, 1024, S, E);
        SmallArgs sa{(const bf16_t*)(ws + OFF_H1B), (const bf16_t*)(ws + OFF_WTXQ), 1024, nullptr, nullptr, (bf16_t*)(ws + OFF_Q), 1024, nullptr, (const float*)(ws + OFF_SSP1), 0.0625f};
        small_gemm<2>(sa, lds);
    }
    GRID_SYNC();
    PH(7) phase_attn(p, lds);
    GRID_SYNC();
    PH(8) {
        pg8::Sched S; S.init((const bf16_t*)(ws + OFF_AO), (const bf16_t*)(ws + OFF_WTXO), M_PR, 1024, nullptr, nullptr, 0, 0, G, c);
        EpiResid E{(const bf16_t*)(ws + OFF_H1B), (bf16_t*)(ws + OFF_H2B), (float*)(ws + OFF_SSP2)};
        pg8::gemm_phase(lds, 1024, S, E);
        SmallArgs sa{(const bf16_t*)(ws + OFF_AO), (const bf16_t*)(ws + OFF_WTXO), 1024, nullptr, (const bf16_t*)(ws + OFF_H1B), (bf16_t*)(ws + OFF_H2B), 1024, (float*)(ws + OFF_SSP2), nullptr, 1.f};
        small_gemm<1>(sa, lds);
    }
    GRID_SYNC();
    PH(9) {
        pg8::Sched S; S.init((const bf16_t*)(ws + OFF_H2B), (const bf16_t*)(ws + OFF_WTPQ), M_PR, 2048, nullptr, nullptr, 0, 0, G, c);
        EpiScale E{(const float*)(ws + OFF_SSP2), (bf16_t*)(ws + OFF_PQ), 2048, 1.0f};
        pg8::gemm_phase(lds, 1024, S, E);
        SmallArgs sa{(const bf16_t*)(ws + OFF_H2B), (const bf16_t*)(ws + OFF_WTPQ), 2048, nullptr, nullptr, (bf16_t*)(ws + OFF_PQ), 2048, nullptr, (const float*)(ws + OFF_SSP2), 1.0f};
        small_gemm<2>(sa, lds);
    }
    GRID_SYNC();
    PH(10) phase_peer(p, lds);
#ifdef DUMP
    GRID_SYNC();
    {
        const size_t gt = (size_t)blockIdx.x * NTHR + threadIdx.x, ngt = (size_t)gridDim.x * NTHR;
        const bf16_t* srcb = (const bf16_t*)(ws + (DUMP == 1 ? OFF_A2 : (DUMP == 2 ? OFF_X : OFF_H1B)));
        const float* srcf = (const float*)(ws + OFF_X);
        if (DUMP == 4) { const bf16_t* pj = (const bf16_t*)(ws + OFF_PROJ); for (size_t i = gt; i < (size_t)M_TOK * 1024; i += ngt) p.out[i] = bf2f(pj[(i >> 10) * NPROJ + (i & 1023)]); }
        else if (DUMP == 5) { const bf16_t* pj = (const bf16_t*)(ws + OFF_PROJ); for (size_t i = gt; i < (size_t)M_TOK * 1024; i += ngt) p.out[i] = bf2f(pj[(i >> 10) * NPROJ + 1792 + (i & 1023)]); }
        else for (size_t i = gt; i < (size_t)M_PR * 1024; i += ngt) p.out[i] = (DUMP == 3) ? srcf[i] : bf2f(srcb[i]);
    }
#endif
}

extern "C" void kernel_launch(void* const* d_in, const int* in_sizes, int n_in, void* d_out, int out_size, void* d_ws, size_t ws_size, hipStream_t stream) {
    static int grid_blocks = 0;
    if (!grid_blocks) {
        int dev = 0, cus = 0, per_cu = 0;
        (void)hipGetDevice(&dev);
        (void)hipDeviceGetAttribute(&cus, hipDeviceAttributeMultiprocessorCount, dev);
        (void)hipFuncSetAttribute((const void*)mk_fwd, hipFuncAttributeMaxDynamicSharedMemorySize, LDS_BYTES);
        (void)hipOccupancyMaxActiveBlocksPerMultiprocessor(&per_cu, (const void*)mk_fwd, NTHR, LDS_BYTES);
        if (per_cu < 1) per_cu = 1;
        grid_blocks = cus * per_cu;
        if (ws_size < WS_END) fprintf(stderr, "kernel_launch: workspace too small (%zu < %zu)\n", ws_size, (size_t)WS_END);
    }
    Params p{};
    for (int i = 0; i < 28; ++i) p.in[i] = (const float*)d_in[i];
    p.out = (float*)d_out; p.ws = (unsigned char*)d_ws;
    (void)hipMemsetAsync((unsigned char*)d_ws + OFF_BAR, 0, 16384, stream);
    void* args[] = {&p};
    hipError_t e = hipLaunchCooperativeKernel((const void*)mk_fwd, dim3(grid_blocks), dim3(NTHR), args, LDS_BYTES, stream);
    if (e != hipSuccess) fprintf(stderr, "cooperative launch failed: %s (grid %d)\n", hipGetErrorString(e), grid_blocks);
}
```
